# Optimizing an MI355X kernel written in HIP

```python
import jax, jax.numpy as jnp
from jax import lax
import numpy as np

D_MODEL = 1024
BATCH = 1
SEQ = 16384
DEPTH = 1
DEC_BATCH = 128
DEC_SEQ = 1
PAST_LEN = 16384
PAGE_SIZE = 128

N_HEADS = 8
QK_NOPE = 128
QK_ROPE = 64
V_DIM = 128
Q_RANK = 256
KV_RANK = 128
ATT_WIDTH = N_HEADS * V_DIM
SOFTMAX_SCALE = (QK_NOPE + QK_ROPE) ** -0.5
ROPE_BASE = 10000.0
Q_BLOCK = 128
NEG_INF = -1e30
POOL_WINDOWS = (2, 4, 8, 16)
N_POOL_GROUPS = 4
POOL_GROUP_DIM = 128
POOL_WIDTH = N_POOL_GROUPS * POOL_GROUP_DIM
POOL_HIST = 15
EPS = 1e-6
OFF_KV = Q_RANK
OFF_KR = OFF_KV + KV_RANK
OFF_ZA = OFF_KR + QK_ROPE
OFF_UP = OFF_ZA + ATT_WIDTH
OFF_ZP = OFF_UP + POOL_WIDTH
OFF_GA = OFF_ZP + POOL_WIDTH
OFF_GP = OFF_GA + D_MODEL
IN_COLS = OFF_GP + D_MODEL
SPLIT_POINTS = (OFF_KV, OFF_KR, OFF_ZA, OFF_UP, OFF_ZP, OFF_GA, OFF_GP)

kernel_name = "mla_pool_gated_hybrid_step"


def rmsnorm(x, g):
    xf = x.astype(jnp.float32)
    y = xf * lax.rsqrt(jnp.mean(xf * xf, axis=-1, keepdims=True) + EPS)
    return (y * g.astype(jnp.float32)).astype(x.dtype)


def rope(x, pos):
    half = QK_ROPE // 2
    inv = ROPE_BASE ** (-jnp.arange(half, dtype=jnp.float32) / half)
    ang = pos.astype(jnp.float32)[:, None] * inv[None, :]
    shape = (1, pos.shape[0]) + (1,) * (x.ndim - 3) + (half,)
    cos = jnp.cos(ang).reshape(shape)
    sin = jnp.sin(ang).reshape(shape)
    xf = x.astype(jnp.float32)
    x1, x2 = xf[..., :half], xf[..., half:]
    return jnp.concatenate([x1 * cos - x2 * sin, x2 * cos + x1 * sin], axis=-1).astype(x.dtype)


def mla_attend(q_abs, q_r, q_pos, ckv, kr, k_pos):
    s = (jnp.einsum('bqhr,bkr->bhqk', q_abs, ckv).astype(jnp.float32)
         + jnp.einsum('bqhp,bkp->bhqk', q_r, kr).astype(jnp.float32)) * SOFTMAX_SCALE
    mask = q_pos[:, None] >= k_pos[None, :]
    s = jnp.where(mask[None, None], s, NEG_INF)
    p = jax.nn.softmax(s, axis=-1).astype(ckv.dtype)
    return jnp.einsum('bhqk,bkr->bqhr', p, ckv)


def blocked_causal_mla(q_abs, q_r, pos, ckv, kr):
    b, L = q_abs.shape[0], q_abs.shape[1]
    nb = L // Q_BLOCK
    qa_b = q_abs.reshape(b, nb, Q_BLOCK, N_HEADS, KV_RANK).swapaxes(0, 1)
    qr_b = q_r.reshape(b, nb, Q_BLOCK, N_HEADS, QK_ROPE).swapaxes(0, 1)
    qp_b = pos.reshape(nb, Q_BLOCK)

    def one_block(args):
        qa, qr, qp = args
        return mla_attend(qa, qr, qp, ckv, kr, pos)

    o = lax.map(one_block, (qa_b, qr_b, qp_b))
    return o.swapaxes(0, 1).reshape(b, L, N_HEADS, KV_RANK)


def pool_mixer(u, hist, pos, w_pool, pool_scale):
    L = u.shape[1]
    u_ext = jnp.concatenate([hist, u], axis=1)
    cs = jnp.cumsum(u_ext.astype(jnp.float32), axis=1)
    cs = jnp.pad(cs, ((0, 0), (1, 0), (0, 0)))
    end = cs[:, POOL_HIST + 1:POOL_HIST + 1 + L]
    groups = []
    for g, w in enumerate(POOL_WINDOWS):
        lo, hi = g * POOL_GROUP_DIM, (g + 1) * POOL_GROUP_DIM
        start = cs[:, POOL_HIST + 1 - w:POOL_HIST + 1 - w + L, lo:hi]
        cnt = jnp.minimum(w, pos + 1).astype(jnp.float32)[None, :, None]
        groups.append((end[..., lo:hi] - start) / cnt)
    pooled = jnp.concatenate(groups, axis=-1) - u.astype(jnp.float32)
    pooled = pooled.astype(u.dtype).reshape(u.shape[0], L, N_POOL_GROUPS, POOL_GROUP_DIM)
    mixed = jnp.einsum('bsgc,gcd->bsgd', pooled, w_pool).reshape(u.shape[0], L, POOL_WIDTH)
    return mixed * pool_scale, u_ext[:, -POOL_HIST:]


def mixer_layer(x, pos0, pool_hist, past_ckv, past_kr,
                g_pre, w_in, g_q, w_uq, g_kv, w_uk, w_uv, w_o_att,
                w_pool, pool_scale, w_o_pool, w_out):
    b, L, _ = x.shape
    h = rmsnorm(x, g_pre)
    z = h @ w_in
    q_lat, kv_lat, k_r, z_att, u_pool, z_pool, g_att, g_pool = jnp.split(z, SPLIT_POINTS, axis=-1)
    pos = pos0 + jnp.arange(L, dtype=jnp.int32)
    q = (rmsnorm(q_lat, g_q) @ w_uq).reshape(b, L, N_HEADS, QK_NOPE + QK_ROPE)
    q_nope = q[..., :QK_NOPE]
    q_r = rope(q[..., QK_NOPE:], pos)
    q_abs = jnp.einsum('bshn,rhn->bshr', q_nope, w_uk)
    ckv_new = rmsnorm(kv_lat, g_kv)
    kr_new = rope(k_r, pos)
    if past_ckv is None:
        o_lat = blocked_causal_mla(q_abs, q_r, pos, ckv_new, kr_new)
    else:
        ckv_all = jnp.concatenate([past_ckv, ckv_new], axis=1)
        kr_all = jnp.concatenate([past_kr, kr_new], axis=1)
        k_pos = jnp.arange(ckv_all.shape[1], dtype=jnp.int32)
        o_lat = mla_attend(q_abs, q_r, pos, ckv_all, kr_all, k_pos)
    o = jnp.einsum('bshr,rhv->bshv', o_lat, w_uv).reshape(b, L, ATT_WIDTH)
    y_att = (o * jax.nn.silu(z_att)) @ w_o_att
    p, pool_state = pool_mixer(u_pool, pool_hist, pos, w_pool, pool_scale)
    y_pool = (p * jax.nn.silu(z_pool)) @ w_o_pool
    merged = jax.nn.sigmoid(g_att) * y_att + jax.nn.sigmoid(g_pool) * y_pool
    x = x + merged @ w_out
    return x, ckv_new, kr_new, pool_state


def setup_inputs(seed: int = 0) -> dict:
    key = jax.random.key(seed)
    ks = jax.random.split(key, 24)
    n_pages = PAST_LEN // PAGE_SIZE
    n_used = DEC_BATCH * n_pages
    n_phys = n_used + n_used // 4

    def nrm(k, shape, scale):
        return jax.random.normal(k, shape, dtype=jnp.float32) * scale

    def gain(k, shape):
        return 1.0 + 0.05 * jax.random.normal(k, shape, dtype=jnp.float32)

    page_table = jax.random.permutation(ks[0], n_phys)[:n_used].reshape(DEC_BATCH, n_pages).astype(jnp.int32)
    return {
        "x_prompt": nrm(ks[1], (BATCH, SEQ, D_MODEL), 1.0),
        "x_sample": nrm(ks[2], (DEC_BATCH, DEC_SEQ, D_MODEL), 1.0),
        "cache_ckv": nrm(ks[3], (DEPTH, n_phys, PAGE_SIZE, KV_RANK), 1.0),
        "cache_krope": nrm(ks[4], (DEPTH, n_phys, PAGE_SIZE, QK_ROPE), 1.0),
        "state_pool": nrm(ks[5], (DEPTH, DEC_BATCH, POOL_HIST, POOL_WIDTH), 1.0),
        "page_table": page_table,
        "g_pre": gain(ks[6], (DEPTH, D_MODEL)),
        "w_in": nrm(ks[7], (DEPTH, D_MODEL, IN_COLS), D_MODEL ** -0.5),
        "g_q": gain(ks[8], (DEPTH, Q_RANK)),
        "w_uq": nrm(ks[9], (DEPTH, Q_RANK, N_HEADS * (QK_NOPE + QK_ROPE)), Q_RANK ** -0.5),
        "g_kv": gain(ks[10], (DEPTH, KV_RANK)),
        "w_uk": nrm(ks[11], (DEPTH, KV_RANK, N_HEADS, QK_NOPE), KV_RANK ** -0.5),
        "w_uv": nrm(ks[12], (DEPTH, KV_RANK, N_HEADS, V_DIM), KV_RANK ** -0.5),
        "w_o_att": nrm(ks[13], (DEPTH, ATT_WIDTH, D_MODEL), ATT_WIDTH ** -0.5),
        "w_pool": nrm(ks[14], (DEPTH, N_POOL_GROUPS, POOL_GROUP_DIM, POOL_GROUP_DIM), POOL_GROUP_DIM ** -0.5),
        "pool_scale": gain(ks[15], (DEPTH, POOL_WIDTH)),
        "w_o_pool": nrm(ks[16], (DEPTH, POOL_WIDTH, D_MODEL), POOL_WIDTH ** -0.5),
        "w_out": nrm(ks[17], (DEPTH, D_MODEL, D_MODEL), D_MODEL ** -0.5),
        "g_final": gain(ks[18], (D_MODEL,)),
    }


def reference(x_prompt, x_sample, cache_ckv, cache_krope, state_pool, page_table,
              g_pre, w_in, g_q, w_uq, g_kv, w_uk, w_uv, w_o_att,
              w_pool, pool_scale, w_o_pool, w_out, g_final):
    dec_b = x_sample.shape[0]
    past_len = page_table.shape[1] * cache_ckv.shape[2]
    xp, xs = x_prompt, x_sample
    ckv_p, kr_p, pool_p, ckv_s, kr_s, pool_s = [], [], [], [], [], []
    for l in range(DEPTH):
        lw = (g_pre[l], w_in[l], g_q[l], w_uq[l], g_kv[l], w_uk[l], w_uv[l], w_o_att[l],
              w_pool[l], pool_scale[l], w_o_pool[l], w_out[l])
        hist0 = jnp.zeros((xp.shape[0], POOL_HIST, POOL_WIDTH), dtype=xp.dtype)
        xp, c_p, k_p, s_p = mixer_layer(xp, 0, hist0, None, None, *lw)
        past_ckv = cache_ckv[l][page_table].reshape(dec_b, past_len, KV_RANK)
        past_kr = cache_krope[l][page_table].reshape(dec_b, past_len, QK_ROPE)
        xs, c_s, k_s, s_s = mixer_layer(xs, past_len, state_pool[l], past_ckv, past_kr, *lw)
        ckv_p.append(c_p); kr_p.append(k_p); pool_p.append(s_p)
        ckv_s.append(c_s); kr_s.append(k_s); pool_s.append(s_s)
    y_prompt = rmsnorm(xp, g_final)
    y_sample = rmsnorm(xs, g_final)
    return (y_prompt, y_sample, jnp.stack(ckv_p), jnp.stack(kr_p), jnp.stack(pool_p),
            jnp.stack(ckv_s), jnp.stack(kr_s), jnp.stack(pool_s))
```

```cpp
#include <hip/hip_runtime.h>
#include <cstdio>
#include <cstdint>

#define GAS __attribute__((address_space(1)))
#define LAS __attribute__((address_space(3)))
typedef unsigned short bf16;
typedef short bf16x8 __attribute__((ext_vector_type(8)));
typedef short s16x4 __attribute__((ext_vector_type(4)));
typedef float f32x2 __attribute__((ext_vector_type(2)));
typedef float f32x4 __attribute__((ext_vector_type(4)));
typedef float f32x16 __attribute__((ext_vector_type(16)));
typedef unsigned u32x2 __attribute__((ext_vector_type(2)));
typedef unsigned u32x4 __attribute__((ext_vector_type(4)));
typedef GAS unsigned gu32;

constexpr int DM = 1024, SEQ = 16384, NS = 128, PAST = 16384, PAGE = 128, NPG = PAST / PAGE;
constexpr int MTOT = SEQ + NS;
constexpr int MPAD = 65 * 256;
constexpr int NH = 8, NOPE = 128, ROPE = 64, VD = 128, QRANK = 256, KVR = 128, ATTW = NH * VD, POOLW = 512, PHIST = 15;
constexpr int QKD = KVR + ROPE;
constexpr int INC = 4544, N1 = 4608;
constexpr int GW = ATTW + POOLW;
constexpr float EPS = 1e-6f;
constexpr float C2 = 0.07216878364870322f * 1.4426950408889634f;
constexpr size_t O_YP = 0, O_YS = O_YP + (size_t)SEQ * DM, O_CKVP = O_YS + (size_t)NS * DM, O_KRP = O_CKVP + (size_t)SEQ * KVR, O_POOLP = O_KRP + (size_t)SEQ * ROPE,
                 O_CKVS = O_POOLP + (size_t)PHIST * POOLW, O_KRS = O_CKVS + (size_t)NS * KVR, O_POOLS = O_KRS + (size_t)NS * ROPE, O_END = O_POOLS + (size_t)NS * PHIST * POOLW;
static_assert(O_END == 21069312, "d_out map");
constexpr size_t MiB = 1u << 20;
constexpr size_t WS_CTL = 0, CTL_ZERO_BYTES = 1 * MiB;
constexpr size_t WS_BT1 = 2 * MiB;
constexpr size_t WS_BTQ = 11 * MiB;
constexpr size_t WS_BTG = 12 * MiB;
constexpr size_t WS_BTOA = 13 * MiB;
constexpr size_t WS_BTOP = 15 * MiB;
constexpr size_t WS_BTOUT = 16 * MiB;
constexpr size_t WS_ROPE = 18 * MiB;
constexpr size_t WS_QSS = 23 * MiB;
constexpr size_t WS_DPART = 24 * MiB;
constexpr size_t WS_H = 32 * MiB;
constexpr size_t WS_QLAT = 65 * MiB;
constexpr size_t WS_KVRAW = 74 * MiB;
constexpr size_t WS_KB = 87 * MiB;
constexpr size_t WS_SZ = 94 * MiB;
constexpr size_t WS_U = 143 * MiB;
constexpr size_t WS_SGA = 176 * MiB;
constexpr size_t WS_SGP = 209 * MiB;
constexpr size_t WS_OLPL = 242 * MiB;
constexpr size_t WS_QA = 291 * MiB;
constexpr size_t WS_QR = 324 * MiB;
constexpr size_t WS_G12 = 341 * MiB;
constexpr size_t WS_M1 = 390 * MiB;
constexpr size_t WS_MG = 456 * MiB;
constexpr size_t WS_END = 489 * MiB;
static_assert(WS_BT1 + (size_t)N1 * 1024 * 2 <= WS_BTQ && WS_BTQ + 1536 * 256 * 2 <= WS_BTG && WS_BTG + 1536 * 256 * 2 <= WS_BTOA && WS_ROPE + (size_t)(SEQ + 1) * 32 * 8 <= WS_QSS &&
              WS_QSS + (size_t)MPAD * 16 <= WS_DPART && WS_DPART + 256 * 8 * 130 * 4 <= WS_H && WS_H + (size_t)MPAD * 2048 <= WS_QLAT && WS_QLAT + (size_t)MPAD * 512 <= WS_KVRAW &&
              WS_KVRAW + (size_t)MPAD * 768 <= WS_KB && WS_KB + (size_t)MPAD * 384 <= WS_SZ && WS_SZ + (size_t)MPAD * 3072 <= WS_U && WS_U + (size_t)MPAD * 2048 <= WS_SGA &&
              WS_SGA + (size_t)MPAD * 2048 <= WS_SGP && WS_SGP + (size_t)MPAD * 2048 <= WS_OLPL && WS_OLPL + (size_t)MPAD * 3072 <= WS_QA && WS_QA + (size_t)MPAD * 2048 <= WS_QR &&
              WS_QR + (size_t)MPAD * 1024 <= WS_G12 && WS_G12 + (size_t)MPAD * 3072 <= WS_M1 && WS_M1 + (size_t)MPAD * 4096 <= WS_MG && WS_MG + (size_t)MPAD * 2048 <= WS_END, "d_ws map");
constexpr int CW_BAR = 4096;
constexpr int RING_OFF = 0, RING_BYTES = 131072;
constexpr int LDSCTL_OFF = RING_BYTES, MISC_OFF = LDSCTL_OFF + 320;
constexpr int LDS_BYTES = 147456;
constexpr int NWAVES = 8;

#define LDS_WAIT() asm volatile("s_waitcnt lgkmcnt(0)" ::: "memory")
#define VM_WAIT() asm volatile("s_waitcnt vmcnt(0)" ::: "memory")
#define SBAR() __builtin_amdgcn_sched_barrier(0)
__device__ __forceinline__ unsigned cvtpk(float lo, float hi) { unsigned r; asm("v_cvt_pk_bf16_f32 %0, %1, %2" : "=v"(r) : "v"(lo), "v"(hi)); return r; }
__device__ __forceinline__ float bflo(unsigned w) { return __builtin_bit_cast(float, w << 16); }
__device__ __forceinline__ float bfhi(unsigned w) { return __builtin_bit_cast(float, w & 0xffff0000u); }
__device__ __forceinline__ float bf2f(bf16 b) { return __builtin_bit_cast(float, (unsigned)b << 16); }
__device__ __forceinline__ float sigmoidf_(float x) { return __builtin_amdgcn_rcpf(1.f + __builtin_amdgcn_exp2f(-1.4426950408889634f * x)); }
__device__ __forceinline__ float wave_sum(float v) {
#pragma unroll
    for (int o = 1; o < 64; o <<= 1) v += __shfl_xor(v, o);
    return v;
}

namespace pg8 {
#define PG8_LAS __attribute__((address_space(3)))
typedef unsigned short bf16_t;
constexpr int BM = 256, BK = 64, HALF = 128, HTB = HALF * BK * 2  , STAGE_BYTES = 8 * HTB, NXCD = 8, WGM = 8;
__host__ __device__ __forceinline__ int lds_byte(int r, int c) { const int st = (r >> 4) * 2 + (c >> 5), rr = r & 15, cc = c & 31, ob = rr * 64 + cc * 2; return st * 1024 + (ob ^ (((ob >> 9) & 1) << 5)); }
__host__ __device__ __forceinline__ void stage_rc(int b, int& R, int& C) { const int st = b / 1024, sb = b % 1024, swz = sb ^ (((sb >> 9) & 1) << 5); R = (st >> 1) * 16 + swz / 64; C = (st & 1) * 32 + (swz % 64) / 2; }
__host__ __device__ __forceinline__ int perm32(int rho) { const int n = rho >> 4, i = rho & 15; return 8 * (i >> 2) + 4 * n + (i & 3); }
struct Unit { int pm, pn; };
struct Gemm { const bf16_t* A; const bf16_t* Bt; int lda, ldb, K, a_pn_off; };
struct StaticOrder {
    int nM, nN, nwg, G, c;
    __host__ __device__ void init(int M, int N, int G_, int c_) { nM = M / BM; nN = N / BM; nwg = nM * nN; G = G_; c = c_; }
    __host__ __device__ bool next(int i, Unit& u) const {
        const long L = (long)i * G + c; if (L >= nwg) return false;
        int wgid = (int)L; { const int q = nwg / NXCD, r = nwg % NXCD, xcd = wgid % NXCD, off = wgid / NXCD; wgid = (xcd < r ? xcd * (q + 1) : r * (q + 1) + (xcd - r) * q) + off; }
        const int nig = WGM * nN, gid = wgid / nig, fm = gid * WGM, gsz = (nM - fm) < WGM ? (nM - fm) : WGM;
        u.pm = fm + ((wgid % nig) % gsz); u.pn = (wgid % nig) / gsz; return true;
    }
    __device__ __forceinline__ void a_ready(const Unit&) const {}
    __device__ __forceinline__ void done(const Unit&) const {}
};
#define EPI_PACK8(v0, v1) ((u32x4){cvtpk((v0)[0], (v0)[1]), cvtpk((v0)[2], (v0)[3]), cvtpk((v1)[0], (v1)[1]), cvtpk((v1)[2], (v1)[3])})
#define EPI_UNPK_LO(g) ((f32x4){bflo((g).x), bfhi((g).x), bflo((g).y), bfhi((g).y)})
#define EPI_UNPK_HI(g) ((f32x4){bflo((g).z), bfhi((g).z), bflo((g).w), bfhi((g).w)})
struct Epi1 {
    static constexpr bool PERM = true, AFTER_DRAIN = false;
    bf16_t* QLAT; float* QSS; float* KVRAW; bf16_t* SZ; float* U; bf16_t* SGA; bf16_t* SGP;
    __device__ __forceinline__ void operator()(const f32x4 (&acc)[2][2][4][2], const Unit& u, int wr, int wc, int fr, int fq) const {
        const int pn = u.pn, row0 = u.pm * BM + wr * 64 + fr, c0 = wc * 32 + 8 * fq;
        if (pn == 0) {
#pragma unroll
            for (int ai = 0; ai < 2; ++ai)
#pragma unroll
                for (int m = 0; m < 4; ++m) { const size_t row = (size_t)(row0 + ai * HALF + m * 16); float ss = 0.f;
#pragma unroll
                    for (int bj = 0; bj < 2; ++bj) { const f32x4 v0 = acc[ai][bj][m][0], v1 = acc[ai][bj][m][1];
                        ss += (v0[0] * v0[0] + v0[1] * v0[1]) + (v0[2] * v0[2] + v0[3] * v0[3]) + (v1[0] * v1[0] + v1[1] * v1[1]) + (v1[2] * v1[2] + v1[3] * v1[3]);
                        *(u32x4*)(QLAT + row * 256 + bj * HALF + c0) = EPI_PACK8(v0, v1); }
                    ss += __shfl_xor(ss, 16); ss += __shfl_xor(ss, 32);
                    if (fq == 0) QSS[row * 4 + wc] = ss; }
        } else if (pn == 1) {
#pragma unroll
            for (int ai = 0; ai < 2; ++ai)
#pragma unroll
                for (int m = 0; m < 4; ++m) { const size_t row = (size_t)(row0 + ai * HALF + m * 16);
#pragma unroll
                    for (int bj = 0; bj < 2; ++bj) { const int c = bj * HALF + c0;
                        if (c < QKD) { *(f32x4*)(KVRAW + row * QKD + c) = acc[ai][bj][m][0]; *(f32x4*)(KVRAW + row * QKD + c + 4) = acc[ai][bj][m][1]; } } }
        } else if (pn == 6 || pn == 7) {
#pragma unroll
            for (int ai = 0; ai < 2; ++ai)
#pragma unroll
                for (int m = 0; m < 4; ++m) { const size_t row = (size_t)(row0 + ai * HALF + m * 16);
#pragma unroll
                    for (int bj = 0; bj < 2; ++bj) { float* p = U + row * POOLW + (pn - 6) * 256 + bj * HALF + c0;
                        *(f32x4*)p = acc[ai][bj][m][0]; *(f32x4*)(p + 4) = acc[ai][bj][m][1]; } }
        } else {
            bf16_t* dst; int ld; bool sig;
            if (pn < 6) { dst = SZ + (pn - 2) * 256; ld = GW; sig = false; }
            else if (pn < 10) { dst = SZ + ATTW + (pn - 8) * 256; ld = GW; sig = false; }
            else if (pn < 14) { dst = SGA + (pn - 10) * 256; ld = DM; sig = true; }
            else { dst = SGP + (pn - 14) * 256; ld = DM; sig = true; }
#pragma unroll
            for (int ai = 0; ai < 2; ++ai)
#pragma unroll
                for (int m = 0; m < 4; ++m) { const size_t row = (size_t)(row0 + ai * HALF + m * 16);
#pragma unroll
                    for (int bj = 0; bj < 2; ++bj) { f32x4 v0 = acc[ai][bj][m][0], v1 = acc[ai][bj][m][1];
#pragma unroll
                        for (int e = 0; e < 4; ++e) { const float s0 = sigmoidf_(v0[e]), s1 = sigmoidf_(v1[e]); v0[e] = sig ? s0 : v0[e] * s0; v1[e] = sig ? s1 : v1[e] * s1; }
                        *(u32x4*)(dst + row * ld + bj * HALF + c0) = EPI_PACK8(v0, v1); } }
        }
    }
};
struct Epi2 {
    static constexpr bool PERM = true, AFTER_DRAIN = false;
    bf16_t* QA; bf16_t* QR; const float* QSS; const float* ROPET;
    __device__ __forceinline__ void operator()(const f32x4 (&acc)[2][2][4][2], const Unit& u, int wr, int wc, int fr, int fq) const {
        const int pn = u.pn, row0 = u.pm * BM + wr * 64 + fr, c0 = wc * 32 + 8 * fq;
#pragma unroll
        for (int ai = 0; ai < 2; ++ai)
#pragma unroll
            for (int m = 0; m < 4; ++m) { const size_t row = (size_t)(row0 + ai * HALF + m * 16);
                const f32x4 q4 = *(const f32x4*)(QSS + row * 4);
                const float s = C2 * __builtin_amdgcn_rsqf(((q4[0] + q4[1]) + (q4[2] + q4[3])) * (1.f / QRANK) + EPS);
                if (pn < 4) {
#pragma unroll
                    for (int bj = 0; bj < 2; ++bj) { const f32x4 v0 = acc[ai][bj][m][0] * s, v1 = acc[ai][bj][m][1] * s;
                        *(u32x4*)(QA + row * ATTW + pn * 256 + bj * HALF + c0) = EPI_PACK8(v0, v1); }
                } else {
                    const int pos = row < SEQ ? (int)row : SEQ;
                    const float* rp = ROPET + ((size_t)pos * 32 + 8 * fq) * 2;
                    bf16_t* q = QR + row * (NH * ROPE) + (4 * (pn - 4) + wc) * ROPE + 8 * fq;
#pragma unroll
                    for (int n = 0; n < 2; ++n) {
                        const f32x4 t0 = *(const f32x4*)(rp + 8 * n), t1 = *(const f32x4*)(rp + 8 * n + 4);
                        const f32x4 a = acc[ai][0][m][n], b = acc[ai][1][m][n];
                        u32x2 lo, hi2;
                        lo.x = cvtpk((a[0] * t0[0] - b[0] * t0[1]) * s, (a[1] * t0[2] - b[1] * t0[3]) * s); lo.y = cvtpk((a[2] * t1[0] - b[2] * t1[1]) * s, (a[3] * t1[2] - b[3] * t1[3]) * s);
                        hi2.x = cvtpk((b[0] * t0[0] + a[0] * t0[1]) * s, (b[1] * t0[2] + a[1] * t0[3]) * s); hi2.y = cvtpk((b[2] * t1[0] + a[2] * t1[1]) * s, (b[3] * t1[2] + a[3] * t1[3]) * s);
                        *(u32x2*)(q + 4 * n) = lo; *(u32x2*)(q + 32 + 4 * n) = hi2; }
                }
                if (m & 1) __builtin_amdgcn_sched_barrier(0);
            }
    }
};
struct Epi5 {
    static constexpr bool PERM = true, AFTER_DRAIN = false;
    bf16_t* G12; const bf16_t* SZ; const float* pool_scale;
    __device__ __forceinline__ void operator()(const f32x4 (&acc)[2][2][4][2], const Unit& u, int wr, int wc, int fr, int fq) const {
        const int pn = u.pn, row0 = u.pm * BM + wr * 64 + fr, c0 = wc * 32 + 8 * fq;
#pragma unroll
        for (int bj = 0; bj < 2; ++bj) { const int c = pn * 256 + bj * HALF + c0;
            f32x4 p0 = {1.f, 1.f, 1.f, 1.f}, p1 = p0;
            if (pn >= 4) { p0 = *(const f32x4*)(pool_scale + c - ATTW); p1 = *(const f32x4*)(pool_scale + c - ATTW + 4); }
#pragma unroll
            for (int ai = 0; ai < 2; ++ai)
#pragma unroll
                for (int m = 0; m < 4; ++m) { const size_t row = (size_t)(row0 + ai * HALF + m * 16);
                    const u32x4 g = *(const u32x4*)(SZ + row * GW + c);
                    const f32x4 v0 = acc[ai][bj][m][0] * p0 * EPI_UNPK_LO(g), v1 = acc[ai][bj][m][1] * p1 * EPI_UNPK_HI(g);
                    *(u32x4*)(G12 + row * GW + c) = EPI_PACK8(v0, v1); } }
    }
};
template <bool SECOND> struct Epi6 {
    static constexpr bool PERM = true, AFTER_DRAIN = false;
    float* M1; bf16_t* MG; const bf16_t* SG;
    __device__ __forceinline__ void operator()(const f32x4 (&acc)[2][2][4][2], const Unit& u, int wr, int wc, int fr, int fq) const {
        const int pn = u.pn, row0 = u.pm * BM + wr * 64 + fr, c0 = wc * 32 + 8 * fq;
#pragma unroll
        for (int ai = 0; ai < 2; ++ai)
#pragma unroll
            for (int m = 0; m < 4; ++m) { const size_t row = (size_t)(row0 + ai * HALF + m * 16);
#pragma unroll
                for (int bj = 0; bj < 2; ++bj) { const size_t o = row * DM + pn * 256 + bj * HALF + c0;
                    const u32x4 g = *(const u32x4*)(SG + o);
                    f32x4 v0 = acc[ai][bj][m][0] * EPI_UNPK_LO(g), v1 = acc[ai][bj][m][1] * EPI_UNPK_HI(g);
                    if (!SECOND) { *(f32x4*)(M1 + o) = v0; *(f32x4*)(M1 + o + 4) = v1; }
                    else { v0 += *(const f32x4*)(M1 + o); v1 += *(const f32x4*)(M1 + o + 4); *(u32x4*)(MG + o) = EPI_PACK8(v0, v1); } } }
    }
};
struct Epi7 {
    static constexpr bool PERM = true, AFTER_DRAIN = false;
    const float* xp; const float* xs; float* out;
    __device__ __forceinline__ void operator()(const f32x4 (&acc)[2][2][4][2], const Unit& u, int wr, int wc, int fr, int fq) const {
        const int pn = u.pn, row0 = u.pm * BM + wr * 64 + fr, c0 = wc * 32 + 8 * fq;
#pragma unroll
        for (int ai = 0; ai < 2; ++ai)
#pragma unroll
            for (int m = 0; m < 4; ++m) { const int row = row0 + ai * HALF + m * 16;
                if (row < MTOT) {
                    const float* x = row < SEQ ? xp + (size_t)row * DM : xs + (size_t)(row - SEQ) * DM;
                    float* y = row < SEQ ? out + O_YP + (size_t)row * DM : out + O_YS + (size_t)(row - SEQ) * DM;
#pragma unroll
                    for (int bj = 0; bj < 2; ++bj) { const int c = pn * 256 + bj * HALF + c0;
                        *(f32x4*)(y + c) = *(const f32x4*)(x + c) + acc[ai][bj][m][0]; *(f32x4*)(y + c + 4) = *(const f32x4*)(x + c + 4) + acc[ai][bj][m][1]; } } }
    }
};
template <class Epi, class Sched, bool ALIGN_EPI = false, bool SP2 = false>
__device__ __forceinline__ void gemm_phase(PG8_LAS unsigned char* lds, const Gemm g, const Sched& S, const Epi& E) {
    int tid_ = threadIdx.x; asm volatile("" : "+v"(tid_));
    const int tid = tid_, wid = __builtin_amdgcn_readfirstlane(tid >> 6), lane = tid & 63, wr = wid >> 2, wc = wid & 3, fr = lane & 15, fq = lane >> 4;
    const int K = g.K, nt = K / BK;
    unsigned voffA[2], voffB[2];
#pragma unroll
    for (int i = 0; i < 2; ++i) { int R, C; stage_rc(tid * 16 + i * 8192, R, C); const int Rb = Epi::PERM ? ((R & ~31) + perm32(R & 31)) : R;
        voffA[i] = (unsigned)(R * g.lda + C) * 2u; voffB[i] = (unsigned)(Rb * g.ldb + C) * 2u; }
    const size_t kstep = (size_t)(BK * 2);
    const size_t hA = (size_t)HALF * g.lda * 2, hB = (size_t)HALF * g.ldb * 2;
    const size_t tA = 2 * hA, tB = 2 * hB, pA = (size_t)g.a_pn_off * 2;
    const unsigned ldsw = (unsigned)wid * 1024u;
    const int aoff = lds_byte(wr * 64 + fr, fq * 8), boff = lds_byte(wc * 32 + fr, fq * 8);
#define PG8_SA(b, h) (((b) * 2 + (h)) * HTB)
#define PG8_SB(b, h) ((4 + (b) * 2 + (h)) * HTB)
#define PG8_STAGE(bufoff, gbase, voff) do { _Pragma("unroll") for (int _i = 0; _i < 2; ++_i) \
        __builtin_amdgcn_global_load_lds((const unsigned*)((const char*)(gbase) + (voff)[_i]), (PG8_LAS unsigned*)(lds + (bufoff) + ldsw + _i * 8192), 16, 0, 0); } while (0)
#define PG8_LDA(dst, b, h) do { _Pragma("unroll") for (int m = 0; m < 4; ++m) _Pragma("unroll") for (int k = 0; k < 2; ++k) dst[m][k] = *(const PG8_LAS bf16x8*)(lds + PG8_SA(b, h) + aoff + m * 2048 + k * 1024); } while (0)
#define PG8_LDB(dst, b, h) do { _Pragma("unroll") for (int n = 0; n < 2; ++n) _Pragma("unroll") for (int k = 0; k < 2; ++k) dst[n][k] = *(const PG8_LAS bf16x8*)(lds + PG8_SB(b, h) + boff + n * 2048 + k * 1024); } while (0)
#define PG8_MMA(ai, bj, At, Bt) do { __builtin_amdgcn_s_setprio(1); _Pragma("unroll") for (int m = 0; m < 4; ++m) _Pragma("unroll") for (int n = 0; n < 2; ++n) _Pragma("unroll") for (int k = 0; k < 2; ++k) \
        acc[ai][bj][m][n] = __builtin_amdgcn_mfma_f32_16x16x32_bf16(Bt[n][k], At[m][k], acc[ai][bj][m][n], 0, 0, 0); __builtin_amdgcn_s_setprio(0); } while (0)
#define PG8_WAIT_V(n) asm volatile("s_waitcnt vmcnt(" #n ")" ::: "memory")
#define PG8_WAIT_L(n) asm volatile("s_waitcnt lgkmcnt(" #n ")" ::: "memory")
#define PG8_BAR __builtin_amdgcn_s_barrier()
#define PG8_SCHED __builtin_amdgcn_sched_barrier(0)
    Unit cur, nxt; int ui = 0;
    if (!S.next(0, cur)) return;
    f32x4 acc[2][2][4][2];
#pragma unroll
    for (int a = 0; a < 2; ++a)
#pragma unroll
        for (int b = 0; b < 2; ++b)
#pragma unroll
            for (int m = 0; m < 4; ++m)
#pragma unroll
                for (int n = 0; n < 2; ++n) acc[a][b][m][n] = (f32x4){0.f, 0.f, 0.f, 0.f};
    bf16x8 At[4][2], B0[2][2], B1[2][2];
    const char* cA = (const char*)g.A + (size_t)cur.pm * tA + (size_t)cur.pn * pA; const char* cB = (const char*)g.Bt + (size_t)cur.pn * tB;
    S.a_ready(cur);
    if constexpr (SP2) {
        PG8_STAGE(PG8_SB(0, 0), cB, voffB); PG8_STAGE(PG8_SB(0, 1), cB + hB, voffB); PG8_STAGE(PG8_SA(0, 0), cA, voffA); PG8_STAGE(PG8_SA(0, 1), cA + hA, voffA);
        if (wr == 1) PG8_BAR;
        PG8_WAIT_V(2); PG8_BAR;
        PG8_STAGE(PG8_SB(1, 0), cB + kstep, voffB); PG8_STAGE(PG8_SA(1, 0), cA + kstep, voffA); PG8_STAGE(PG8_SB(1, 1), cB + hB + kstep, voffB);
        PG8_WAIT_V(6); PG8_BAR;
    } else {
        PG8_STAGE(PG8_SB(0, 0), cB, voffB); PG8_STAGE(PG8_SA(0, 0), cA, voffA); PG8_STAGE(PG8_SB(0, 1), cB + hB, voffB); PG8_STAGE(PG8_SA(0, 1), cA + hA, voffA);
        if (wr == 1) PG8_BAR;
        PG8_WAIT_V(4); PG8_BAR;
        PG8_STAGE(PG8_SB(1, 0), cB + kstep, voffB); PG8_STAGE(PG8_SA(1, 0), cA + kstep, voffA); PG8_STAGE(PG8_SB(1, 1), cB + hB + kstep, voffB);
        PG8_WAIT_V(6); PG8_BAR;
    }
    for (;;) {
        const bool has_next = S.next(ui + 1, nxt);
        const char* nA = has_next ? (const char*)g.A + (size_t)nxt.pm * tA + (size_t)nxt.pn * pA : cA; const char* nB = has_next ? (const char*)g.Bt + (size_t)nxt.pn * tB : cB;
        for (int t = 0; t < nt; t += 2) {
            const bool last = (t == nt - 2);
            const char* a1 = cA + (size_t)(t + 1) * kstep;
            const char* a2 = last ? nA : cA + (size_t)(t + 2) * kstep; const char* b2 = last ? nB : cB + (size_t)(t + 2) * kstep;
            const char* a3 = a2 + kstep; const char* b3 = b2 + kstep;
            if (last && has_next) S.a_ready(nxt);
            if constexpr (SP2) {
            PG8_LDB(B0, 0, 0); PG8_LDB(B1, 0, 1); PG8_SCHED; PG8_LDA(At, 0, 0); PG8_STAGE(PG8_SA(1, 1), a1 + hA, voffA);
            PG8_WAIT_V(8); PG8_WAIT_L(0); PG8_BAR; PG8_MMA(0, 0, At, B0); PG8_MMA(0, 1, At, B1); PG8_BAR; PG8_SCHED;
            PG8_LDA(At, 0, 1); PG8_STAGE(PG8_SB(0, 0), b2, voffB); PG8_STAGE(PG8_SB(0, 1), b2 + hB, voffB); PG8_STAGE(PG8_SA(0, 0), a2, voffA);
            PG8_WAIT_V(8); PG8_WAIT_L(0); PG8_BAR; PG8_MMA(1, 0, At, B0); PG8_MMA(1, 1, At, B1); PG8_BAR; PG8_SCHED;
            PG8_LDB(B0, 1, 0); PG8_LDB(B1, 1, 1); PG8_SCHED; PG8_LDA(At, 1, 0); PG8_STAGE(PG8_SA(0, 1), a2 + hA, voffA);
            PG8_WAIT_V(8); PG8_WAIT_L(0); PG8_BAR; PG8_MMA(0, 0, At, B0); PG8_MMA(0, 1, At, B1); PG8_BAR; PG8_SCHED;
            PG8_LDA(At, 1, 1); PG8_STAGE(PG8_SB(1, 0), b3, voffB); PG8_STAGE(PG8_SB(1, 1), b3 + hB, voffB); PG8_STAGE(PG8_SA(1, 0), a3, voffA);
            PG8_WAIT_V(8); PG8_WAIT_L(0); PG8_BAR; PG8_MMA(1, 0, At, B0); PG8_MMA(1, 1, At, B1); PG8_BAR; PG8_SCHED;
            } else {
            PG8_LDB(B0, 0, 0); PG8_SCHED; PG8_LDA(At, 0, 0); PG8_STAGE(PG8_SA(1, 1), a1 + hA, voffA);
            PG8_WAIT_L(8); PG8_BAR; PG8_WAIT_L(0); PG8_MMA(0, 0, At, B0); PG8_BAR; PG8_SCHED;
            PG8_LDB(B1, 0, 1); PG8_STAGE(PG8_SB(0, 0), b2, voffB);
            PG8_BAR; PG8_WAIT_L(0); PG8_MMA(0, 1, At, B1); PG8_BAR;
            PG8_LDA(At, 0, 1); PG8_STAGE(PG8_SA(0, 0), a2, voffA);
            PG8_BAR; PG8_WAIT_L(0); PG8_MMA(1, 0, At, B0); PG8_BAR; PG8_SCHED;
            PG8_STAGE(PG8_SB(0, 1), b2 + hB, voffB);
            PG8_WAIT_V(6); PG8_BAR; PG8_MMA(1, 1, At, B1); PG8_BAR;
            PG8_LDB(B0, 1, 0); PG8_SCHED; PG8_LDA(At, 1, 0); PG8_STAGE(PG8_SA(0, 1), a2 + hA, voffA);
            PG8_WAIT_L(8); PG8_BAR; PG8_WAIT_L(0); PG8_MMA(0, 0, At, B0); PG8_BAR; PG8_SCHED;
            PG8_LDB(B1, 1, 1); PG8_STAGE(PG8_SB(1, 0), b3, voffB);
            PG8_BAR; PG8_WAIT_L(0); PG8_MMA(0, 1, At, B1); PG8_BAR;
            PG8_LDA(At, 1, 1); PG8_STAGE(PG8_SA(1, 0), a3, voffA);
            PG8_BAR; PG8_WAIT_L(0); PG8_MMA(1, 0, At, B0); PG8_BAR; PG8_SCHED;
            PG8_STAGE(PG8_SB(1, 1), b3 + hB, voffB);
            PG8_WAIT_V(6); PG8_BAR; PG8_MMA(1, 1, At, B1); PG8_BAR;
            }
        }
        if constexpr (ALIGN_EPI) { if (wr == 0) PG8_BAR; }
        if constexpr (!Epi::AFTER_DRAIN) { int l_; asm volatile("v_mbcnt_lo_u32_b32 %0, -1, 0\n\tv_mbcnt_hi_u32_b32 %0, -1, %0" : "=v"(l_));
            E(acc, cur, wr, wc, l_ & 15, l_ >> 4); S.done(cur); }
        if (!has_next) break;
#pragma unroll
        for (int a = 0; a < 2; ++a)
#pragma unroll
            for (int b = 0; b < 2; ++b)
#pragma unroll
                for (int m = 0; m < 4; ++m)
#pragma unroll
                    for (int n = 0; n < 2; ++n) acc[a][b][m][n] = (f32x4){0.f, 0.f, 0.f, 0.f};
        cur = nxt; cA = nA; cB = nB; ++ui;
        if constexpr (ALIGN_EPI) { if (wr == 1) PG8_BAR; }
    }
    PG8_WAIT_V(0);
    if constexpr (!ALIGN_EPI) { if (wr == 0) PG8_BAR; }
    PG8_BAR;
    if constexpr (Epi::AFTER_DRAIN) { E.fused(acc, cur, wr, wc, fr, fq, lds, wid, lane); S.done(cur); }
#undef PG8_SA
#undef PG8_SB
#undef PG8_STAGE
#undef PG8_LDA
#undef PG8_LDB
#undef PG8_MMA
#undef PG8_WAIT_V
#undef PG8_WAIT_L
#undef PG8_BAR
#undef PG8_SCHED
}
}
namespace att {
constexpr int SHM_K = 64 * 384, SHM_V = 64 * 256;
constexpr int L_V = 0, L_K = 2 * SHM_V, L_WS = L_K + 2 * SHM_K, L_QR = L_WS + NWAVES * 256, LDS_NEED = L_QR + NWAVES * 4096;
constexpr int DROW = 400, DIMG = 32 * DROW;
static_assert(LDS_NEED <= RING_BYTES && NWAVES * DIMG + 12 * 17 * 16 <= RING_BYTES, "attention LDS");
constexpr float THR2 = 8.f * 1.4426950408889634f;
__device__ __forceinline__ int crow(int r, int hi) { return (r & 3) + 8 * (r >> 2) + 4 * hi; }
__device__ __forceinline__ int v_st(int k, int c) { const int kk = (k & ~0xC) | ((k & 4) << 1) | ((k & 8) >> 1); return ((kk >> 3) * 4 + (c >> 5)) * 512 + ((kk & 7) * 32 + (c & 31)) * 2; }
__device__ __forceinline__ int v_rd_base(int lane) { return ((lane & 3) << 3) | (((lane >> 2) & 3) << 6) | (((lane >> 4) & 1) << 5) | (((lane >> 5) & 1) << 8); }
constexpr int v_rd_off(int d0, int ks, int half) { return d0 * 512 + ks * 4096 + half * 2048; }
__device__ __forceinline__ float pl_swap_max(float v) { auto rr = __builtin_amdgcn_permlane32_swap(__float_as_uint(v), __float_as_uint(v), false, false); return fmaxf(__uint_as_float(rr[0]), __uint_as_float(rr[1])); }
__device__ __forceinline__ float pl_swap_add(float v) { auto rr = __builtin_amdgcn_permlane32_swap(__float_as_uint(v), __float_as_uint(v), false, false); return __uint_as_float(rr[0]) + __uint_as_float(rr[1]); }
#define ATT_PK4(P, B_, OUT) do { unsigned a0 = cvtpk(P[B_+0], P[B_+1]), a1 = cvtpk(P[B_+2], P[B_+3]);                          \
        unsigned b0 = cvtpk(P[B_+4], P[B_+5]), b1 = cvtpk(P[B_+6], P[B_+7]);                                             \
        auto r0 = __builtin_amdgcn_permlane32_swap(a0, b0, false, false); auto r1 = __builtin_amdgcn_permlane32_swap(a1, b1, false, false); \
        u32x4 w = {r0[0], r1[0], r0[1], r1[1]}; OUT = __builtin_bit_cast(bf16x8, w); } while (0)
#define ATT_TRRD(dst, addr, off) asm volatile("ds_read_b64_tr_b16 %0, %1 offset:%2" : "=&v"(dst) : "v"(addr), "i"(off) : "memory")
#define ATT_PK(L, H) ((bf16x8){L[0], L[1], L[2], L[3], H[0], H[1], H[2], H[3]})

__device__ __forceinline__ void mask_tile(f32x16& p0, f32x16& p1, int dq) {
    const float NEG = -__builtin_inff();
#pragma unroll
    for (int r = 0; r < 16; ++r) { const int c = (r & 3) + 8 * (r >> 2);
        if (dq - c < 0) p0[r] = NEG;
        if (dq - c - 32 < 0) p1[r] = NEG; }
}
__device__ __forceinline__ void partialSM(f32x16& p0, f32x16& p1, float& m_reg, float& alpha) {
    float pmax = p0[0];
#pragma unroll
    for (int r = 1; r < 16; ++r) pmax = fmaxf(pmax, p0[r]);
#pragma unroll
    for (int r = 0; r < 16; ++r) pmax = fmaxf(pmax, p1[r]);
    pmax = pl_swap_max(pmax);
    float mn;
    if (__builtin_expect(__all(pmax - m_reg <= THR2), 1)) { mn = m_reg; alpha = 1.f; }
    else { mn = fmaxf(m_reg, pmax); alpha = __builtin_amdgcn_exp2f(m_reg - mn); m_reg = mn; }
#pragma unroll
    for (int r = 0; r < 16; ++r) p0[r] = __builtin_amdgcn_exp2f(p0[r] - mn);
#pragma unroll
    for (int r = 0; r < 16; ++r) p1[r] = p1[r] - mn;
}
__device__ __forceinline__ void finishSM(f32x16& p0, f32x16& p1, float alpha, float& l_reg, bf16x8& pa0, bf16x8& pa1, bf16x8& pa2, bf16x8& pa3) {
#pragma unroll
    for (int r = 0; r < 16; ++r) p1[r] = __builtin_amdgcn_exp2f(p1[r]);
    float ps = 0.f;
#pragma unroll
    for (int r = 0; r < 16; ++r) ps += p0[r];
#pragma unroll
    for (int r = 0; r < 16; ++r) ps += p1[r];
    ps = pl_swap_add(ps);
    l_reg = l_reg * alpha + ps;
    ATT_PK4(p0, 0, pa0); ATT_PK4(p0, 8, pa1); ATT_PK4(p1, 0, pa2); ATT_PK4(p1, 8, pa3);
}
template <int KB>
__device__ __forceinline__ void qkt(f32x16& p0, f32x16& p1, const LAS unsigned char* lds, int r32, int hi, const bf16x8* qr, const LAS unsigned char* qlds) {
    p0 = f32x16{}; p1 = f32x16{};
    const int sw = ((r32 >> 1) & 7) << 4;
    const LAS unsigned char* kb[4];
#pragma unroll
    for (int dd = 0; dd < 4; ++dd) kb[dd] = lds + L_K + KB * SHM_K + r32 * 384 + ((dd * 32 + hi * 16) ^ sw);
#pragma unroll
    for (int d0 = 0; d0 < 12; ++d0) { const LAS unsigned char* a = kb[d0 & 3] + (d0 >> 2) * 128;
        const bf16x8 b0 = *(const LAS bf16x8*)a, b1 = *(const LAS bf16x8*)(a + 32 * 384);
        const bf16x8 qf = d0 < 8 ? qr[d0 & 7] : *(const LAS bf16x8*)(qlds + (d0 - 8) * 1024);
        p0 = __builtin_amdgcn_mfma_f32_32x32x16_bf16(b0, qf, p0, 0, 0, 0);
        p1 = __builtin_amdgcn_mfma_f32_32x32x16_bf16(b1, qf, p1, 0, 0, 0); }
}
template <int VB>
__device__ __forceinline__ void pv_tile(f32x16* o, int vb0, bf16x8 pa0, bf16x8 pa1, bf16x8 pa2, bf16x8 pa3) {
#define ATT_PV_D0(d0) do { s16x4 l0, l1, l2, l3, h0, h1, h2, h3; constexpr int b_ = L_V + VB * SHM_V + v_rd_off(d0, 0, 0); \
        ATT_TRRD(l0, vb0, b_); ATT_TRRD(h0, vb0, b_ + 2048); ATT_TRRD(l1, vb0, b_ + 4096); ATT_TRRD(h1, vb0, b_ + 6144); ATT_TRRD(l2, vb0, b_ + 8192); ATT_TRRD(h2, vb0, b_ + 10240); ATT_TRRD(l3, vb0, b_ + 12288); ATT_TRRD(h3, vb0, b_ + 14336); \
        asm volatile("s_waitcnt lgkmcnt(0)" ::: "memory"); SBAR(); \
        o[d0] = __builtin_amdgcn_mfma_f32_32x32x16_bf16(pa0, ATT_PK(l0, h0), o[d0], 0, 0, 0); \
        o[d0] = __builtin_amdgcn_mfma_f32_32x32x16_bf16(pa1, ATT_PK(l1, h1), o[d0], 0, 0, 0); \
        o[d0] = __builtin_amdgcn_mfma_f32_32x32x16_bf16(pa2, ATT_PK(l2, h2), o[d0], 0, 0, 0); \
        o[d0] = __builtin_amdgcn_mfma_f32_32x32x16_bf16(pa3, ATT_PK(l3, h3), o[d0], 0, 0, 0); } while (0)
    ATT_PV_D0(0); ATT_PV_D0(1); ATT_PV_D0(2); ATT_PV_D0(3);
#undef ATT_PV_D0
}

__device__ __forceinline__ void prompt_unit(int q0, const bf16* __restrict__ QA, const bf16* __restrict__ QR, const bf16* __restrict__ KBm, bf16* __restrict__ OL, LAS unsigned char* lds, int tid, int wid, int lane) {
    const int r32 = lane & 31, hi = lane >> 5;
    const int NT = (q0 >> 6) + 1;
    bf16x8 qr[8];
    LAS unsigned char* qlds = lds + L_QR + wid * 4096 + lane * 16;
    { const bf16* qa = QA + (size_t)(q0 + r32) * ATTW + wid * NOPE + hi * 8; const bf16* qq = QR + (size_t)(q0 + r32) * (NH * ROPE) + wid * ROPE + hi * 8;
#pragma unroll
      for (int d0 = 0; d0 < 8; ++d0) qr[d0] = *(const bf16x8*)(qa + d0 * 16);
#pragma unroll
      for (int d0 = 0; d0 < 4; ++d0) *(LAS bf16x8*)(qlds + d0 * 1024) = *(const bf16x8*)(qq + d0 * 16); }
    LAS float* wsf = (LAS float*)(lds + L_WS) + wid * 64; LAS float* li_l = wsf; LAS float* al_l = wsf + 32;
    float m_reg = -1e30f, l_reg = 0.f; f32x16 o[4] = {};
    const int skey = tid >> 3, sc8 = tid & 7;
    const int kw0 = skey * 384 + ((sc8 * 16) ^ (((skey >> 1) & 7) << 4));
    const int vw0 = v_st(skey, sc8 * 8);
    const int vb0 = (int)(uintptr_t)lds + v_rd_base(lane);
    const int qm = q0 + r32 - 4 * hi;
    const bf16* ksrc = KBm + (size_t)skey * QKD + sc8 * 8;
    bf16x8 st0, st1, st2;
#define ATT_SLOAD(t) do { const bf16* p_ = ksrc + (size_t)(t) * (64 * QKD); st0 = *(const bf16x8*)p_; st1 = *(const bf16x8*)(p_ + 64); st2 = *(const bf16x8*)(p_ + 128); } while (0)
#define ATT_SWRITE(bf) do { LAS unsigned char* k_ = lds + L_K + (bf) * SHM_K + kw0; *(LAS bf16x8*)k_ = st0; *(LAS bf16x8*)(k_ + 128) = st1; *(LAS bf16x8*)(k_ + 256) = st2; \
        LAS unsigned char* v_ = lds + L_V + (bf) * SHM_V + vw0; *(LAS bf16x8*)v_ = st0; *(LAS bf16x8*)(v_ + 1024) = st1; } while (0)
#define ATT_RESC(a) do { if (__any((a) < 1.f)) { if (hi == 0) al_l[r32] = (a); LDS_WAIT(); \
        _Pragma("unroll") for (int d_ = 0; d_ < 4; ++d_) _Pragma("unroll") for (int r = 0; r < 16; ++r) o[d_][r] *= al_l[crow(r, hi)]; } } while (0)
#define ATT_MASKT(P0_, P1_, t) do { if ((t) == NT - 1) mask_tile(P0_, P1_, qm - 64 * (t)); } while (0)
    f32x16 pA0, pA1, pB0, pB1; float alA, alB; bf16x8 pa0, pa1, pa2, pa3;
    ATT_SLOAD(0); VM_WAIT(); ATT_SWRITE(0); SBAR();
    if (NT > 1) ATT_SLOAD(1);
    __syncthreads();
    SBAR(); qkt<0>(pA0, pA1, lds, r32, hi, qr, qlds);
    ATT_MASKT(pA0, pA1, 0); partialSM(pA0, pA1, m_reg, alA);
    if (NT > 1) { VM_WAIT(); ATT_SWRITE(1); }
    __syncthreads();
#define ATT_HALF_STEP(PX0, PX1, alX, PY0, PY1, alY, t, KB, VB, SB) do {                                          \
        SBAR(); qkt<KB>(PX0, PX1, lds, r32, hi, qr, qlds);                                                         \
        finishSM(PY0, PY1, alY, l_reg, pa0, pa1, pa2, pa3); SBAR();                                              \
        if ((t) + 1 < NT) { ATT_SLOAD((t) + 1); SBAR(); }                                                        \
        pv_tile<VB>(o, vb0, pa0, pa1, pa2, pa3); ATT_MASKT(PX0, PX1, (t)); partialSM(PX0, PX1, m_reg, alX);      \
        __syncthreads();                                                                                         \
        if ((t) + 1 < NT) { VM_WAIT(); ATT_SWRITE(SB); }                                                         \
        ATT_RESC(alX); __syncthreads(); } while (0)
    for (int t = 1; t + 1 < NT; t += 2) {
        ATT_HALF_STEP(pB0, pB1, alB, pA0, pA1, alA, t, 1, 0, 0);
        ATT_HALF_STEP(pA0, pA1, alA, pB0, pB1, alB, t + 1, 0, 1, 1);
    }
    const bool even = (NT & 1) == 0;
    if (even) { SBAR(); qkt<1>(pB0, pB1, lds, r32, hi, qr, qlds); SBAR(); }
    finishSM(pA0, pA1, alA, l_reg, pa0, pa1, pa2, pa3); SBAR();
    pv_tile<0>(o, vb0, pa0, pa1, pa2, pa3);
    if (even) { ATT_MASKT(pB0, pB1, NT - 1); partialSM(pB0, pB1, m_reg, alB); ATT_RESC(alB);
        finishSM(pB0, pB1, alB, l_reg, pa0, pa1, pa2, pa3); SBAR(); pv_tile<1>(o, vb0, pa0, pa1, pa2, pa3); }
    if (hi == 0) li_l[r32] = l_reg; LDS_WAIT();
    float rli[16];
#pragma unroll
    for (int r = 0; r < 16; ++r) rli[r] = __builtin_amdgcn_rcpf(li_l[crow(r, hi)]);
    bf16* Ow = OL + (size_t)q0 * GW + wid * VD;
#pragma unroll
    for (int r = 0; r < 16; ++r) { const int orow = crow(r, hi);
#pragma unroll
        for (int d0 = 0; d0 < 4; ++d0) { const float v = o[d0][r] * rli[r]; const float vn = __shfl_xor(v, 1);
            if ((r32 & 1) == 0) *(unsigned*)(Ow + (size_t)orow * GW + d0 * 32 + r32) = cvtpk(v, vn); } }
    __syncthreads();
#undef ATT_SLOAD
#undef ATT_SWRITE
#undef ATT_RESC
#undef ATT_MASKT
#undef ATT_HALF_STEP
}

__device__ __forceinline__ void decode_item(int item, const float* __restrict__ cckv, const float* __restrict__ ckr, const int* __restrict__ ptab, const bf16* __restrict__ QA, const bf16* __restrict__ QR,
                                            float* __restrict__ DPART, LAS unsigned char* lds, int tid, int wid, int lane) {
    const int b = item >> 1, half = item & 1, r32 = lane & 31, hi = lane >> 5;
    constexpr int QOFF = NWAVES * DIMG, QSTR = 17 * 16;
    if (wid == 0) { const size_t qrow = (size_t)(SEQ + b);
        if (r32 < 8) { const bf16* qa = QA + qrow * ATTW + r32 * NOPE + hi * 8; const bf16* qq = QR + qrow * (NH * ROPE) + r32 * ROPE + hi * 8; LAS unsigned char* d = lds + QOFF + (hi * 8 + r32) * 16;
#pragma unroll
            for (int d0 = 0; d0 < 8; ++d0) *(LAS bf16x8*)(d + d0 * QSTR) = *(const bf16x8*)(qa + d0 * 16);
#pragma unroll
            for (int d0 = 0; d0 < 4; ++d0) *(LAS bf16x8*)(d + (8 + d0) * QSTR) = *(const bf16x8*)(qq + d0 * 16); }
        else if (lane == 8) { const bf16x8 z = {0, 0, 0, 0, 0, 0, 0, 0};
#pragma unroll
            for (int d0 = 0; d0 < 12; ++d0) *(LAS bf16x8*)(lds + QOFF + 256 + d0 * QSTR) = z; } }
    __syncthreads();
    const LAS unsigned char* qsl = lds + QOFF + (r32 < 8 ? (hi * 8 + r32) * 16 : 256);
    LAS unsigned char* img = lds + wid * DIMG;
    const int kaddr = r32 * DROW + 16 * hi;
    const int vaddr = (int)(uintptr_t)img + (8 * (lane >> 5) + ((lane >> 2) & 3)) * DROW + (16 * ((lane >> 4) & 1) + 4 * (lane & 3)) * 2;
    const int woA = (lane >> 5) * DROW + (lane & 31) * 8, woB = (lane >> 4) * DROW + 256 + (lane & 15) * 8;
    float m_reg = -1e30f, l_reg = 0.f; f32x16 o[4] = {};
    f32x4 sa[16], sb[8];
#define DEC_LOAD(s_) do { const int pg_ = 64 * half + wid + 8 * ((s_) >> 2); const int phys_ = __builtin_amdgcn_readfirstlane(ptab[b * NPG + pg_]); \
        const float* pc_ = cckv + (size_t)phys_ * (PAGE * KVR) + ((s_) & 3) * (32 * KVR) + lane * 4; const float* pk_ = ckr + (size_t)phys_ * (PAGE * ROPE) + ((s_) & 3) * (32 * ROPE) + lane * 4; \
        _Pragma("unroll") for (int i = 0; i < 16; ++i) sa[i] = __builtin_nontemporal_load((const f32x4*)(pc_ + i * 256)); \
        _Pragma("unroll") for (int i = 0; i < 8; ++i) sb[i] = __builtin_nontemporal_load((const f32x4*)(pk_ + i * 256)); } while (0)
    DEC_LOAD(0);
    for (int s = 0; s < 32; ++s) {
#pragma unroll
        for (int i = 0; i < 16; ++i) *(LAS u32x2*)(img + woA + i * (2 * DROW)) = (u32x2){cvtpk(sa[i][0], sa[i][1]), cvtpk(sa[i][2], sa[i][3])};
#pragma unroll
        for (int i = 0; i < 8; ++i) *(LAS u32x2*)(img + woB + i * (4 * DROW)) = (u32x2){cvtpk(sb[i][0], sb[i][1]), cvtpk(sb[i][2], sb[i][3])};
        SBAR();
        if (s + 1 < 32) DEC_LOAD(s + 1);
        SBAR();
        f32x16 p0 = {};
#pragma unroll
        for (int d0 = 0; d0 < 12; ++d0) { const bf16x8 a = *(const LAS bf16x8*)(img + kaddr + 32 * d0); const bf16x8 qf = *(const LAS bf16x8*)(qsl + d0 * QSTR); p0 = __builtin_amdgcn_mfma_f32_32x32x16_bf16(a, qf, p0, 0, 0, 0); }
        float pmax = p0[0];
#pragma unroll
        for (int r = 1; r < 16; ++r) pmax = fmaxf(pmax, p0[r]);
        pmax = pl_swap_max(pmax);
        float mn, alpha;
        if (__builtin_expect(__all(pmax - m_reg <= THR2), 1)) { mn = m_reg; alpha = 1.f; }
        else { mn = fmaxf(m_reg, pmax); alpha = __builtin_amdgcn_exp2f(m_reg - mn); m_reg = mn; }
        float ps = 0.f;
#pragma unroll
        for (int r = 0; r < 16; ++r) { p0[r] = __builtin_amdgcn_exp2f(p0[r] - mn); ps += p0[r]; }
        ps = pl_swap_add(ps);
        l_reg = l_reg * alpha + ps;
        bf16x8 pa0, pa1; ATT_PK4(p0, 0, pa0); ATT_PK4(p0, 8, pa1);
        if (__any(alpha < 1.f)) {
#pragma unroll
            for (int r = 0; r < 4; ++r) { const float a = __shfl(alpha, r + 4 * hi);
#pragma unroll
                for (int d = 0; d < 4; ++d) o[d][r] *= a; } }
#define DEC_PV_D0(d0) do { s16x4 l0, h0, l1, h1; ATT_TRRD(l0, vaddr, (d0) * 64); ATT_TRRD(h0, vaddr, (d0) * 64 + 4 * DROW); ATT_TRRD(l1, vaddr, (d0) * 64 + 16 * DROW); ATT_TRRD(h1, vaddr, (d0) * 64 + 20 * DROW); \
        asm volatile("s_waitcnt lgkmcnt(0)" ::: "memory"); SBAR(); \
        o[d0] = __builtin_amdgcn_mfma_f32_32x32x16_bf16(pa0, ATT_PK(l0, h0), o[d0], 0, 0, 0); \
        o[d0] = __builtin_amdgcn_mfma_f32_32x32x16_bf16(pa1, ATT_PK(l1, h1), o[d0], 0, 0, 0); } while (0)
        DEC_PV_D0(0); DEC_PV_D0(1); DEC_PV_D0(2); DEC_PV_D0(3);
#undef DEC_PV_D0
        asm volatile("" ::: "memory");
    }
#undef DEC_LOAD
    LDS_WAIT();
    { LAS float* Ow = (LAS float*)img; LAS float* ml = (LAS float*)(img + 4096);
#pragma unroll
      for (int r = 0; r < 4; ++r)
#pragma unroll
          for (int d = 0; d < 4; ++d) Ow[(r + 4 * hi) * VD + d * 32 + r32] = o[d][r];
      if (lane < 8) { ml[2 * lane] = m_reg; ml[2 * lane + 1] = l_reg; } }
    __syncthreads();
    { const int head = tid >> 6, c = tid & 63; float M = -1e30f;
#pragma unroll
      for (int w = 0; w < NWAVES; ++w) M = fmaxf(M, ((LAS float*)(lds + w * DIMG + 4096))[2 * head]);
      float L = 0.f, O0 = 0.f, O1 = 0.f;
#pragma unroll
      for (int w = 0; w < NWAVES; ++w) { LAS float* ml = (LAS float*)(lds + w * DIMG + 4096); LAS float* Ow = (LAS float*)(lds + w * DIMG) + head * VD;
          const float f = __builtin_amdgcn_exp2f(ml[2 * head] - M); L += ml[2 * head + 1] * f; O0 += Ow[c] * f; O1 += Ow[c + 64] * f; }
      float* dp = DPART + ((size_t)item * NH + head) * 130; dp[c] = O0; dp[c + 64] = O1; if (c == 0) { dp[128] = M; dp[129] = L; } }
    __syncthreads();
}
}
#define XB_TMO      128
#define XB_XCNT(j)  (256  + 64 * (j))
#define XB_XSUB(j)  (1280 + 64 * (j))
#define XB_XGEN(j)  (2304 + 64 * (j))
#define XB_TOP      3328
#define XB_TOPGEN   3392
#define XCD_BAR_WORDS 3456
#define XB_SPIN_CAP (1u << 18)

__device__ __forceinline__ unsigned xb_ld(unsigned* p)              { return __hip_atomic_load(p, __ATOMIC_RELAXED, __HIP_MEMORY_SCOPE_AGENT); }
__device__ __forceinline__ unsigned xb_add(unsigned* p, unsigned v) { return __hip_atomic_fetch_add(p, v, __ATOMIC_RELAXED, __HIP_MEMORY_SCOPE_AGENT); }
__device__ __forceinline__ unsigned xb_xcc_id() { return (unsigned)__builtin_amdgcn_s_getreg((3 << 11) | 20) & 0xFu; }
#define XB_SPIN(cond, bar) do { unsigned _sp = 0; while (cond) { __builtin_amdgcn_s_sleep(1); \
    if ((++_sp & 255u) == 0u) { if (xb_ld(&(bar)[XB_TMO])) break; if (_sp > XB_SPIN_CAP) { atomicAdd(&(bar)[XB_TMO], 1u); break; } } } } while (0)

struct XcdBarrier {
    unsigned* bar; unsigned x;
    volatile LAS unsigned* st;
};

__device__ __forceinline__ XcdBarrier xcd_barrier_post(unsigned* bar, volatile LAS unsigned* st) {
    XcdBarrier b; b.bar = bar; b.x = xb_xcc_id(); b.st = st;
    if (threadIdx.x == 0) (void)xb_add(&bar[XB_XCNT(b.x)], 1u);
    return b;
}
__device__ __forceinline__ void xcd_barrier_complete(unsigned* bar, unsigned x, unsigned& nloc, unsigned& nx) {
    const unsigned G = gridDim.x * gridDim.y * gridDim.z;
    unsigned sum, cnt, mine, sp = 0u;
    for (;;) {
        sum = 0u; cnt = 0u; mine = 0u;
#pragma unroll
        for (unsigned j = 0; j < 16; ++j) { const unsigned c = xb_ld(&bar[XB_XCNT(j)]); sum += c; cnt += (c > 0u) ? 1u : 0u; mine = (j == x) ? c : mine; }
        if (sum == G) break;
        __builtin_amdgcn_s_sleep(1);
        if ((++sp & 255u) == 0u) { if (xb_ld(&bar[XB_TMO])) break; if (sp > XB_SPIN_CAP) { atomicAdd(&bar[XB_TMO], 1u); break; } }
    }
    nloc = mine > 0u ? mine : 1u; nx = cnt > 0u ? cnt : 1u;
}

__device__ __forceinline__ void xcd_barrier(const XcdBarrier& b) {
    asm volatile("s_waitcnt vmcnt(0)" ::: "memory");
    __syncthreads();
    if (threadIdx.x == 0) {
        unsigned* bar = b.bar;
        __builtin_amdgcn_s_waitcnt(0);
        unsigned nloc = b.st[0], nx = b.st[1];
        if (nloc == 0u) { xcd_barrier_complete(bar, b.x, nloc, nx); b.st[0] = nloc; b.st[1] = nx; }
        const unsigned old = xb_add(&bar[XB_XSUB(b.x)], 1u);
        const unsigned gen = old / nloc;
        if (old + 1u == (gen + 1u) * nloc) {
            __builtin_amdgcn_fence(__ATOMIC_RELEASE, "agent");
            asm volatile("s_waitcnt vmcnt(0)" ::: "memory");
            const unsigned og = xb_add(&bar[XB_TOP], 1u);
            const unsigned tg = og / nx;
            if (og + 1u == (tg + 1u) * nx) xb_add(&bar[XB_TOPGEN], 1u);
            else XB_SPIN(xb_ld(&bar[XB_TOPGEN]) == tg, bar);
            __builtin_amdgcn_fence(__ATOMIC_ACQUIRE, "agent");
            xb_add(&bar[XB_XGEN(b.x)], 1u);
            asm volatile("s_waitcnt vmcnt(0)" ::: "memory");
        } else {
            XB_SPIN(xb_ld(&bar[XB_XGEN(b.x)]) == gen, bar);
            __builtin_amdgcn_fence(__ATOMIC_ACQUIRE, "agent");
            asm volatile("s_waitcnt vmcnt(0)" ::: "memory");
        }
    }
    __syncthreads();
}

struct Args { const float* in[19]; float* out; unsigned char* ws; int ph_lo, ph_hi; };
enum { I_XP = 0, I_XS, I_CKV, I_CKR, I_SPOOL, I_PTAB, I_GPRE, I_WIN, I_GQ, I_WUQ, I_GKV, I_WUK, I_WUV, I_WOATT, I_WPOOL, I_PSCALE, I_WOPOOL, I_WOUT, I_GFINAL };
constexpr int N_PHASES = 9;

__device__ __forceinline__ void p0_transpose_item(const float* __restrict__ W, int K, int N, bf16* __restrict__ WT, int row_off, LAS float* scr, int item, int lane) {
    const int nblk = N / 32, kb = item / nblk, nb = item % nblk, k0 = 64 * kb, n0 = 32 * nb;
#pragma unroll 8
    for (int i = 0; i < 32; ++i) { const int kk = 2 * i + (lane >> 5); scr[kk * 33 + (lane & 31)] = W[(size_t)(k0 + kk) * N + n0 + (lane & 31)]; }
    LDS_WAIT(); asm volatile("" ::: "memory");
    const int c = lane & 7;
#pragma unroll
    for (int j = 0; j < 4; ++j) { const int n = (lane >> 3) + 8 * j; const LAS float* s = scr + (8 * c) * 33 + n;
        u32x4 o; o.x = cvtpk(s[0 * 33], s[1 * 33]); o.y = cvtpk(s[2 * 33], s[3 * 33]); o.z = cvtpk(s[4 * 33], s[5 * 33]); o.w = cvtpk(s[6 * 33], s[7 * 33]);
        *(u32x4*)(WT + (size_t)(row_off + n0 + n) * K + k0 + 8 * c) = o; }
    LDS_WAIT(); asm volatile("" ::: "memory");
}


#define PHASE_ARGS() \
    int tid_ = threadIdx.x; asm volatile("" : "+v"(tid_)); const int tid = tid_, lane = tid & 63, wave = __builtin_amdgcn_readfirstlane(tid >> 6); (void)lane; \
    const __attribute__((address_space(4))) Args* ap_ = (const __attribute__((address_space(4))) Args*)__builtin_amdgcn_kernarg_segment_ptr(); asm volatile("" : "+s"(ap_)); const __attribute__((address_space(4))) Args& args = *ap_; \
    unsigned char* ws = args.ws; float* out = args.out; (void)out; \
    bf16* BT1 = (bf16*)(ws + WS_BT1); bf16* BTQ = (bf16*)(ws + WS_BTQ); bf16* BTG = (bf16*)(ws + WS_BTG); bf16* BTOA = (bf16*)(ws + WS_BTOA); bf16* BTOP = (bf16*)(ws + WS_BTOP); bf16* BTOUT = (bf16*)(ws + WS_BTOUT); \
    float* ROPET = (float*)(ws + WS_ROPE); float* QSS = (float*)(ws + WS_QSS); float* DPART = (float*)(ws + WS_DPART); \
    bf16* H = (bf16*)(ws + WS_H); bf16* QLAT = (bf16*)(ws + WS_QLAT); float* KVRAW = (float*)(ws + WS_KVRAW); bf16* KB = (bf16*)(ws + WS_KB); bf16* SZ = (bf16*)(ws + WS_SZ); \
    float* U = (float*)(ws + WS_U); bf16* SGA = (bf16*)(ws + WS_SGA); bf16* SGP = (bf16*)(ws + WS_SGP); bf16* OLPL = (bf16*)(ws + WS_OLPL); bf16* QA = (bf16*)(ws + WS_QA); bf16* QR = (bf16*)(ws + WS_QR); \
    bf16* G12 = (bf16*)(ws + WS_G12); float* M1 = (float*)(ws + WS_M1); bf16* MG = (bf16*)(ws + WS_MG); \
    (void)BT1; (void)BTQ; (void)BTG; (void)BTOA; (void)BTOP; (void)BTOUT; (void)ROPET; (void)QSS; (void)DPART; (void)H; (void)QLAT; (void)KVRAW; (void)KB; (void)SZ; (void)U; (void)SGA; (void)SGP; (void)OLPL; (void)QA; (void)QR; (void)G12; (void)M1; (void)MG; \
    const int G = gridDim.x, bx = blockIdx.x; const int vcu = (G % 8 == 0) ? (bx % 8) * (G / 8) + bx / 8 : bx; const int gw = vcu * NWAVES + wave, NGW = G * NWAVES; (void)gw; (void)NGW;

__global__ void __launch_bounds__(NWAVES * 64, 2) mk_fwd(Args args_in) {
    extern __shared__ __attribute__((aligned(16))) unsigned char lds_raw[];
    LAS unsigned char* lds = (LAS unsigned char*)lds_raw;
    volatile LAS unsigned* MISC = (volatile LAS unsigned*)(lds + MISC_OFF);
    for (int u = threadIdx.x; u < (LDS_BYTES - LDSCTL_OFF) / 4; u += NWAVES * 64) ((LAS unsigned*)(lds + LDSCTL_OFF))[u] = 0u;
    __syncthreads();
    const int lo = args_in.ph_lo, hi = args_in.ph_hi;
    XcdBarrier bar = xcd_barrier_post((unsigned*)(args_in.ws + WS_CTL) + CW_BAR + lo * XCD_BAR_WORDS, MISC + 8);
#ifndef PH_MASK
#define PH_MASK 0x1ff
#endif
#define IN(k) (((PH_MASK >> (k)) & 1) && lo <= (k) && (k) < hi)
#define SEAM(k) do { if (IN(k) && IN((k) + 1)) xcd_barrier(bar); } while (0)

    if (IN(0)) { PHASE_ARGS()
        LAS float* scr = (LAS float*)(lds + RING_OFF + wave * 16384);
        { constexpr int I_1 = (DM / 64) * (INC / 32), I_OA = (ATTW / 64) * (DM / 32), I_OP = (POOLW / 64) * (DM / 32), I_OUT = (DM / 64) * (DM / 32), NIT = I_1 + I_OA + I_OP + I_OUT;
          for (int it = gw; it < NIT; it += NGW) { int r = it;
              if (r < I_1) { const int nb = r % (INC / 32); p0_transpose_item(args.in[I_WIN], DM, INC, BT1, (32 * nb >= 448) ? 64 : 0, scr, r, lane); continue; } r -= I_1;
              if (r < I_OA) { p0_transpose_item(args.in[I_WOATT], ATTW, DM, BTOA, 0, scr, r, lane); continue; } r -= I_OA;
              if (r < I_OP) { p0_transpose_item(args.in[I_WOPOOL], POOLW, DM, BTOP, 0, scr, r, lane); continue; } r -= I_OP;
              p0_transpose_item(args.in[I_WOUT], DM, DM, BTOUT, 0, scr, r, lane); } }
        for (int i = bx * 512 + tid; i < 64 * DM / 8; i += G * 512) *(u32x4*)(BT1 + (size_t)448 * DM + (size_t)i * 8) = (u32x4){0u, 0u, 0u, 0u};
        for (int it = gw; it < 1536; it += NGW) {
            const float* wuq = args.in[I_WUQ]; const float* gq = args.in[I_GQ];
            if (it < 1024) { const int h = it >> 7, r = it & 127; const float* uk = args.in[I_WUK] + ((size_t)r * NH + h) * NOPE;
                float a[4] = {0.f, 0.f, 0.f, 0.f};
                for (int n = 0; n < NOPE; n += 4) { const f32x4 k4 = *(const f32x4*)(uk + n);
#pragma unroll
                    for (int j = 0; j < 4; ++j) { const f32x4 q4 = *(const f32x4*)(wuq + (size_t)(lane + 64 * j) * (NH * (NOPE + ROPE)) + h * (NOPE + ROPE) + n);
                        a[j] += (q4[0] * k4[0] + q4[1] * k4[1]) + (q4[2] * k4[2] + q4[3] * k4[3]); } }
#pragma unroll
                for (int j = 0; j < 4; ++j) { const int k = lane + 64 * j; BTQ[(size_t)it * QRANK + k] = (bf16)(cvtpk(a[j] * gq[k], 0.f) & 0xffffu); }
            } else { const int j2 = it - 1024, pn = j2 >> 8, jj = j2 & 255, bj = jj >> 7, x = jj & 127, head = 4 * pn + (x >> 5), dim = (x & 31) + 32 * bj;
#pragma unroll
                for (int j = 0; j < 4; ++j) { const int k = lane + 64 * j; BTQ[(size_t)it * QRANK + k] = (bf16)(cvtpk(gq[k] * wuq[(size_t)k * (NH * (NOPE + ROPE)) + head * (NOPE + ROPE) + NOPE + dim], 0.f) & 0xffffu); } }
        }
        for (int it = gw; it < 1536; it += NGW) {
#pragma unroll
            for (int j = 0; j < 4; ++j) { const int kk = lane + 64 * j; float v = 0.f;
                if (it < 1024) { const int h = it >> 7, vv = it & 127; if ((kk >> 7) == (h & 1)) v = args.in[I_WUV][((size_t)(kk & 127) * NH + h) * VD + vv]; }
                else { const int n = it - 1024, g = n >> 7, d = n & 127; if ((kk >> 7) == (g & 1)) v = args.in[I_WPOOL][((size_t)g * 128 + (kk & 127)) * 128 + d]; }
                BTG[(size_t)it * 256 + kk] = (bf16)(cvtpk(v, 0.f) & 0xffffu); }
        }
        for (int e = gw * 64 + lane; e < (SEQ + 1) * 32; e += NGW * 64) { const int pos = e >> 5, i = e & 31;
            const float inv = powf(10000.0f, -(float)i / 32.0f); const float ang = (float)pos * inv;
            ROPET[2 * (size_t)e] = (float)cos((double)ang); ROPET[2 * (size_t)e + 1] = (float)sin((double)ang); }
        for (int m = gw; m < MTOT; m += NGW) {
            const float* xrow = m < SEQ ? args.in[I_XP] + (size_t)m * DM : args.in[I_XS] + (size_t)(m - SEQ) * DM;
            const f32x4* xr = (const f32x4*)xrow + lane; const f32x4* gr = (const f32x4*)args.in[I_GPRE] + lane;
            f32x4 v[4]; float s = 0.f;
#pragma unroll
            for (int j = 0; j < 4; ++j) { v[j] = xr[64 * j]; s += (v[j][0] * v[j][0] + v[j][1] * v[j][1]) + (v[j][2] * v[j][2] + v[j][3] * v[j][3]); }
            const float rs = 1.0f / sqrtf(wave_sum(s) * (1.f / DM) + EPS);
            unsigned long long* o8 = (unsigned long long*)(H + (size_t)m * DM) + lane;
#pragma unroll
            for (int j = 0; j < 4; ++j) { const f32x4 g = gr[64 * j]; o8[64 * j] = (unsigned long long)cvtpk(v[j][0] * rs * g[0], v[j][1] * rs * g[1]) | ((unsigned long long)cvtpk(v[j][2] * rs * g[2], v[j][3] * rs * g[3]) << 32); }
        }
        VM_WAIT(); __syncthreads();
    }
    SEAM(0);

    if (IN(1)) { PHASE_ARGS()
        pg8::Gemm g{H, BT1, DM, DM, DM, 0}; pg8::StaticOrder S; S.init(MPAD, N1, G, bx);
        pg8::Epi1 E{QLAT, QSS, KVRAW, SZ, U, SGA, SGP};
        pg8::gemm_phase<pg8::Epi1, pg8::StaticOrder, true, true>(lds + RING_OFF, g, S, E);
    }
    SEAM(1);

    if (IN(2)) { PHASE_ARGS()
#ifndef P2_NO_ELEM
        for (int row = gw; row < MTOT; row += NGW) {
            const float* src = KVRAW + (size_t)row * QKD; const int pos = row < SEQ ? row : SEQ;
            float* ckv_o = row < SEQ ? out + O_CKVP + (size_t)row * KVR : out + O_CKVS + (size_t)(row - SEQ) * KVR;
            float* kr_o = row < SEQ ? out + O_KRP + (size_t)row * ROPE : out + O_KRS + (size_t)(row - SEQ) * ROPE;
            const float v0 = src[lane], v1 = src[lane + 64];
            const float rs = 1.0f / sqrtf(wave_sum(v0 * v0 + v1 * v1) * (1.f / KVR) + EPS);
            const float c0 = v0 * rs * args.in[I_GKV][lane], c1 = v1 * rs * args.in[I_GKV][lane + 64];
            ckv_o[lane] = c0; ckv_o[lane + 64] = c1;
            bf16* kb = KB + (size_t)row * QKD; kb[lane] = (bf16)(cvtpk(c0, 0.f) & 0xffffu); kb[lane + 64] = (bf16)(cvtpk(c1, 0.f) & 0xffffu);
            if (lane < 32) { const float x1 = src[KVR + lane], x2 = src[KVR + 32 + lane]; const float cs = ROPET[2 * ((size_t)pos * 32 + lane)], sn = ROPET[2 * ((size_t)pos * 32 + lane) + 1];
                const float o1 = x1 * cs - x2 * sn, o2 = x2 * cs + x1 * sn;
                kr_o[lane] = o1; kr_o[lane + 32] = o2; kb[KVR + lane] = (bf16)(cvtpk(o1, 0.f) & 0xffffu); kb[KVR + 32 + lane] = (bf16)(cvtpk(o2, 0.f) & 0xffffu); }
        }
        for (int it = gw; it < (SEQ / 64) * 4; it += NGW) { const int q = it & 3, t0 = (it >> 2) * 64, w = 2 << q, c = 128 * q + 2 * lane;
            f32x2 sum = {0.f, 0.f};
            for (int i = 1; i < w; ++i) { const int t = t0 - i; if (t >= 0) sum += *(const f32x2*)(U + (size_t)t * POOLW + c); }
            for (int t = t0; t < t0 + 64; ++t) { const f32x2 u = *(const f32x2*)(U + (size_t)t * POOLW + c); sum += u;
                const float rc = 1.0f / (float)(t + 1 < w ? t + 1 : w);
                *(unsigned*)(OLPL + (size_t)t * GW + ATTW + c) = cvtpk(sum[0] * rc - u[0], sum[1] * rc - u[1]);
                const int told = t - (w - 1); if (told >= 0) sum -= *(const f32x2*)(U + (size_t)told * POOLW + c); }
        }
        for (int it = gw; it < NS * 4; it += NGW) { const int q = it & 3, b = it >> 2, w = 2 << q, c = 128 * q + 2 * lane;
            const f32x2 u = *(const f32x2*)(U + (size_t)(SEQ + b) * POOLW + c); f32x2 sum = u;
            for (int i = 0; i < w - 1; ++i) sum += *(const f32x2*)(args.in[I_SPOOL] + ((size_t)b * PHIST + (PHIST - 1 - i)) * POOLW + c);
            const float rc = 1.0f / (float)w;
            *(unsigned*)(OLPL + (size_t)(SEQ + b) * GW + ATTW + c) = cvtpk(sum[0] * rc - u[0], sum[1] * rc - u[1]); }
        for (int e = gw * 64 + lane; e < (PHIST * POOLW + NS * PHIST * POOLW) / 4; e += NGW * 64) {
            if (e < PHIST * POOLW / 4) { *(f32x4*)(out + O_POOLP + (size_t)e * 4) = *(const f32x4*)(U + (size_t)(SEQ - PHIST) * POOLW + (size_t)e * 4); }
            else { const int e2 = e - PHIST * POOLW / 4, b = e2 / (PHIST * POOLW / 4), r = e2 % (PHIST * POOLW / 4), j = r / (POOLW / 4), c4 = r % (POOLW / 4);
                const f32x4 v = j < PHIST - 1 ? *(const f32x4*)(args.in[I_SPOOL] + ((size_t)b * PHIST + j + 1) * POOLW + c4 * 4) : *(const f32x4*)(U + (size_t)(SEQ + b) * POOLW + c4 * 4);
                *(f32x4*)(out + O_POOLS + (size_t)e2 * 4) = v; } }
#endif
#ifndef P2_NO_GEMM
        pg8::Gemm g{QLAT, BTQ, QRANK, QRANK, QRANK, 0}; pg8::StaticOrder S; S.init(MPAD, 1536, G, bx);
        pg8::Epi2 E{QA, QR, QSS, ROPET};
        pg8::gemm_phase<pg8::Epi2, pg8::StaticOrder, true, true>(lds + RING_OFF, g, S, E);
#endif
    }
    SEAM(2);

    if (IN(3)) { PHASE_ARGS()
#ifndef NO_PROMPT
        for (int i = 0; i < 2 * ((SEQ / 64 - bx + G - 1) / G); ++i) {
            const int x = bx + (i >> 1) * G, xx = (i & 1) ? SEQ / 32 - 1 - x : x;
            att::prompt_unit(32 * xx, QA, QR, KB, OLPL, lds + RING_OFF, tid, wave, lane);
        }
#endif
#ifndef NO_DECODE
        for (int it = bx; it < 2 * NS; it += G)
            att::decode_item(it, args.in[I_CKV], args.in[I_CKR], (const int*)args.in[I_PTAB], QA, QR, DPART, lds + RING_OFF, tid, wave, lane);
#endif
    }
    SEAM(3);

    if (IN(4)) { PHASE_ARGS()
        for (int it = gw; it < NS * NH; it += NGW) { const int b = it >> 3, h = it & 7; const size_t row = (size_t)(SEQ + b);
            const float* d0 = DPART + ((size_t)(2 * b) * NH + h) * 130; const float* d1 = DPART + ((size_t)(2 * b + 1) * NH + h) * 130;
            const bf16* qa = QA + row * ATTW + h * NOPE; const bf16* qq = QR + row * (NH * ROPE) + h * ROPE; const bf16* kb = KB + row * QKD;
            float ts = bf2f(qa[lane]) * bf2f(kb[lane]) + bf2f(qa[lane + 64]) * bf2f(kb[lane + 64]) + bf2f(qq[lane]) * bf2f(kb[KVR + lane]);
            ts = wave_sum(ts);
            const float M0 = d0[128], L0 = d0[129], M1_ = d1[128], L1 = d1[129];
            const float M = fmaxf(fmaxf(M0, M1_), ts), w0 = __builtin_amdgcn_exp2f(M0 - M), w1 = __builtin_amdgcn_exp2f(M1_ - M), wsf = __builtin_amdgcn_exp2f(ts - M);
            const float rl = 1.0f / (L0 * w0 + L1 * w1 + wsf);
#pragma unroll
            for (int j = 0; j < 2; ++j) { const int c = lane + 64 * j;
                OLPL[row * GW + h * VD + c] = (bf16)(cvtpk((d0[c] * w0 + d1[c] * w1 + wsf * bf2f(kb[c])) * rl, 0.f) & 0xffffu); }
        }
        VM_WAIT(); __syncthreads();
    }
    SEAM(4);

    if (IN(5)) { PHASE_ARGS()
        pg8::Gemm g{OLPL, BTG, GW, 256, 256, 256}; pg8::StaticOrder S; S.init(MPAD, GW, G, bx);
        pg8::Epi5 E{G12, SZ, args.in[I_PSCALE]};
        pg8::gemm_phase<pg8::Epi5, pg8::StaticOrder, true, true>(lds + RING_OFF, g, S, E);
    }
    SEAM(5);

    if (IN(6)) { PHASE_ARGS()
        { pg8::Gemm g{G12, BTOA, GW, ATTW, ATTW, 0}; pg8::StaticOrder S; S.init(MPAD, DM, G, bx);
          pg8::Epi6<false> E{M1, MG, SGA};
          pg8::gemm_phase<pg8::Epi6<false>, pg8::StaticOrder, true, true>(lds + RING_OFF, g, S, E); }
        VM_WAIT(); __syncthreads();
        { pg8::Gemm g{G12 + ATTW, BTOP, GW, POOLW, POOLW, 0}; pg8::StaticOrder S; S.init(MPAD, DM, G, bx);
          pg8::Epi6<true> E{M1, MG, SGP};
          pg8::gemm_phase<pg8::Epi6<true>, pg8::StaticOrder, true, true>(lds + RING_OFF, g, S, E); }
    }
    SEAM(6);

    if (IN(7)) { PHASE_ARGS()
        pg8::Gemm g{MG, BTOUT, DM, DM, DM, 0}; pg8::StaticOrder S; S.init(MPAD, DM, G, bx);
        pg8::Epi7 E{args.in[I_XP], args.in[I_XS], out};
        pg8::gemm_phase<pg8::Epi7, pg8::StaticOrder, true, true>(lds + RING_OFF, g, S, E);
    }
    SEAM(7);

    if (IN(8)) { PHASE_ARGS()
        for (int m = gw; m < MTOT; m += NGW) {
            float* y = m < SEQ ? out + O_YP + (size_t)m * DM : out + O_YS + (size_t)(m - SEQ) * DM;
            f32x4* yr = (f32x4*)y + lane; const f32x4* gr = (const f32x4*)args.in[I_GFINAL] + lane;
            f32x4 v[4]; float s = 0.f;
#pragma unroll
            for (int j = 0; j < 4; ++j) { v[j] = yr[64 * j]; s += (v[j][0] * v[j][0] + v[j][1] * v[j][1]) + (v[j][2] * v[j][2] + v[j][3] * v[j][3]); }
            const float rs = 1.0f / sqrtf(wave_sum(s) * (1.f / DM) + EPS);
#pragma unroll
            for (int j = 0; j < 4; ++j) yr[64 * j] = v[j] * rs * gr[64 * j];
        }
    }
#undef IN
#undef SEAM
}

#ifndef MK_CUTS
#define MK_CUTS 0
#endif
extern "C" void kernel_launch(void* const* d_in, const int* in_sizes, int n_in, void* d_out, int out_size, void* d_ws, size_t ws_size, hipStream_t stream) {
    static int grid = 0;
    if (grid == 0) {
        if (n_in != 19 || out_size != (int)O_END || ws_size < WS_END) { fprintf(stderr, "kernel_launch: built for 19 inputs, %zu outputs, >= %zu bytes of workspace; got %d, %d, %zu\n", (size_t)O_END, (size_t)WS_END, n_in, out_size, ws_size); grid = -1; return; }
        int dev = 0, cus = 0, per_cu = 0;
        if (hipGetDevice(&dev) != hipSuccess || hipDeviceGetAttribute(&cus, hipDeviceAttributeMultiprocessorCount, dev) != hipSuccess) { grid = -1; return; }
        if (hipFuncSetAttribute((const void*)mk_fwd, hipFuncAttributeMaxDynamicSharedMemorySize, LDS_BYTES) != hipSuccess) { fprintf(stderr, "kernel_launch: hipFuncSetAttribute failed\n"); grid = -1; return; }
        if (hipOccupancyMaxActiveBlocksPerMultiprocessor(&per_cu, (const void*)mk_fwd, NWAVES * 64, LDS_BYTES) != hipSuccess || per_cu < 1) { fprintf(stderr, "kernel_launch: occupancy query says %d workgroups per CU\n", per_cu); }
        (void)hipGetLastError();
        grid = cus;
    }
    if (grid < 0) return;
    (void)hipMemsetAsync((char*)d_ws + WS_CTL, 0, CTL_ZERO_BYTES, stream);
    Args a{};
    for (int i = 0; i < 19; ++i) a.in[i] = (const float*)d_in[i];
    a.out = (float*)d_out; a.ws = (unsigned char*)d_ws;
#if MK_CUTS
    for (int p = 0; p < N_PHASES; ++p) { a.ph_lo = p; a.ph_hi = p + 1; hipLaunchKernelGGL(mk_fwd, dim3(grid), dim3(NWAVES * 64), LDS_BYTES, stream, a); }
#else
    a.ph_lo = 0; a.ph_hi = N_PHASES; hipLaunchKernelGGL(mk_fwd, dim3(grid), dim3(NWAVES * 64), LDS_BYTES, stream, a);
#endif
    const hipError_t le = hipPeekAtLastError();
    if (le != hipSuccess) fprintf(stderr, "kernel_launch: launch failed: %s\n", hipGetErrorName(le));
}
```

```cpp
#include <hip/hip_runtime.h>
#include <cstdio>
#include <cstdint>

#define GAS __attribute__((address_space(1)))
#define LAS __attribute__((address_space(3)))
typedef unsigned short bf16;
typedef short bf16x8 __attribute__((ext_vector_type(8)));
typedef short s16x4 __attribute__((ext_vector_type(4)));
typedef float f32x2 __attribute__((ext_vector_type(2)));
typedef float f32x4 __attribute__((ext_vector_type(4)));
typedef float f32x16 __attribute__((ext_vector_type(16)));
typedef unsigned u32x2 __attribute__((ext_vector_type(2)));
typedef unsigned u32x4 __attribute__((ext_vector_type(4)));
typedef GAS unsigned gu32;

constexpr int DM = 1024, SEQ = 16384, NS = 128, PAST = 16384, PAGE = 128, NPG = PAST / PAGE;
constexpr int MTOT = SEQ + NS;
constexpr int MPAD = 65 * 256;
constexpr int NH = 8, NOPE = 128, ROPE = 64, VD = 128, QRANK = 256, KVR = 128, ATTW = NH * VD, POOLW = 512, PHIST = 15;
constexpr int QKD = KVR + ROPE;
constexpr int INC = 4544, N1 = 4608;
constexpr int GW = ATTW + POOLW;
constexpr float EPS = 1e-6f;
constexpr float C2 = 0.07216878364870322f * 1.4426950408889634f;
constexpr size_t O_YP = 0, O_YS = O_YP + (size_t)SEQ * DM, O_CKVP = O_YS + (size_t)NS * DM, O_KRP = O_CKVP + (size_t)SEQ * KVR, O_POOLP = O_KRP + (size_t)SEQ * ROPE,
                 O_CKVS = O_POOLP + (size_t)PHIST * POOLW, O_KRS = O_CKVS + (size_t)NS * KVR, O_POOLS = O_KRS + (size_t)NS * ROPE, O_END = O_POOLS + (size_t)NS * PHIST * POOLW;
static_assert(O_END == 21069312, "d_out map");
constexpr size_t MiB = 1u << 20;
constexpr size_t WS_CTL = 0, CTL_ZERO_BYTES = 1 * MiB;
constexpr size_t WS_BT1 = 2 * MiB;
constexpr size_t WS_BTQ = 11 * MiB;
constexpr size_t WS_BTG = 12 * MiB;
constexpr size_t WS_BTOA = 13 * MiB;
constexpr size_t WS_BTOP = 15 * MiB;
constexpr size_t WS_BTOUT = 16 * MiB;
constexpr size_t WS_ROPE = 18 * MiB;
constexpr size_t WS_QSS = 23 * MiB;
constexpr size_t WS_DPART = 24 * MiB;
constexpr size_t WS_H = 32 * MiB;
constexpr size_t WS_QLAT = 65 * MiB;
constexpr size_t WS_KVRAW = 74 * MiB;
constexpr size_t WS_KB = 87 * MiB;
constexpr size_t WS_SZ = 94 * MiB;
constexpr size_t WS_U = 143 * MiB;
constexpr size_t WS_SGA = 176 * MiB;
constexpr size_t WS_SGP = 209 * MiB;
constexpr size_t WS_OLPL = 242 * MiB;
constexpr size_t WS_QA = 291 * MiB;
constexpr size_t WS_QR = 324 * MiB;
constexpr size_t WS_G12 = 341 * MiB;
constexpr size_t WS_M1 = 390 * MiB;
constexpr size_t WS_MG = 456 * MiB;
constexpr size_t WS_END = 489 * MiB;
static_assert(WS_BT1 + (size_t)N1 * 1024 * 2 <= WS_BTQ && WS_BTQ + 1536 * 256 * 2 <= WS_BTG && WS_BTG + 1536 * 256 * 2 <= WS_BTOA && WS_ROPE + (size_t)(SEQ + 1) * 32 * 8 <= WS_QSS &&
              WS_QSS + (size_t)MPAD * 16 <= WS_DPART && WS_DPART + (size_t)NS * 8 * 8 * 130 * 4 <= WS_H && WS_H + (size_t)MPAD * 2048 <= WS_QLAT && WS_QLAT + (size_t)MPAD * 512 <= WS_KVRAW &&
              WS_KVRAW + (size_t)MPAD * 768 <= WS_KB && WS_KB + (size_t)MPAD * 384 <= WS_SZ && WS_SZ + (size_t)MPAD * 3072 <= WS_U && WS_U + (size_t)MPAD * 2048 <= WS_SGA &&
              WS_SGA + (size_t)MPAD * 2048 <= WS_SGP && WS_SGP + (size_t)MPAD * 2048 <= WS_OLPL && WS_OLPL + (size_t)MPAD * 3072 <= WS_QA && WS_QA + (size_t)MPAD * 2048 <= WS_QR &&
              WS_QR + (size_t)MPAD * 1024 <= WS_G12 && WS_G12 + (size_t)MPAD * 3072 <= WS_M1 && WS_M1 + (size_t)MPAD * 4096 <= WS_MG && WS_MG + (size_t)MPAD * 2048 <= WS_END, "d_ws map");
constexpr int CW_QPROMPT = 1024, CW_QDEC = 1088;
constexpr int DSPLIT = 4;
#ifndef ND_FIRST
#define ND_FIRST 32
#endif
constexpr int CW_BAR = 4096;
constexpr int RING_OFF = 0, RING_BYTES = 131072;
constexpr int LDSCTL_OFF = RING_BYTES, MISC_OFF = LDSCTL_OFF + 320;
constexpr int LDS_BYTES = 147456;
constexpr int NWAVES = 8;

#define LDS_WAIT() asm volatile("s_waitcnt lgkmcnt(0)" ::: "memory")
#define VM_WAIT() asm volatile("s_waitcnt vmcnt(0)" ::: "memory")
#define SBAR() __builtin_amdgcn_sched_barrier(0)
__device__ __forceinline__ unsigned cvtpk(float lo, float hi) { unsigned r; asm("v_cvt_pk_bf16_f32 %0, %1, %2" : "=v"(r) : "v"(lo), "v"(hi)); return r; }
__device__ __forceinline__ float bflo(unsigned w) { return __builtin_bit_cast(float, w << 16); }
__device__ __forceinline__ float bfhi(unsigned w) { return __builtin_bit_cast(float, w & 0xffff0000u); }
__device__ __forceinline__ float bf2f(bf16 b) { return __builtin_bit_cast(float, (unsigned)b << 16); }
__device__ __forceinline__ float sigmoidf_(float x) { return __builtin_amdgcn_rcpf(1.f + __builtin_amdgcn_exp2f(-1.4426950408889634f * x)); }
__device__ __forceinline__ float wave_sum(float v) {
#pragma unroll
    for (int o = 1; o < 64; o <<= 1) v += __shfl_xor(v, o);
    return v;
}

namespace pg8 {
#define PG8_LAS __attribute__((address_space(3)))
typedef unsigned short bf16_t;
constexpr int BM = 256, BK = 64, HALF = 128, HTB = HALF * BK * 2  , STAGE_BYTES = 8 * HTB, NXCD = 8, WGM = 8;
__host__ __device__ __forceinline__ int lds_byte(int r, int c) { const int st = (r >> 4) * 2 + (c >> 5), rr = r & 15, cc = c & 31, ob = rr * 64 + cc * 2; return st * 1024 + (ob ^ (((ob >> 9) & 1) << 5)); }
__host__ __device__ __forceinline__ void stage_rc(int b, int& R, int& C) { const int st = b / 1024, sb = b % 1024, swz = sb ^ (((sb >> 9) & 1) << 5); R = (st >> 1) * 16 + swz / 64; C = (st & 1) * 32 + (swz % 64) / 2; }
__host__ __device__ __forceinline__ int perm32(int rho) { const int n = rho >> 4, i = rho & 15; return 8 * (i >> 2) + 4 * n + (i & 3); }
struct Unit { int pm, pn; };
struct Gemm { const bf16_t* A; const bf16_t* Bt; int lda, ldb, K, a_pn_off; };
struct StaticOrder {
    int nM, nN, nwg, G, c;
    __host__ __device__ void init(int M, int N, int G_, int c_) { nM = M / BM; nN = N / BM; nwg = nM * nN; G = G_; c = c_; }
    __host__ __device__ bool next(int i, Unit& u) const {
        const long L = (long)i * G + c; if (L >= nwg) return false;
        int wgid = (int)L; { const int q = nwg / NXCD, r = nwg % NXCD, xcd = wgid % NXCD, off = wgid / NXCD; wgid = (xcd < r ? xcd * (q + 1) : r * (q + 1) + (xcd - r) * q) + off; }
        const int nig = WGM * nN, gid = wgid / nig, fm = gid * WGM, gsz = (nM - fm) < WGM ? (nM - fm) : WGM;
        u.pm = fm + ((wgid % nig) % gsz); u.pn = (wgid % nig) / gsz; return true;
    }
    __device__ __forceinline__ void a_ready(const Unit&) const {}
    __device__ __forceinline__ void done(const Unit&) const {}
};
#define EPI_PACK8(v0, v1) ((u32x4){cvtpk((v0)[0], (v0)[1]), cvtpk((v0)[2], (v0)[3]), cvtpk((v1)[0], (v1)[1]), cvtpk((v1)[2], (v1)[3])})
#define EPI_UNPK_LO(g) ((f32x4){bflo((g).x), bfhi((g).x), bflo((g).y), bfhi((g).y)})
#define EPI_UNPK_HI(g) ((f32x4){bflo((g).z), bfhi((g).z), bflo((g).w), bfhi((g).w)})
struct Epi1 {
    static constexpr bool PERM = true, AFTER_DRAIN = false;
    bf16_t* QLAT; float* QSS; float* KVRAW; bf16_t* SZ; float* U; bf16_t* SGA; bf16_t* SGP;
    __device__ __forceinline__ void operator()(const f32x4 (&acc)[2][2][4][2], const Unit& u, int wr, int wc, int fr, int fq) const {
        const int pn = u.pn, row0 = u.pm * BM + wr * 64 + fr, c0 = wc * 32 + 8 * fq;
        if (pn == 0) {
#pragma unroll
            for (int ai = 0; ai < 2; ++ai)
#pragma unroll
                for (int m = 0; m < 4; ++m) { const size_t row = (size_t)(row0 + ai * HALF + m * 16); float ss = 0.f;
#pragma unroll
                    for (int bj = 0; bj < 2; ++bj) { const f32x4 v0 = acc[ai][bj][m][0], v1 = acc[ai][bj][m][1];
                        ss += (v0[0] * v0[0] + v0[1] * v0[1]) + (v0[2] * v0[2] + v0[3] * v0[3]) + (v1[0] * v1[0] + v1[1] * v1[1]) + (v1[2] * v1[2] + v1[3] * v1[3]);
                        *(u32x4*)(QLAT + row * 256 + bj * HALF + c0) = EPI_PACK8(v0, v1); }
                    ss += __shfl_xor(ss, 16); ss += __shfl_xor(ss, 32);
                    if (fq == 0) QSS[row * 4 + wc] = ss; }
        } else if (pn == 1) {
#pragma unroll
            for (int ai = 0; ai < 2; ++ai)
#pragma unroll
                for (int m = 0; m < 4; ++m) { const size_t row = (size_t)(row0 + ai * HALF + m * 16);
#pragma unroll
                    for (int bj = 0; bj < 2; ++bj) { const int c = bj * HALF + c0;
                        if (c < QKD) { *(f32x4*)(KVRAW + row * QKD + c) = acc[ai][bj][m][0]; *(f32x4*)(KVRAW + row * QKD + c + 4) = acc[ai][bj][m][1]; } } }
        } else if (pn == 6 || pn == 7) {
#pragma unroll
            for (int ai = 0; ai < 2; ++ai)
#pragma unroll
                for (int m = 0; m < 4; ++m) { const size_t row = (size_t)(row0 + ai * HALF + m * 16);
#pragma unroll
                    for (int bj = 0; bj < 2; ++bj) { float* p = U + row * POOLW + (pn - 6) * 256 + bj * HALF + c0;
                        *(f32x4*)p = acc[ai][bj][m][0]; *(f32x4*)(p + 4) = acc[ai][bj][m][1]; } }
        } else {
            bf16_t* dst; int ld; bool sig;
            if (pn < 6) { dst = SZ + (pn - 2) * 256; ld = GW; sig = false; }
            else if (pn < 10) { dst = SZ + ATTW + (pn - 8) * 256; ld = GW; sig = false; }
            else if (pn < 14) { dst = SGA + (pn - 10) * 256; ld = DM; sig = true; }
            else { dst = SGP + (pn - 14) * 256; ld = DM; sig = true; }
#pragma unroll
            for (int ai = 0; ai < 2; ++ai)
#pragma unroll
                for (int m = 0; m < 4; ++m) { const size_t row = (size_t)(row0 + ai * HALF + m * 16);
#pragma unroll
                    for (int bj = 0; bj < 2; ++bj) { f32x4 v0 = acc[ai][bj][m][0], v1 = acc[ai][bj][m][1];
#pragma unroll
                        for (int e = 0; e < 4; ++e) { const float s0 = sigmoidf_(v0[e]), s1 = sigmoidf_(v1[e]); v0[e] = sig ? s0 : v0[e] * s0; v1[e] = sig ? s1 : v1[e] * s1; }
                        *(u32x4*)(dst + row * ld + bj * HALF + c0) = EPI_PACK8(v0, v1); } }
        }
    }
};
struct Epi2 {
    static constexpr bool PERM = true, AFTER_DRAIN = false;
    bf16_t* QA; bf16_t* QR; const float* QSS; const float* ROPET;
    __device__ __forceinline__ void operator()(const f32x4 (&acc)[2][2][4][2], const Unit& u, int wr, int wc, int fr, int fq) const {
        const int pn = u.pn, row0 = u.pm * BM + wr * 64 + fr, c0 = wc * 32 + 8 * fq;
#pragma unroll
        for (int ai = 0; ai < 2; ++ai)
#pragma unroll
            for (int m = 0; m < 4; ++m) { const size_t row = (size_t)(row0 + ai * HALF + m * 16);
                const f32x4 q4 = *(const f32x4*)(QSS + row * 4);
                const float s = C2 * __builtin_amdgcn_rsqf(((q4[0] + q4[1]) + (q4[2] + q4[3])) * (1.f / QRANK) + EPS);
                if (pn < 4) {
#pragma unroll
                    for (int bj = 0; bj < 2; ++bj) { const f32x4 v0 = acc[ai][bj][m][0] * s, v1 = acc[ai][bj][m][1] * s;
                        *(u32x4*)(QA + row * ATTW + pn * 256 + bj * HALF + c0) = EPI_PACK8(v0, v1); }
                } else {
                    const int pos = row < SEQ ? (int)row : SEQ;
                    const float* rp = ROPET + ((size_t)pos * 32 + 8 * fq) * 2;
                    bf16_t* q = QR + row * (NH * ROPE) + (4 * (pn - 4) + wc) * ROPE + 8 * fq;
#pragma unroll
                    for (int n = 0; n < 2; ++n) {
                        const f32x4 t0 = *(const f32x4*)(rp + 8 * n), t1 = *(const f32x4*)(rp + 8 * n + 4);
                        const f32x4 a = acc[ai][0][m][n], b = acc[ai][1][m][n];
                        u32x2 lo, hi2;
                        lo.x = cvtpk((a[0] * t0[0] - b[0] * t0[1]) * s, (a[1] * t0[2] - b[1] * t0[3]) * s); lo.y = cvtpk((a[2] * t1[0] - b[2] * t1[1]) * s, (a[3] * t1[2] - b[3] * t1[3]) * s);
                        hi2.x = cvtpk((b[0] * t0[0] + a[0] * t0[1]) * s, (b[1] * t0[2] + a[1] * t0[3]) * s); hi2.y = cvtpk((b[2] * t1[0] + a[2] * t1[1]) * s, (b[3] * t1[2] + a[3] * t1[3]) * s);
                        *(u32x2*)(q + 4 * n) = lo; *(u32x2*)(q + 32 + 4 * n) = hi2; }
                }
                if (m & 1) __builtin_amdgcn_sched_barrier(0);
            }
    }
};
struct Epi5 {
    static constexpr bool PERM = true, AFTER_DRAIN = false;
    bf16_t* G12; const bf16_t* SZ; const float* pool_scale;
    __device__ __forceinline__ void operator()(const f32x4 (&acc)[2][2][4][2], const Unit& u, int wr, int wc, int fr, int fq) const {
        const int pn = u.pn, row0 = u.pm * BM + wr * 64 + fr, c0 = wc * 32 + 8 * fq;
#pragma unroll
        for (int bj = 0; bj < 2; ++bj) { const int c = pn * 256 + bj * HALF + c0;
            f32x4 p0 = {1.f, 1.f, 1.f, 1.f}, p1 = p0;
            if (pn >= 4) { p0 = *(const f32x4*)(pool_scale + c - ATTW); p1 = *(const f32x4*)(pool_scale + c - ATTW + 4); }
#pragma unroll
            for (int ai = 0; ai < 2; ++ai)
#pragma unroll
                for (int m = 0; m < 4; ++m) { const size_t row = (size_t)(row0 + ai * HALF + m * 16);
                    const u32x4 g = *(const u32x4*)(SZ + row * GW + c);
                    const f32x4 v0 = acc[ai][bj][m][0] * p0 * EPI_UNPK_LO(g), v1 = acc[ai][bj][m][1] * p1 * EPI_UNPK_HI(g);
                    *(u32x4*)(G12 + row * GW + c) = EPI_PACK8(v0, v1); } }
    }
};
template <bool SECOND> struct Epi6 {
    static constexpr bool PERM = true, AFTER_DRAIN = false;
    float* M1; bf16_t* MG; const bf16_t* SG;
    __device__ __forceinline__ void operator()(const f32x4 (&acc)[2][2][4][2], const Unit& u, int wr, int wc, int fr, int fq) const {
        const int pn = u.pn, row0 = u.pm * BM + wr * 64 + fr, c0 = wc * 32 + 8 * fq;
#pragma unroll
        for (int ai = 0; ai < 2; ++ai)
#pragma unroll
            for (int m = 0; m < 4; ++m) { const size_t row = (size_t)(row0 + ai * HALF + m * 16);
#pragma unroll
                for (int bj = 0; bj < 2; ++bj) { const size_t o = row * DM + pn * 256 + bj * HALF + c0;
                    const u32x4 g = *(const u32x4*)(SG + o);
                    f32x4 v0 = acc[ai][bj][m][0] * EPI_UNPK_LO(g), v1 = acc[ai][bj][m][1] * EPI_UNPK_HI(g);
                    if (!SECOND) { *(f32x4*)(M1 + o) = v0; *(f32x4*)(M1 + o + 4) = v1; }
                    else { v0 += *(const f32x4*)(M1 + o); v1 += *(const f32x4*)(M1 + o + 4); *(u32x4*)(MG + o) = EPI_PACK8(v0, v1); } } }
    }
};
struct Epi7 {
    static constexpr bool PERM = true, AFTER_DRAIN = false;
    const float* xp; const float* xs; float* out;
    __device__ __forceinline__ void operator()(const f32x4 (&acc)[2][2][4][2], const Unit& u, int wr, int wc, int fr, int fq) const {
        const int pn = u.pn, row0 = u.pm * BM + wr * 64 + fr, c0 = wc * 32 + 8 * fq;
#pragma unroll
        for (int ai = 0; ai < 2; ++ai)
#pragma unroll
            for (int m = 0; m < 4; ++m) { const int row = row0 + ai * HALF + m * 16;
                if (row < MTOT) {
                    const float* x = row < SEQ ? xp + (size_t)row * DM : xs + (size_t)(row - SEQ) * DM;
                    float* y = row < SEQ ? out + O_YP + (size_t)row * DM : out + O_YS + (size_t)(row - SEQ) * DM;
#pragma unroll
                    for (int bj = 0; bj < 2; ++bj) { const int c = pn * 256 + bj * HALF + c0;
                        *(f32x4*)(y + c) = *(const f32x4*)(x + c) + acc[ai][bj][m][0]; *(f32x4*)(y + c + 4) = *(const f32x4*)(x + c + 4) + acc[ai][bj][m][1]; } } }
    }
};
template <class Epi, class Sched, bool ALIGN_EPI = false, bool SP2 = false>
__device__ __forceinline__ void gemm_phase(PG8_LAS unsigned char* lds, const Gemm g, const Sched& S, const Epi& E) {
    int tid_ = threadIdx.x; asm volatile("" : "+v"(tid_));
    const int tid = tid_, wid = __builtin_amdgcn_readfirstlane(tid >> 6), lane = tid & 63, wr = wid >> 2, wc = wid & 3, fr = lane & 15, fq = lane >> 4;
    const int K = g.K, nt = K / BK;
    unsigned voffA[2], voffB[2];
#pragma unroll
    for (int i = 0; i < 2; ++i) { int R, C; stage_rc(tid * 16 + i * 8192, R, C); const int Rb = Epi::PERM ? ((R & ~31) + perm32(R & 31)) : R;
        voffA[i] = (unsigned)(R * g.lda + C) * 2u; voffB[i] = (unsigned)(Rb * g.ldb + C) * 2u; }
    const size_t kstep = (size_t)(BK * 2);
    const size_t hA = (size_t)HALF * g.lda * 2, hB = (size_t)HALF * g.ldb * 2;
    const size_t tA = 2 * hA, tB = 2 * hB, pA = (size_t)g.a_pn_off * 2;
    const unsigned ldsw = (unsigned)wid * 1024u;
    const int aoff = lds_byte(wr * 64 + fr, fq * 8), boff = lds_byte(wc * 32 + fr, fq * 8);
#define PG8_SA(b, h) (((b) * 2 + (h)) * HTB)
#define PG8_SB(b, h) ((4 + (b) * 2 + (h)) * HTB)
#define PG8_STAGE(bufoff, gbase, voff) do { _Pragma("unroll") for (int _i = 0; _i < 2; ++_i) \
        __builtin_amdgcn_global_load_lds((const unsigned*)((const char*)(gbase) + (voff)[_i]), (PG8_LAS unsigned*)(lds + (bufoff) + ldsw + _i * 8192), 16, 0, 0); } while (0)
#define PG8_LDA(dst, b, h) do { _Pragma("unroll") for (int m = 0; m < 4; ++m) _Pragma("unroll") for (int k = 0; k < 2; ++k) dst[m][k] = *(const PG8_LAS bf16x8*)(lds + PG8_SA(b, h) + aoff + m * 2048 + k * 1024); } while (0)
#define PG8_LDB(dst, b, h) do { _Pragma("unroll") for (int n = 0; n < 2; ++n) _Pragma("unroll") for (int k = 0; k < 2; ++k) dst[n][k] = *(const PG8_LAS bf16x8*)(lds + PG8_SB(b, h) + boff + n * 2048 + k * 1024); } while (0)
#define PG8_MMA(ai, bj, At, Bt) do { __builtin_amdgcn_s_setprio(1); _Pragma("unroll") for (int m = 0; m < 4; ++m) _Pragma("unroll") for (int n = 0; n < 2; ++n) _Pragma("unroll") for (int k = 0; k < 2; ++k) \
        acc[ai][bj][m][n] = __builtin_amdgcn_mfma_f32_16x16x32_bf16(Bt[n][k], At[m][k], acc[ai][bj][m][n], 0, 0, 0); __builtin_amdgcn_s_setprio(0); } while (0)
#define PG8_WAIT_V(n) asm volatile("s_waitcnt vmcnt(" #n ")" ::: "memory")
#define PG8_WAIT_L(n) asm volatile("s_waitcnt lgkmcnt(" #n ")" ::: "memory")
#define PG8_BAR __builtin_amdgcn_s_barrier()
#define PG8_SCHED __builtin_amdgcn_sched_barrier(0)
    Unit cur, nxt; int ui = 0;
    if (!S.next(0, cur)) return;
    f32x4 acc[2][2][4][2];
#pragma unroll
    for (int a = 0; a < 2; ++a)
#pragma unroll
        for (int b = 0; b < 2; ++b)
#pragma unroll
            for (int m = 0; m < 4; ++m)
#pragma unroll
                for (int n = 0; n < 2; ++n) acc[a][b][m][n] = (f32x4){0.f, 0.f, 0.f, 0.f};
    bf16x8 At[4][2], B0[2][2], B1[2][2];
    const char* cA = (const char*)g.A + (size_t)cur.pm * tA + (size_t)cur.pn * pA; const char* cB = (const char*)g.Bt + (size_t)cur.pn * tB;
    S.a_ready(cur);
    if constexpr (SP2) {
        PG8_STAGE(PG8_SB(0, 0), cB, voffB); PG8_STAGE(PG8_SB(0, 1), cB + hB, voffB); PG8_STAGE(PG8_SA(0, 0), cA, voffA); PG8_STAGE(PG8_SA(0, 1), cA + hA, voffA);
        if (wr == 1) PG8_BAR;
        PG8_WAIT_V(2); PG8_BAR;
        PG8_STAGE(PG8_SB(1, 0), cB + kstep, voffB); PG8_STAGE(PG8_SA(1, 0), cA + kstep, voffA); PG8_STAGE(PG8_SB(1, 1), cB + hB + kstep, voffB);
        PG8_WAIT_V(6); PG8_BAR;
    } else {
        PG8_STAGE(PG8_SB(0, 0), cB, voffB); PG8_STAGE(PG8_SA(0, 0), cA, voffA); PG8_STAGE(PG8_SB(0, 1), cB + hB, voffB); PG8_STAGE(PG8_SA(0, 1), cA + hA, voffA);
        if (wr == 1) PG8_BAR;
        PG8_WAIT_V(4); PG8_BAR;
        PG8_STAGE(PG8_SB(1, 0), cB + kstep, voffB); PG8_STAGE(PG8_SA(1, 0), cA + kstep, voffA); PG8_STAGE(PG8_SB(1, 1), cB + hB + kstep, voffB);
        PG8_WAIT_V(6); PG8_BAR;
    }
    for (;;) {
        const bool has_next = S.next(ui + 1, nxt);
        const char* nA = has_next ? (const char*)g.A + (size_t)nxt.pm * tA + (size_t)nxt.pn * pA : cA; const char* nB = has_next ? (const char*)g.Bt + (size_t)nxt.pn * tB : cB;
        for (int t = 0; t < nt; t += 2) {
            const bool last = (t == nt - 2);
            const char* a1 = cA + (size_t)(t + 1) * kstep;
            const char* a2 = last ? nA : cA + (size_t)(t + 2) * kstep; const char* b2 = last ? nB : cB + (size_t)(t + 2) * kstep;
            const char* a3 = a2 + kstep; const char* b3 = b2 + kstep;
            if (last && has_next) S.a_ready(nxt);
            if constexpr (SP2) {
            PG8_LDB(B0, 0, 0); PG8_LDB(B1, 0, 1); PG8_SCHED; PG8_LDA(At, 0, 0); PG8_STAGE(PG8_SA(1, 1), a1 + hA, voffA);
            PG8_WAIT_V(8); PG8_WAIT_L(0); PG8_BAR; PG8_MMA(0, 0, At, B0); PG8_MMA(0, 1, At, B1); PG8_BAR; PG8_SCHED;
            PG8_LDA(At, 0, 1); PG8_STAGE(PG8_SB(0, 0), b2, voffB); PG8_STAGE(PG8_SB(0, 1), b2 + hB, voffB); PG8_STAGE(PG8_SA(0, 0), a2, voffA);
            PG8_WAIT_V(8); PG8_WAIT_L(0); PG8_BAR; PG8_MMA(1, 0, At, B0); PG8_MMA(1, 1, At, B1); PG8_BAR; PG8_SCHED;
            PG8_LDB(B0, 1, 0); PG8_LDB(B1, 1, 1); PG8_SCHED; PG8_LDA(At, 1, 0); PG8_STAGE(PG8_SA(0, 1), a2 + hA, voffA);
            PG8_WAIT_V(8); PG8_WAIT_L(0); PG8_BAR; PG8_MMA(0, 0, At, B0); PG8_MMA(0, 1, At, B1); PG8_BAR; PG8_SCHED;
            PG8_LDA(At, 1, 1); PG8_STAGE(PG8_SB(1, 0), b3, voffB); PG8_STAGE(PG8_SB(1, 1), b3 + hB, voffB); PG8_STAGE(PG8_SA(1, 0), a3, voffA);
            PG8_WAIT_V(8); PG8_WAIT_L(0); PG8_BAR; PG8_MMA(1, 0, At, B0); PG8_MMA(1, 1, At, B1); PG8_BAR; PG8_SCHED;
            } else {
            PG8_LDB(B0, 0, 0); PG8_SCHED; PG8_LDA(At, 0, 0); PG8_STAGE(PG8_SA(1, 1), a1 + hA, voffA);
            PG8_WAIT_L(8); PG8_BAR; PG8_WAIT_L(0); PG8_MMA(0, 0, At, B0); PG8_BAR; PG8_SCHED;
            PG8_LDB(B1, 0, 1); PG8_STAGE(PG8_SB(0, 0), b2, voffB);
            PG8_BAR; PG8_WAIT_L(0); PG8_MMA(0, 1, At, B1); PG8_BAR;
            PG8_LDA(At, 0, 1); PG8_STAGE(PG8_SA(0, 0), a2, voffA);
            PG8_BAR; PG8_WAIT_L(0); PG8_MMA(1, 0, At, B0); PG8_BAR; PG8_SCHED;
            PG8_STAGE(PG8_SB(0, 1), b2 + hB, voffB);
            PG8_WAIT_V(6); PG8_BAR; PG8_MMA(1, 1, At, B1); PG8_BAR;
            PG8_LDB(B0, 1, 0); PG8_SCHED; PG8_LDA(At, 1, 0); PG8_STAGE(PG8_SA(0, 1), a2 + hA, voffA);
            PG8_WAIT_L(8); PG8_BAR; PG8_WAIT_L(0); PG8_MMA(0, 0, At, B0); PG8_BAR; PG8_SCHED;
            PG8_LDB(B1, 1, 1); PG8_STAGE(PG8_SB(1, 0), b3, voffB);
            PG8_BAR; PG8_WAIT_L(0); PG8_MMA(0, 1, At, B1); PG8_BAR;
            PG8_LDA(At, 1, 1); PG8_STAGE(PG8_SA(1, 0), a3, voffA);
            PG8_BAR; PG8_WAIT_L(0); PG8_MMA(1, 0, At, B0); PG8_BAR; PG8_SCHED;
            PG8_STAGE(PG8_SB(1, 1), b3 + hB, voffB);
            PG8_WAIT_V(6); PG8_BAR; PG8_MMA(1, 1, At, B1); PG8_BAR;
            }
        }
        if constexpr (ALIGN_EPI) { if (wr == 0) PG8_BAR; }
        if constexpr (!Epi::AFTER_DRAIN) { int l_; asm volatile("v_mbcnt_lo_u32_b32 %0, -1, 0\n\tv_mbcnt_hi_u32_b32 %0, -1, %0" : "=v"(l_));
            E(acc, cur, wr, wc, l_ & 15, l_ >> 4); S.done(cur); }
        if (!has_next) break;
#pragma unroll
        for (int a = 0; a < 2; ++a)
#pragma unroll
            for (int b = 0; b < 2; ++b)
#pragma unroll
                for (int m = 0; m < 4; ++m)
#pragma unroll
                    for (int n = 0; n < 2; ++n) acc[a][b][m][n] = (f32x4){0.f, 0.f, 0.f, 0.f};
        cur = nxt; cA = nA; cB = nB; ++ui;
        if constexpr (ALIGN_EPI) { if (wr == 1) PG8_BAR; }
    }
    PG8_WAIT_V(0);
    if constexpr (!ALIGN_EPI) { if (wr == 0) PG8_BAR; }
    PG8_BAR;
    if constexpr (Epi::AFTER_DRAIN) { E.fused(acc, cur, wr, wc, fr, fq, lds, wid, lane); S.done(cur); }
#undef PG8_SA
#undef PG8_SB
#undef PG8_STAGE
#undef PG8_LDA
#undef PG8_LDB
#undef PG8_MMA
#undef PG8_WAIT_V
#undef PG8_WAIT_L
#undef PG8_BAR
#undef PG8_SCHED
}
}
namespace att {
constexpr int SHM_K = 64 * 384, SHM_V = 64 * 256;
constexpr int L_V = 0, L_K = 2 * SHM_V, L_WS = L_K + 2 * SHM_K, L_QR = L_WS + NWAVES * 256, LDS_NEED = L_QR + NWAVES * 4096;
constexpr int DROW = 400, DIMG = 32 * DROW;
static_assert(LDS_NEED <= RING_BYTES && NWAVES * DIMG + 12 * 17 * 16 <= RING_BYTES, "attention LDS");
constexpr float THR2 = 8.f * 1.4426950408889634f;
__device__ __forceinline__ int crow(int r, int hi) { return (r & 3) + 8 * (r >> 2) + 4 * hi; }
__device__ __forceinline__ int v_st(int k, int c) { const int kk = (k & ~0xC) | ((k & 4) << 1) | ((k & 8) >> 1); return ((kk >> 3) * 4 + (c >> 5)) * 512 + ((kk & 7) * 32 + (c & 31)) * 2; }
__device__ __forceinline__ int v_rd_base(int lane) { return ((lane & 3) << 3) | (((lane >> 2) & 3) << 6) | (((lane >> 4) & 1) << 5) | (((lane >> 5) & 1) << 8); }
constexpr int v_rd_off(int d0, int ks, int half) { return d0 * 512 + ks * 4096 + half * 2048; }
__device__ __forceinline__ float pl_swap_max(float v) { auto rr = __builtin_amdgcn_permlane32_swap(__float_as_uint(v), __float_as_uint(v), false, false); return fmaxf(__uint_as_float(rr[0]), __uint_as_float(rr[1])); }
__device__ __forceinline__ float pl_swap_add(float v) { auto rr = __builtin_amdgcn_permlane32_swap(__float_as_uint(v), __float_as_uint(v), false, false); return __uint_as_float(rr[0]) + __uint_as_float(rr[1]); }
#define ATT_PK4(P, B_, OUT) do { unsigned a0 = cvtpk(P[B_+0], P[B_+1]), a1 = cvtpk(P[B_+2], P[B_+3]);                          \
        unsigned b0 = cvtpk(P[B_+4], P[B_+5]), b1 = cvtpk(P[B_+6], P[B_+7]);                                             \
        auto r0 = __builtin_amdgcn_permlane32_swap(a0, b0, false, false); auto r1 = __builtin_amdgcn_permlane32_swap(a1, b1, false, false); \
        u32x4 w = {r0[0], r1[0], r0[1], r1[1]}; OUT = __builtin_bit_cast(bf16x8, w); } while (0)
#define ATT_TRRD(dst, addr, off) asm volatile("ds_read_b64_tr_b16 %0, %1 offset:%2" : "=&v"(dst) : "v"(addr), "i"(off) : "memory")
#define ATT_PK(L, H) ((bf16x8){L[0], L[1], L[2], L[3], H[0], H[1], H[2], H[3]})

__device__ __forceinline__ void mask_tile(f32x16& p0, f32x16& p1, int dq) {
    const float NEG = -__builtin_inff();
#pragma unroll
    for (int r = 0; r < 16; ++r) { const int c = (r & 3) + 8 * (r >> 2);
        if (dq - c < 0) p0[r] = NEG;
        if (dq - c - 32 < 0) p1[r] = NEG; }
}
__device__ __forceinline__ void partialSM(f32x16& p0, f32x16& p1, float& m_reg, float& alpha) {
    float pmax = p0[0];
#pragma unroll
    for (int r = 1; r < 16; ++r) pmax = fmaxf(pmax, p0[r]);
#pragma unroll
    for (int r = 0; r < 16; ++r) pmax = fmaxf(pmax, p1[r]);
    pmax = pl_swap_max(pmax);
    float mn;
    if (__builtin_expect(__all(pmax - m_reg <= THR2), 1)) { mn = m_reg; alpha = 1.f; }
    else { mn = fmaxf(m_reg, pmax); alpha = __builtin_amdgcn_exp2f(m_reg - mn); m_reg = mn; }
#pragma unroll
    for (int r = 0; r < 16; ++r) p0[r] = __builtin_amdgcn_exp2f(p0[r] - mn);
#pragma unroll
    for (int r = 0; r < 16; ++r) p1[r] = p1[r] - mn;
}
__device__ __forceinline__ void finishSM(f32x16& p0, f32x16& p1, float alpha, float& l_reg, bf16x8& pa0, bf16x8& pa1, bf16x8& pa2, bf16x8& pa3) {
#pragma unroll
    for (int r = 0; r < 16; ++r) p1[r] = __builtin_amdgcn_exp2f(p1[r]);
    float ps = 0.f;
#pragma unroll
    for (int r = 0; r < 16; ++r) ps += p0[r];
#pragma unroll
    for (int r = 0; r < 16; ++r) ps += p1[r];
    ps = pl_swap_add(ps);
    l_reg = l_reg * alpha + ps;
    ATT_PK4(p0, 0, pa0); ATT_PK4(p0, 8, pa1); ATT_PK4(p1, 0, pa2); ATT_PK4(p1, 8, pa3);
}
template <int KB>
__device__ __forceinline__ void qkt(f32x16& p0, f32x16& p1, const LAS unsigned char* lds, int r32, int hi, const bf16x8* qr, const LAS unsigned char* qlds) {
    p0 = f32x16{}; p1 = f32x16{};
    const int sw = ((r32 >> 1) & 7) << 4;
    const LAS unsigned char* kb[4];
#pragma unroll
    for (int dd = 0; dd < 4; ++dd) kb[dd] = lds + L_K + KB * SHM_K + r32 * 384 + ((dd * 32 + hi * 16) ^ sw);
#pragma unroll
    for (int d0 = 0; d0 < 12; ++d0) { const LAS unsigned char* a = kb[d0 & 3] + (d0 >> 2) * 128;
        const bf16x8 b0 = *(const LAS bf16x8*)a, b1 = *(const LAS bf16x8*)(a + 32 * 384);
        const bf16x8 qf = d0 < 8 ? qr[d0 & 7] : *(const LAS bf16x8*)(qlds + (d0 - 8) * 1024);
        p0 = __builtin_amdgcn_mfma_f32_32x32x16_bf16(b0, qf, p0, 0, 0, 0);
        p1 = __builtin_amdgcn_mfma_f32_32x32x16_bf16(b1, qf, p1, 0, 0, 0); }
}
template <int VB>
__device__ __forceinline__ void pv_tile(f32x16* o, int vb0, bf16x8 pa0, bf16x8 pa1, bf16x8 pa2, bf16x8 pa3) {
#define ATT_PV_D0(d0) do { s16x4 l0, l1, l2, l3, h0, h1, h2, h3; constexpr int b_ = L_V + VB * SHM_V + v_rd_off(d0, 0, 0); \
        ATT_TRRD(l0, vb0, b_); ATT_TRRD(h0, vb0, b_ + 2048); ATT_TRRD(l1, vb0, b_ + 4096); ATT_TRRD(h1, vb0, b_ + 6144); ATT_TRRD(l2, vb0, b_ + 8192); ATT_TRRD(h2, vb0, b_ + 10240); ATT_TRRD(l3, vb0, b_ + 12288); ATT_TRRD(h3, vb0, b_ + 14336); \
        asm volatile("s_waitcnt lgkmcnt(0)" ::: "memory"); SBAR(); \
        o[d0] = __builtin_amdgcn_mfma_f32_32x32x16_bf16(pa0, ATT_PK(l0, h0), o[d0], 0, 0, 0); \
        o[d0] = __builtin_amdgcn_mfma_f32_32x32x16_bf16(pa1, ATT_PK(l1, h1), o[d0], 0, 0, 0); \
        o[d0] = __builtin_amdgcn_mfma_f32_32x32x16_bf16(pa2, ATT_PK(l2, h2), o[d0], 0, 0, 0); \
        o[d0] = __builtin_amdgcn_mfma_f32_32x32x16_bf16(pa3, ATT_PK(l3, h3), o[d0], 0, 0, 0); } while (0)
    ATT_PV_D0(0); ATT_PV_D0(1); ATT_PV_D0(2); ATT_PV_D0(3);
#undef ATT_PV_D0
}

__device__ __forceinline__ void prompt_unit(int q0, const bf16* __restrict__ QA, const bf16* __restrict__ QR, const bf16* __restrict__ KBm, bf16* __restrict__ OL, LAS unsigned char* lds, int tid, int wid, int lane) {
    const int r32 = lane & 31, hi = lane >> 5;
    const int NT = (q0 >> 6) + 1;
    bf16x8 qr[8];
    LAS unsigned char* qlds = lds + L_QR + wid * 4096 + lane * 16;
    { const bf16* qa = QA + (size_t)(q0 + r32) * ATTW + wid * NOPE + hi * 8; const bf16* qq = QR + (size_t)(q0 + r32) * (NH * ROPE) + wid * ROPE + hi * 8;
#pragma unroll
      for (int d0 = 0; d0 < 8; ++d0) qr[d0] = *(const bf16x8*)(qa + d0 * 16);
#pragma unroll
      for (int d0 = 0; d0 < 4; ++d0) *(LAS bf16x8*)(qlds + d0 * 1024) = *(const bf16x8*)(qq + d0 * 16); }
    LAS float* wsf = (LAS float*)(lds + L_WS) + wid * 64; LAS float* li_l = wsf; LAS float* al_l = wsf + 32;
    float m_reg = -1e30f, l_reg = 0.f; f32x16 o[4] = {};
    const int skey = tid >> 3, sc8 = tid & 7;
    const int kw0 = skey * 384 + ((sc8 * 16) ^ (((skey >> 1) & 7) << 4));
    const int vw0 = v_st(skey, sc8 * 8);
    const int vb0 = (int)(uintptr_t)lds + v_rd_base(lane);
    const int qm = q0 + r32 - 4 * hi;
    const bf16* ksrc = KBm + (size_t)skey * QKD + sc8 * 8;
    bf16x8 st0, st1, st2;
#define ATT_SLOAD(t) do { const bf16* p_ = ksrc + (size_t)(t) * (64 * QKD); st0 = *(const bf16x8*)p_; st1 = *(const bf16x8*)(p_ + 64); st2 = *(const bf16x8*)(p_ + 128); } while (0)
#define ATT_SWRITE(bf) do { LAS unsigned char* k_ = lds + L_K + (bf) * SHM_K + kw0; *(LAS bf16x8*)k_ = st0; *(LAS bf16x8*)(k_ + 128) = st1; *(LAS bf16x8*)(k_ + 256) = st2; \
        LAS unsigned char* v_ = lds + L_V + (bf) * SHM_V + vw0; *(LAS bf16x8*)v_ = st0; *(LAS bf16x8*)(v_ + 1024) = st1; } while (0)
#define ATT_RESC(a) do { if (__any((a) < 1.f)) { if (hi == 0) al_l[r32] = (a); LDS_WAIT(); \
        _Pragma("unroll") for (int d_ = 0; d_ < 4; ++d_) _Pragma("unroll") for (int r = 0; r < 16; ++r) o[d_][r] *= al_l[crow(r, hi)]; } } while (0)
#define ATT_MASKT(P0_, P1_, t) do { if ((t) == NT - 1) mask_tile(P0_, P1_, qm - 64 * (t)); } while (0)
    f32x16 pA0, pA1, pB0, pB1; float alA, alB; bf16x8 pa0, pa1, pa2, pa3;
    ATT_SLOAD(0); VM_WAIT(); ATT_SWRITE(0); SBAR();
    if (NT > 1) ATT_SLOAD(1);
    __syncthreads();
    SBAR(); qkt<0>(pA0, pA1, lds, r32, hi, qr, qlds);
    ATT_MASKT(pA0, pA1, 0); partialSM(pA0, pA1, m_reg, alA);
    if (NT > 1) { VM_WAIT(); ATT_SWRITE(1); }
    __syncthreads();
#define ATT_HALF_STEP(PX0, PX1, alX, PY0, PY1, alY, t, KB, VB, SB) do {                                          \
        SBAR(); qkt<KB>(PX0, PX1, lds, r32, hi, qr, qlds);                                                         \
        finishSM(PY0, PY1, alY, l_reg, pa0, pa1, pa2, pa3); SBAR();                                              \
        if ((t) + 1 < NT) { ATT_SLOAD((t) + 1); SBAR(); }                                                        \
        pv_tile<VB>(o, vb0, pa0, pa1, pa2, pa3); ATT_MASKT(PX0, PX1, (t)); partialSM(PX0, PX1, m_reg, alX);      \
        __syncthreads();                                                                                         \
        if ((t) + 1 < NT) { VM_WAIT(); ATT_SWRITE(SB); }                                                         \
        ATT_RESC(alX); __syncthreads(); } while (0)
    for (int t = 1; t + 1 < NT; t += 2) {
        ATT_HALF_STEP(pB0, pB1, alB, pA0, pA1, alA, t, 1, 0, 0);
        ATT_HALF_STEP(pA0, pA1, alA, pB0, pB1, alB, t + 1, 0, 1, 1);
    }
    const bool even = (NT & 1) == 0;
    if (even) { SBAR(); qkt<1>(pB0, pB1, lds, r32, hi, qr, qlds); SBAR(); }
    finishSM(pA0, pA1, alA, l_reg, pa0, pa1, pa2, pa3); SBAR();
    pv_tile<0>(o, vb0, pa0, pa1, pa2, pa3);
    if (even) { ATT_MASKT(pB0, pB1, NT - 1); partialSM(pB0, pB1, m_reg, alB); ATT_RESC(alB);
        finishSM(pB0, pB1, alB, l_reg, pa0, pa1, pa2, pa3); SBAR(); pv_tile<1>(o, vb0, pa0, pa1, pa2, pa3); }
    if (hi == 0) li_l[r32] = l_reg; LDS_WAIT();
    float rli[16];
#pragma unroll
    for (int r = 0; r < 16; ++r) rli[r] = __builtin_amdgcn_rcpf(li_l[crow(r, hi)]);
    bf16* Ow = OL + (size_t)q0 * GW + wid * VD;
#pragma unroll
    for (int r = 0; r < 16; ++r) { const int orow = crow(r, hi);
#pragma unroll
        for (int d0 = 0; d0 < 4; ++d0) { const float v = o[d0][r] * rli[r]; const float vn = __shfl_xor(v, 1);
            if ((r32 & 1) == 0) *(unsigned*)(Ow + (size_t)orow * GW + d0 * 32 + r32) = cvtpk(v, vn); } }
    __syncthreads();
#undef ATT_SLOAD
#undef ATT_SWRITE
#undef ATT_RESC
#undef ATT_MASKT
#undef ATT_HALF_STEP
}

__device__ __forceinline__ void decode_item(int item, const float* __restrict__ cckv, const float* __restrict__ ckr, const int* __restrict__ ptab, const bf16* __restrict__ QA, const bf16* __restrict__ QR,
                                            float* __restrict__ DPART, LAS unsigned char* lds, int tid, int wid, int lane) {
    constexpr int PPI = NPG / DSPLIT, NSTEP = 4 * PPI / NWAVES;
    const int b = item / DSPLIT, part = item % DSPLIT, r32 = lane & 31, hi = lane >> 5;
    constexpr int QOFF = NWAVES * DIMG, QSTR = 17 * 16;
    if (wid == 0) { const size_t qrow = (size_t)(SEQ + b);
        if (r32 < 8) { const bf16* qa = QA + qrow * ATTW + r32 * NOPE + hi * 8; const bf16* qq = QR + qrow * (NH * ROPE) + r32 * ROPE + hi * 8; LAS unsigned char* d = lds + QOFF + (hi * 8 + r32) * 16;
#pragma unroll
            for (int d0 = 0; d0 < 8; ++d0) *(LAS bf16x8*)(d + d0 * QSTR) = *(const bf16x8*)(qa + d0 * 16);
#pragma unroll
            for (int d0 = 0; d0 < 4; ++d0) *(LAS bf16x8*)(d + (8 + d0) * QSTR) = *(const bf16x8*)(qq + d0 * 16); }
        else if (lane == 8) { const bf16x8 z = {0, 0, 0, 0, 0, 0, 0, 0};
#pragma unroll
            for (int d0 = 0; d0 < 12; ++d0) *(LAS bf16x8*)(lds + QOFF + 256 + d0 * QSTR) = z; } }
    __syncthreads();
    const LAS unsigned char* qsl = lds + QOFF + (r32 < 8 ? (hi * 8 + r32) * 16 : 256);
    LAS unsigned char* img = lds + wid * DIMG;
    const int kaddr = r32 * DROW + 16 * hi;
    const int vaddr = (int)(uintptr_t)img + (8 * (lane >> 5) + ((lane >> 2) & 3)) * DROW + (16 * ((lane >> 4) & 1) + 4 * (lane & 3)) * 2;
    const int woA = (lane >> 5) * DROW + (lane & 31) * 8, woB = (lane >> 4) * DROW + 256 + (lane & 15) * 8;
    float m_reg = -1e30f, l_reg = 0.f; f32x16 o[4] = {};
    f32x4 sa[16], sb[8];
#define DEC_LOAD(s_) do { const int pg_ = PPI * part + wid + 8 * ((s_) >> 2); const int phys_ = __builtin_amdgcn_readfirstlane(ptab[b * NPG + pg_]); \
        const float* pc_ = cckv + (size_t)phys_ * (PAGE * KVR) + ((s_) & 3) * (32 * KVR) + lane * 4; const float* pk_ = ckr + (size_t)phys_ * (PAGE * ROPE) + ((s_) & 3) * (32 * ROPE) + lane * 4; \
        _Pragma("unroll") for (int i = 0; i < 16; ++i) sa[i] = __builtin_nontemporal_load((const f32x4*)(pc_ + i * 256)); \
        _Pragma("unroll") for (int i = 0; i < 8; ++i) sb[i] = __builtin_nontemporal_load((const f32x4*)(pk_ + i * 256)); } while (0)
    DEC_LOAD(0);
    for (int s = 0; s < NSTEP; ++s) {
#pragma unroll
        for (int i = 0; i < 16; ++i) *(LAS u32x2*)(img + woA + i * (2 * DROW)) = (u32x2){cvtpk(sa[i][0], sa[i][1]), cvtpk(sa[i][2], sa[i][3])};
#pragma unroll
        for (int i = 0; i < 8; ++i) *(LAS u32x2*)(img + woB + i * (4 * DROW)) = (u32x2){cvtpk(sb[i][0], sb[i][1]), cvtpk(sb[i][2], sb[i][3])};
        SBAR();
        if (s + 1 < NSTEP) DEC_LOAD(s + 1);
        SBAR();
        f32x16 p0 = {};
#pragma unroll
        for (int d0 = 0; d0 < 12; ++d0) { const bf16x8 a = *(const LAS bf16x8*)(img + kaddr + 32 * d0); const bf16x8 qf = *(const LAS bf16x8*)(qsl + d0 * QSTR); p0 = __builtin_amdgcn_mfma_f32_32x32x16_bf16(a, qf, p0, 0, 0, 0); }
        float pmax = p0[0];
#pragma unroll
        for (int r = 1; r < 16; ++r) pmax = fmaxf(pmax, p0[r]);
        pmax = pl_swap_max(pmax);
        float mn, alpha;
        if (__builtin_expect(__all(pmax - m_reg <= THR2), 1)) { mn = m_reg; alpha = 1.f; }
        else { mn = fmaxf(m_reg, pmax); alpha = __builtin_amdgcn_exp2f(m_reg - mn); m_reg = mn; }
        float ps = 0.f;
#pragma unroll
        for (int r = 0; r < 16; ++r) { p0[r] = __builtin_amdgcn_exp2f(p0[r] - mn); ps += p0[r]; }
        ps = pl_swap_add(ps);
        l_reg = l_reg * alpha + ps;
        bf16x8 pa0, pa1; ATT_PK4(p0, 0, pa0); ATT_PK4(p0, 8, pa1);
        if (__any(alpha < 1.f)) {
#pragma unroll
            for (int r = 0; r < 4; ++r) { const float a = __shfl(alpha, r + 4 * hi);
#pragma unroll
                for (int d = 0; d < 4; ++d) o[d][r] *= a; } }
#define DEC_PV_D0(d0) do { s16x4 l0, h0, l1, h1; ATT_TRRD(l0, vaddr, (d0) * 64); ATT_TRRD(h0, vaddr, (d0) * 64 + 4 * DROW); ATT_TRRD(l1, vaddr, (d0) * 64 + 16 * DROW); ATT_TRRD(h1, vaddr, (d0) * 64 + 20 * DROW); \
        asm volatile("s_waitcnt lgkmcnt(0)" ::: "memory"); SBAR(); \
        o[d0] = __builtin_amdgcn_mfma_f32_32x32x16_bf16(pa0, ATT_PK(l0, h0), o[d0], 0, 0, 0); \
        o[d0] = __builtin_amdgcn_mfma_f32_32x32x16_bf16(pa1, ATT_PK(l1, h1), o[d0], 0, 0, 0); } while (0)
        DEC_PV_D0(0); DEC_PV_D0(1); DEC_PV_D0(2); DEC_PV_D0(3);
#undef DEC_PV_D0
        asm volatile("" ::: "memory");
    }
#undef DEC_LOAD
    LDS_WAIT();
    { LAS float* Ow = (LAS float*)img; LAS float* ml = (LAS float*)(img + 4096);
#pragma unroll
      for (int r = 0; r < 4; ++r)
#pragma unroll
          for (int d = 0; d < 4; ++d) Ow[(r + 4 * hi) * VD + d * 32 + r32] = o[d][r];
      if (lane < 8) { ml[2 * lane] = m_reg; ml[2 * lane + 1] = l_reg; } }
    __syncthreads();
    { const int head = tid >> 6, c = tid & 63; float M = -1e30f;
#pragma unroll
      for (int w = 0; w < NWAVES; ++w) M = fmaxf(M, ((LAS float*)(lds + w * DIMG + 4096))[2 * head]);
      float L = 0.f, O0 = 0.f, O1 = 0.f;
#pragma unroll
      for (int w = 0; w < NWAVES; ++w) { LAS float* ml = (LAS float*)(lds + w * DIMG + 4096); LAS float* Ow = (LAS float*)(lds + w * DIMG) + head * VD;
          const float f = __builtin_amdgcn_exp2f(ml[2 * head] - M); L += ml[2 * head + 1] * f; O0 += Ow[c] * f; O1 += Ow[c + 64] * f; }
      float* dp = DPART + ((size_t)item * NH + head) * 130; dp[c] = O0; dp[c + 64] = O1; if (c == 0) { dp[128] = M; dp[129] = L; } }
    __syncthreads();
}
}
#define XB_TMO      128
#define XB_XCNT(j)  (256  + 64 * (j))
#define XB_XSUB(j)  (1280 + 64 * (j))
#define XB_XGEN(j)  (2304 + 64 * (j))
#define XB_TOP      3328
#define XB_TOPGEN   3392
#define XCD_BAR_WORDS 3456
#define XB_SPIN_CAP (1u << 18)

__device__ __forceinline__ unsigned xb_ld(unsigned* p)              { return __hip_atomic_load(p, __ATOMIC_RELAXED, __HIP_MEMORY_SCOPE_AGENT); }
__device__ __forceinline__ unsigned xb_add(unsigned* p, unsigned v) { return __hip_atomic_fetch_add(p, v, __ATOMIC_RELAXED, __HIP_MEMORY_SCOPE_AGENT); }
__device__ __forceinline__ unsigned xb_xcc_id() { return (unsigned)__builtin_amdgcn_s_getreg((3 << 11) | 20) & 0xFu; }
#define XB_SPIN(cond, bar) do { unsigned _sp = 0; while (cond) { __builtin_amdgcn_s_sleep(1); \
    if ((++_sp & 255u) == 0u) { if (xb_ld(&(bar)[XB_TMO])) break; if (_sp > XB_SPIN_CAP) { atomicAdd(&(bar)[XB_TMO], 1u); break; } } } } while (0)

struct XcdBarrier {
    unsigned* bar; unsigned x;
    volatile LAS unsigned* st;
};

__device__ __forceinline__ XcdBarrier xcd_barrier_post(unsigned* bar, volatile LAS unsigned* st) {
    XcdBarrier b; b.bar = bar; b.x = xb_xcc_id(); b.st = st;
    if (threadIdx.x == 0) (void)xb_add(&bar[XB_XCNT(b.x)], 1u);
    return b;
}
__device__ __forceinline__ void xcd_barrier_complete(unsigned* bar, unsigned x, unsigned& nloc, unsigned& nx) {
    const unsigned G = gridDim.x * gridDim.y * gridDim.z;
    unsigned sum, cnt, mine, sp = 0u;
    for (;;) {
        sum = 0u; cnt = 0u; mine = 0u;
#pragma unroll
        for (unsigned j = 0; j < 16; ++j) { const unsigned c = xb_ld(&bar[XB_XCNT(j)]); sum += c; cnt += (c > 0u) ? 1u : 0u; mine = (j == x) ? c : mine; }
        if (sum == G) break;
        __builtin_amdgcn_s_sleep(1);
        if ((++sp & 255u) == 0u) { if (xb_ld(&bar[XB_TMO])) break; if (sp > XB_SPIN_CAP) { atomicAdd(&bar[XB_TMO], 1u); break; } }
    }
    nloc = mine > 0u ? mine : 1u; nx = cnt > 0u ? cnt : 1u;
}

__device__ __forceinline__ void xcd_barrier(const XcdBarrier& b) {
    asm volatile("s_waitcnt vmcnt(0)" ::: "memory");
    __syncthreads();
    if (threadIdx.x == 0) {
        unsigned* bar = b.bar;
        __builtin_amdgcn_s_waitcnt(0);
        unsigned nloc = b.st[0], nx = b.st[1];
        if (nloc == 0u) { xcd_barrier_complete(bar, b.x, nloc, nx); b.st[0] = nloc; b.st[1] = nx; }
        const unsigned old = xb_add(&bar[XB_XSUB(b.x)], 1u);
        const unsigned gen = old / nloc;
        if (old + 1u == (gen + 1u) * nloc) {
            __builtin_amdgcn_fence(__ATOMIC_RELEASE, "agent");
            asm volatile("s_waitcnt vmcnt(0)" ::: "memory");
            const unsigned og = xb_add(&bar[XB_TOP], 1u);
            const unsigned tg = og / nx;
            if (og + 1u == (tg + 1u) * nx) xb_add(&bar[XB_TOPGEN], 1u);
            else XB_SPIN(xb_ld(&bar[XB_TOPGEN]) == tg, bar);
            __builtin_amdgcn_fence(__ATOMIC_ACQUIRE, "agent");
            xb_add(&bar[XB_XGEN(b.x)], 1u);
            asm volatile("s_waitcnt vmcnt(0)" ::: "memory");
        } else {
            XB_SPIN(xb_ld(&bar[XB_XGEN(b.x)]) == gen, bar);
            __builtin_amdgcn_fence(__ATOMIC_ACQUIRE, "agent");
            asm volatile("s_waitcnt vmcnt(0)" ::: "memory");
        }
    }
    __syncthreads();
}

struct Args { const float* in[19]; float* out; unsigned char* ws; int ph_lo, ph_hi; };
enum { I_XP = 0, I_XS, I_CKV, I_CKR, I_SPOOL, I_PTAB, I_GPRE, I_WIN, I_GQ, I_WUQ, I_GKV, I_WUK, I_WUV, I_WOATT, I_WPOOL, I_PSCALE, I_WOPOOL, I_WOUT, I_GFINAL };
constexpr int N_PHASES = 9;

__device__ __forceinline__ void p0_transpose_item(const float* __restrict__ W, int K, int N, bf16* __restrict__ WT, int row_off, LAS float* scr, int item, int lane) {
    const int nblk = N / 32, kb = item / nblk, nb = item % nblk, k0 = 64 * kb, n0 = 32 * nb;
#pragma unroll 8
    for (int i = 0; i < 32; ++i) { const int kk = 2 * i + (lane >> 5); scr[kk * 33 + (lane & 31)] = W[(size_t)(k0 + kk) * N + n0 + (lane & 31)]; }
    LDS_WAIT(); asm volatile("" ::: "memory");
    const int c = lane & 7;
#pragma unroll
    for (int j = 0; j < 4; ++j) { const int n = (lane >> 3) + 8 * j; const LAS float* s = scr + (8 * c) * 33 + n;
        u32x4 o; o.x = cvtpk(s[0 * 33], s[1 * 33]); o.y = cvtpk(s[2 * 33], s[3 * 33]); o.z = cvtpk(s[4 * 33], s[5 * 33]); o.w = cvtpk(s[6 * 33], s[7 * 33]);
        *(u32x4*)(WT + (size_t)(row_off + n0 + n) * K + k0 + 8 * c) = o; }
    LDS_WAIT(); asm volatile("" ::: "memory");
}


#define PHASE_ARGS() \
    int tid_ = threadIdx.x; asm volatile("" : "+v"(tid_)); const int tid = tid_, lane = tid & 63, wave = __builtin_amdgcn_readfirstlane(tid >> 6); (void)lane; \
    const __attribute__((address_space(4))) Args* ap_ = (const __attribute__((address_space(4))) Args*)__builtin_amdgcn_kernarg_segment_ptr(); asm volatile("" : "+s"(ap_)); const __attribute__((address_space(4))) Args& args = *ap_; \
    unsigned char* ws = args.ws; float* out = args.out; (void)out; \
    bf16* BT1 = (bf16*)(ws + WS_BT1); bf16* BTQ = (bf16*)(ws + WS_BTQ); bf16* BTG = (bf16*)(ws + WS_BTG); bf16* BTOA = (bf16*)(ws + WS_BTOA); bf16* BTOP = (bf16*)(ws + WS_BTOP); bf16* BTOUT = (bf16*)(ws + WS_BTOUT); \
    float* ROPET = (float*)(ws + WS_ROPE); float* QSS = (float*)(ws + WS_QSS); float* DPART = (float*)(ws + WS_DPART); \
    bf16* H = (bf16*)(ws + WS_H); bf16* QLAT = (bf16*)(ws + WS_QLAT); float* KVRAW = (float*)(ws + WS_KVRAW); bf16* KB = (bf16*)(ws + WS_KB); bf16* SZ = (bf16*)(ws + WS_SZ); \
    float* U = (float*)(ws + WS_U); bf16* SGA = (bf16*)(ws + WS_SGA); bf16* SGP = (bf16*)(ws + WS_SGP); bf16* OLPL = (bf16*)(ws + WS_OLPL); bf16* QA = (bf16*)(ws + WS_QA); bf16* QR = (bf16*)(ws + WS_QR); \
    bf16* G12 = (bf16*)(ws + WS_G12); float* M1 = (float*)(ws + WS_M1); bf16* MG = (bf16*)(ws + WS_MG); \
    (void)BT1; (void)BTQ; (void)BTG; (void)BTOA; (void)BTOP; (void)BTOUT; (void)ROPET; (void)QSS; (void)DPART; (void)H; (void)QLAT; (void)KVRAW; (void)KB; (void)SZ; (void)U; (void)SGA; (void)SGP; (void)OLPL; (void)QA; (void)QR; (void)G12; (void)M1; (void)MG; \
    const int G = gridDim.x, bx = blockIdx.x; const int vcu = (G % 8 == 0) ? (bx % 8) * (G / 8) + bx / 8 : bx; const int gw = vcu * NWAVES + wave, NGW = G * NWAVES; (void)gw; (void)NGW;

__global__ void __launch_bounds__(NWAVES * 64, 2) mk_fwd(Args args_in) {
    extern __shared__ __attribute__((aligned(16))) unsigned char lds_raw[];
    LAS unsigned char* lds = (LAS unsigned char*)lds_raw;
    volatile LAS unsigned* MISC = (volatile LAS unsigned*)(lds + MISC_OFF);
    for (int u = threadIdx.x; u < (LDS_BYTES - LDSCTL_OFF) / 4; u += NWAVES * 64) ((LAS unsigned*)(lds + LDSCTL_OFF))[u] = 0u;
    __syncthreads();
    const int lo = args_in.ph_lo, hi = args_in.ph_hi;
    XcdBarrier bar = xcd_barrier_post((unsigned*)(args_in.ws + WS_CTL) + CW_BAR + lo * XCD_BAR_WORDS, MISC + 8);
#ifndef PH_MASK
#define PH_MASK 0x1ff
#endif
#define IN(k) (((PH_MASK >> (k)) & 1) && lo <= (k) && (k) < hi)
#define SEAM(k) do { if (IN(k) && IN((k) + 1)) xcd_barrier(bar); } while (0)

    if (IN(0)) { PHASE_ARGS()
        LAS float* scr = (LAS float*)(lds + RING_OFF + wave * 16384);
        { constexpr int I_1 = (DM / 64) * (INC / 32), I_OA = (ATTW / 64) * (DM / 32), I_OP = (POOLW / 64) * (DM / 32), I_OUT = (DM / 64) * (DM / 32), NIT = I_1 + I_OA + I_OP + I_OUT;
          for (int it = gw; it < NIT; it += NGW) { int r = it;
              if (r < I_1) { const int nb = r % (INC / 32); p0_transpose_item(args.in[I_WIN], DM, INC, BT1, (32 * nb >= 448) ? 64 : 0, scr, r, lane); continue; } r -= I_1;
              if (r < I_OA) { p0_transpose_item(args.in[I_WOATT], ATTW, DM, BTOA, 0, scr, r, lane); continue; } r -= I_OA;
              if (r < I_OP) { p0_transpose_item(args.in[I_WOPOOL], POOLW, DM, BTOP, 0, scr, r, lane); continue; } r -= I_OP;
              p0_transpose_item(args.in[I_WOUT], DM, DM, BTOUT, 0, scr, r, lane); } }
        for (int i = bx * 512 + tid; i < 64 * DM / 8; i += G * 512) *(u32x4*)(BT1 + (size_t)448 * DM + (size_t)i * 8) = (u32x4){0u, 0u, 0u, 0u};
        for (int it = gw; it < 1536; it += NGW) {
            const float* wuq = args.in[I_WUQ]; const float* gq = args.in[I_GQ];
            if (it < 1024) { const int h = it >> 7, r = it & 127; const float* uk = args.in[I_WUK] + ((size_t)r * NH + h) * NOPE;
                float a[4] = {0.f, 0.f, 0.f, 0.f};
                for (int n = 0; n < NOPE; n += 4) { const f32x4 k4 = *(const f32x4*)(uk + n);
#pragma unroll
                    for (int j = 0; j < 4; ++j) { const f32x4 q4 = *(const f32x4*)(wuq + (size_t)(lane + 64 * j) * (NH * (NOPE + ROPE)) + h * (NOPE + ROPE) + n);
                        a[j] += (q4[0] * k4[0] + q4[1] * k4[1]) + (q4[2] * k4[2] + q4[3] * k4[3]); } }
#pragma unroll
                for (int j = 0; j < 4; ++j) { const int k = lane + 64 * j; BTQ[(size_t)it * QRANK + k] = (bf16)(cvtpk(a[j] * gq[k], 0.f) & 0xffffu); }
            } else { const int j2 = it - 1024, pn = j2 >> 8, jj = j2 & 255, bj = jj >> 7, x = jj & 127, head = 4 * pn + (x >> 5), dim = (x & 31) + 32 * bj;
#pragma unroll
                for (int j = 0; j < 4; ++j) { const int k = lane + 64 * j; BTQ[(size_t)it * QRANK + k] = (bf16)(cvtpk(gq[k] * wuq[(size_t)k * (NH * (NOPE + ROPE)) + head * (NOPE + ROPE) + NOPE + dim], 0.f) & 0xffffu); } }
        }
        for (int it = gw; it < 1536; it += NGW) {
#pragma unroll
            for (int j = 0; j < 4; ++j) { const int kk = lane + 64 * j; float v = 0.f;
                if (it < 1024) { const int h = it >> 7, vv = it & 127; if ((kk >> 7) == (h & 1)) v = args.in[I_WUV][((size_t)(kk & 127) * NH + h) * VD + vv]; }
                else { const int n = it - 1024, g = n >> 7, d = n & 127; if ((kk >> 7) == (g & 1)) v = args.in[I_WPOOL][((size_t)g * 128 + (kk & 127)) * 128 + d]; }
                BTG[(size_t)it * 256 + kk] = (bf16)(cvtpk(v, 0.f) & 0xffffu); }
        }
        for (int e = gw * 64 + lane; e < (SEQ + 1) * 32; e += NGW * 64) { const int pos = e >> 5, i = e & 31;
            const float inv = powf(10000.0f, -(float)i / 32.0f); const float ang = (float)pos * inv;
            ROPET[2 * (size_t)e] = (float)cos((double)ang); ROPET[2 * (size_t)e + 1] = (float)sin((double)ang); }
        for (int m = gw; m < MTOT; m += NGW) {
            const float* xrow = m < SEQ ? args.in[I_XP] + (size_t)m * DM : args.in[I_XS] + (size_t)(m - SEQ) * DM;
            const f32x4* xr = (const f32x4*)xrow + lane; const f32x4* gr = (const f32x4*)args.in[I_GPRE] + lane;
            f32x4 v[4]; float s = 0.f;
#pragma unroll
            for (int j = 0; j < 4; ++j) { v[j] = xr[64 * j]; s += (v[j][0] * v[j][0] + v[j][1] * v[j][1]) + (v[j][2] * v[j][2] + v[j][3] * v[j][3]); }
            const float rs = 1.0f / sqrtf(wave_sum(s) * (1.f / DM) + EPS);
            unsigned long long* o8 = (unsigned long long*)(H + (size_t)m * DM) + lane;
#pragma unroll
            for (int j = 0; j < 4; ++j) { const f32x4 g = gr[64 * j]; o8[64 * j] = (unsigned long long)cvtpk(v[j][0] * rs * g[0], v[j][1] * rs * g[1]) | ((unsigned long long)cvtpk(v[j][2] * rs * g[2], v[j][3] * rs * g[3]) << 32); }
        }
        VM_WAIT(); __syncthreads();
    }
    SEAM(0);

    if (IN(1)) { PHASE_ARGS()
        pg8::Gemm g{H, BT1, DM, DM, DM, 0}; pg8::StaticOrder S; S.init(MPAD, N1, G, bx);
        pg8::Epi1 E{QLAT, QSS, KVRAW, SZ, U, SGA, SGP};
        pg8::gemm_phase<pg8::Epi1, pg8::StaticOrder, true, true>(lds + RING_OFF, g, S, E);
    }
    SEAM(1);

    if (IN(2)) { PHASE_ARGS()
#ifndef P2_NO_ELEM
        for (int row = gw; row < MTOT; row += NGW) {
            const float* src = KVRAW + (size_t)row * QKD; const int pos = row < SEQ ? row : SEQ;
            float* ckv_o = row < SEQ ? out + O_CKVP + (size_t)row * KVR : out + O_CKVS + (size_t)(row - SEQ) * KVR;
            float* kr_o = row < SEQ ? out + O_KRP + (size_t)row * ROPE : out + O_KRS + (size_t)(row - SEQ) * ROPE;
            const float v0 = src[lane], v1 = src[lane + 64];
            const float rs = 1.0f / sqrtf(wave_sum(v0 * v0 + v1 * v1) * (1.f / KVR) + EPS);
            const float c0 = v0 * rs * args.in[I_GKV][lane], c1 = v1 * rs * args.in[I_GKV][lane + 64];
            ckv_o[lane] = c0; ckv_o[lane + 64] = c1;
            bf16* kb = KB + (size_t)row * QKD; kb[lane] = (bf16)(cvtpk(c0, 0.f) & 0xffffu); kb[lane + 64] = (bf16)(cvtpk(c1, 0.f) & 0xffffu);
            if (lane < 32) { const float x1 = src[KVR + lane], x2 = src[KVR + 32 + lane]; const float cs = ROPET[2 * ((size_t)pos * 32 + lane)], sn = ROPET[2 * ((size_t)pos * 32 + lane) + 1];
                const float o1 = x1 * cs - x2 * sn, o2 = x2 * cs + x1 * sn;
                kr_o[lane] = o1; kr_o[lane + 32] = o2; kb[KVR + lane] = (bf16)(cvtpk(o1, 0.f) & 0xffffu); kb[KVR + 32 + lane] = (bf16)(cvtpk(o2, 0.f) & 0xffffu); }
        }
        for (int it = gw; it < (SEQ / 64) * 4; it += NGW) { const int q = it & 3, t0 = (it >> 2) * 64, w = 2 << q, c = 128 * q + 2 * lane;
            f32x2 sum = {0.f, 0.f};
            for (int i = 1; i < w; ++i) { const int t = t0 - i; if (t >= 0) sum += *(const f32x2*)(U + (size_t)t * POOLW + c); }
            for (int t = t0; t < t0 + 64; ++t) { const f32x2 u = *(const f32x2*)(U + (size_t)t * POOLW + c); sum += u;
                const float rc = 1.0f / (float)(t + 1 < w ? t + 1 : w);
                *(unsigned*)(OLPL + (size_t)t * GW + ATTW + c) = cvtpk(sum[0] * rc - u[0], sum[1] * rc - u[1]);
                const int told = t - (w - 1); if (told >= 0) sum -= *(const f32x2*)(U + (size_t)told * POOLW + c); }
        }
        for (int it = gw; it < NS * 4; it += NGW) { const int q = it & 3, b = it >> 2, w = 2 << q, c = 128 * q + 2 * lane;
            const f32x2 u = *(const f32x2*)(U + (size_t)(SEQ + b) * POOLW + c); f32x2 sum = u;
            for (int i = 0; i < w - 1; ++i) sum += *(const f32x2*)(args.in[I_SPOOL] + ((size_t)b * PHIST + (PHIST - 1 - i)) * POOLW + c);
            const float rc = 1.0f / (float)w;
            *(unsigned*)(OLPL + (size_t)(SEQ + b) * GW + ATTW + c) = cvtpk(sum[0] * rc - u[0], sum[1] * rc - u[1]); }
        for (int e = gw * 64 + lane; e < (PHIST * POOLW + NS * PHIST * POOLW) / 4; e += NGW * 64) {
            if (e < PHIST * POOLW / 4) { *(f32x4*)(out + O_POOLP + (size_t)e * 4) = *(const f32x4*)(U + (size_t)(SEQ - PHIST) * POOLW + (size_t)e * 4); }
            else { const int e2 = e - PHIST * POOLW / 4, b = e2 / (PHIST * POOLW / 4), r = e2 % (PHIST * POOLW / 4), j = r / (POOLW / 4), c4 = r % (POOLW / 4);
                const f32x4 v = j < PHIST - 1 ? *(const f32x4*)(args.in[I_SPOOL] + ((size_t)b * PHIST + j + 1) * POOLW + c4 * 4) : *(const f32x4*)(U + (size_t)(SEQ + b) * POOLW + c4 * 4);
                *(f32x4*)(out + O_POOLS + (size_t)e2 * 4) = v; } }
#endif
#ifndef P2_NO_GEMM
        pg8::Gemm g{QLAT, BTQ, QRANK, QRANK, QRANK, 0}; pg8::StaticOrder S; S.init(MPAD, 1536, G, bx);
        pg8::Epi2 E{QA, QR, QSS, ROPET};
        pg8::gemm_phase<pg8::Epi2, pg8::StaticOrder, true, true>(lds + RING_OFF, g, S, E);
#endif
    }
    SEAM(2);

    if (IN(3)) { PHASE_ARGS()
        gu32* qp = (gu32*)(ws + WS_CTL) + CW_QPROMPT; gu32* qd = (gu32*)(ws + WS_CTL) + CW_QDEC;
        volatile LAS unsigned* slot = (volatile LAS unsigned*)(lds + MISC_OFF) + 16;
#define GRAB(q_, v_) do { if (tid == 0) *slot = __hip_atomic_fetch_add((q_), 1u, __ATOMIC_RELAXED, __HIP_MEMORY_SCOPE_AGENT); __syncthreads(); (v_) = (int)*slot; __syncthreads(); } while (0)
        int mode = bx < ND_FIRST ? 0 : 1;
        for (int done = 0; done < 2;) {
            int it;
            const __attribute__((address_space(4))) Args* a2 = (const __attribute__((address_space(4))) Args*)__builtin_amdgcn_kernarg_segment_ptr(); asm volatile("" : "+s"(a2));
            unsigned char* w2 = a2->ws;
            int t2 = tid; asm volatile("" : "+v"(t2)); const int l2 = t2 & 63;
            if (mode == 0) { GRAB(qd, it); if (it >= NS * DSPLIT) { mode = 1; ++done; continue; }
                att::decode_item(it, a2->in[I_CKV], a2->in[I_CKR], (const int*)a2->in[I_PTAB], (const bf16*)(w2 + WS_QA), (const bf16*)(w2 + WS_QR), (float*)(w2 + WS_DPART), lds + RING_OFF, t2, wave, l2); }
            else { GRAB(qp, it); if (it >= SEQ / 32) { mode = 0; ++done; continue; }
                att::prompt_unit(32 * (SEQ / 32 - 1 - it), (const bf16*)(w2 + WS_QA), (const bf16*)(w2 + WS_QR), (const bf16*)(w2 + WS_KB), (bf16*)(w2 + WS_OLPL), lds + RING_OFF, t2, wave, l2); }
        }
#undef GRAB
    }
    SEAM(3);

    if (IN(4)) { PHASE_ARGS()
        for (int it = gw; it < NS * NH; it += NGW) { const int b = it >> 3, h = it & 7; const size_t row = (size_t)(SEQ + b);
            const float* dp = DPART + ((size_t)(b * DSPLIT) * NH + h) * 130;
            const bf16* qa = QA + row * ATTW + h * NOPE; const bf16* qq = QR + row * (NH * ROPE) + h * ROPE; const bf16* kb = KB + row * QKD;
            float ts = bf2f(qa[lane]) * bf2f(kb[lane]) + bf2f(qa[lane + 64]) * bf2f(kb[lane + 64]) + bf2f(qq[lane]) * bf2f(kb[KVR + lane]);
            ts = wave_sum(ts);
            float M = ts;
#pragma unroll
            for (int p = 0; p < DSPLIT; ++p) M = fmaxf(M, dp[p * NH * 130 + 128]);
            const float wsf = __builtin_amdgcn_exp2f(ts - M);
            float L = wsf, o0 = wsf * bf2f(kb[lane]), o1 = wsf * bf2f(kb[lane + 64]);
#pragma unroll
            for (int p = 0; p < DSPLIT; ++p) { const float* d = dp + p * NH * 130; const float w = __builtin_amdgcn_exp2f(d[128] - M); L += d[129] * w; o0 += d[lane] * w; o1 += d[lane + 64] * w; }
            const float rl = 1.0f / L;
            OLPL[row * GW + h * VD + lane] = (bf16)(cvtpk(o0 * rl, 0.f) & 0xffffu); OLPL[row * GW + h * VD + lane + 64] = (bf16)(cvtpk(o1 * rl, 0.f) & 0xffffu);
        }
        VM_WAIT(); __syncthreads();
    }
    SEAM(4);

    if (IN(5)) { PHASE_ARGS()
        pg8::Gemm g{OLPL, BTG, GW, 256, 256, 256}; pg8::StaticOrder S; S.init(MPAD, GW, G, bx);
        pg8::Epi5 E{G12, SZ, args.in[I_PSCALE]};
        pg8::gemm_phase<pg8::Epi5, pg8::StaticOrder, true, true>(lds + RING_OFF, g, S, E);
    }
    SEAM(5);

    if (IN(6)) { PHASE_ARGS()
        { pg8::Gemm g{G12, BTOA, GW, ATTW, ATTW, 0}; pg8::StaticOrder S; S.init(MPAD, DM, G, bx);
          pg8::Epi6<false> E{M1, MG, SGA};
          pg8::gemm_phase<pg8::Epi6<false>, pg8::StaticOrder, true, true>(lds + RING_OFF, g, S, E); }
        VM_WAIT(); __syncthreads();
        { pg8::Gemm g{G12 + ATTW, BTOP, GW, POOLW, POOLW, 0}; pg8::StaticOrder S; S.init(MPAD, DM, G, bx);
          pg8::Epi6<true> E{M1, MG, SGP};
          pg8::gemm_phase<pg8::Epi6<true>, pg8::StaticOrder, true, true>(lds + RING_OFF, g, S, E); }
    }
    SEAM(6);

    if (IN(7)) { PHASE_ARGS()
        pg8::Gemm g{MG, BTOUT, DM, DM, DM, 0}; pg8::StaticOrder S; S.init(MPAD, DM, G, bx);
        pg8::Epi7 E{args.in[I_XP], args.in[I_XS], out};
        pg8::gemm_phase<pg8::Epi7, pg8::StaticOrder, true, true>(lds + RING_OFF, g, S, E);
    }
    SEAM(7);

    if (IN(8)) { PHASE_ARGS()
        for (int m = gw; m < MTOT; m += NGW) {
            float* y = m < SEQ ? out + O_YP + (size_t)m * DM : out + O_YS + (size_t)(m - SEQ) * DM;
            f32x4* yr = (f32x4*)y + lane; const f32x4* gr = (const f32x4*)args.in[I_GFINAL] + lane;
            f32x4 v[4]; float s = 0.f;
#pragma unroll
            for (int j = 0; j < 4; ++j) { v[j] = yr[64 * j]; s += (v[j][0] * v[j][0] + v[j][1] * v[j][1]) + (v[j][2] * v[j][2] + v[j][3] * v[j][3]); }
            const float rs = 1.0f / sqrtf(wave_sum(s) * (1.f / DM) + EPS);
#pragma unroll
            for (int j = 0; j < 4; ++j) yr[64 * j] = v[j] * rs * gr[64 * j];
        }
    }
#undef IN
#undef SEAM
}

#ifndef MK_CUTS
#define MK_CUTS 0
#endif
extern "C" void kernel_launch(void* const* d_in, const int* in_sizes, int n_in, void* d_out, int out_size, void* d_ws, size_t ws_size, hipStream_t stream) {
    static int grid = 0;
    if (grid == 0) {
        if (n_in != 19 || out_size != (int)O_END || ws_size < WS_END) { fprintf(stderr, "kernel_launch: built for 19 inputs, %zu outputs, >= %zu bytes of workspace; got %d, %d, %zu\n", (size_t)O_END, (size_t)WS_END, n_in, out_size, ws_size); grid = -1; return; }
        int dev = 0, cus = 0, per_cu = 0;
        if (hipGetDevice(&dev) != hipSuccess || hipDeviceGetAttribute(&cus, hipDeviceAttributeMultiprocessorCount, dev) != hipSuccess) { grid = -1; return; }
        if (hipFuncSetAttribute((const void*)mk_fwd, hipFuncAttributeMaxDynamicSharedMemorySize, LDS_BYTES) != hipSuccess) { fprintf(stderr, "kernel_launch: hipFuncSetAttribute failed\n"); grid = -1; return; }
        if (hipOccupancyMaxActiveBlocksPerMultiprocessor(&per_cu, (const void*)mk_fwd, NWAVES * 64, LDS_BYTES) != hipSuccess || per_cu < 1) { fprintf(stderr, "kernel_launch: occupancy query says %d workgroups per CU\n", per_cu); }
        (void)hipGetLastError();
        grid = cus;
    }
    if (grid < 0) return;
    (void)hipMemsetAsync((char*)d_ws + WS_CTL, 0, CTL_ZERO_BYTES, stream);
    Args a{};
    for (int i = 0; i < 19; ++i) a.in[i] = (const float*)d_in[i];
    a.out = (float*)d_out; a.ws = (unsigned char*)d_ws;
#if MK_CUTS
    for (int p = 0; p < N_PHASES; ++p) { a.ph_lo = p; a.ph_hi = p + 1; hipLaunchKernelGGL(mk_fwd, dim3(grid), dim3(NWAVES * 64), LDS_BYTES, stream, a); }
#else
    a.ph_lo = 0; a.ph_hi = N_PHASES; hipLaunchKernelGGL(mk_fwd, dim3(grid), dim3(NWAVES * 64), LDS_BYTES, stream, a);
#endif
#ifdef MK_CHECK
    { static bool once = false; if (!once) { once = true; (void)hipFuncSetAttribute((const void*)chk_attn, hipFuncAttributeMaxDynamicSharedMemorySize, 68000); }
      hipLaunchKernelGGL(chk_attn, dim3(160 * 8), dim3(256), 68000, stream, a);
      hipLaunchKernelGGL(chk_chain, dim3(64), dim3(256), 0, stream, a);
      hipLaunchKernelGGL(chk_report, dim3(64), dim3(256), 0, stream, a); }
#endif
    const hipError_t le = hipPeekAtLastError();
    if (le != hipSuccess) fprintf(stderr, "kernel_launch: launch failed: %s\n", hipGetErrorName(le));
}
```

```cpp
#include <hip/hip_runtime.h>
#include <cstdio>
#include <cstdint>

#define GAS __attribute__((address_space(1)))
#define LAS __attribute__((address_space(3)))
typedef unsigned short bf16;
typedef short bf16x8 __attribute__((ext_vector_type(8)));
typedef short s16x4 __attribute__((ext_vector_type(4)));
typedef float f32x2 __attribute__((ext_vector_type(2)));
typedef float f32x4 __attribute__((ext_vector_type(4)));
typedef float f32x16 __attribute__((ext_vector_type(16)));
typedef unsigned u32x2 __attribute__((ext_vector_type(2)));
typedef unsigned u32x4 __attribute__((ext_vector_type(4)));
typedef GAS unsigned gu32;

constexpr int DM = 1024, SEQ = 16384, NS = 128, PAST = 16384, PAGE = 128, NPG = PAST / PAGE;
constexpr int MTOT = SEQ + NS;
constexpr int MPAD = 65 * 256;
constexpr int NH = 8, NOPE = 128, ROPE = 64, VD = 128, QRANK = 256, KVR = 128, ATTW = NH * VD, POOLW = 512, PHIST = 15;
constexpr int QKD = KVR + ROPE;
constexpr int INC = 4544, N1 = 4608;
constexpr int GW = ATTW + POOLW;
constexpr float EPS = 1e-6f;
constexpr float C2 = 0.07216878364870322f * 1.4426950408889634f;
constexpr size_t O_YP = 0, O_YS = O_YP + (size_t)SEQ * DM, O_CKVP = O_YS + (size_t)NS * DM, O_KRP = O_CKVP + (size_t)SEQ * KVR, O_POOLP = O_KRP + (size_t)SEQ * ROPE,
                 O_CKVS = O_POOLP + (size_t)PHIST * POOLW, O_KRS = O_CKVS + (size_t)NS * KVR, O_POOLS = O_KRS + (size_t)NS * ROPE, O_END = O_POOLS + (size_t)NS * PHIST * POOLW;
static_assert(O_END == 21069312, "d_out map");
constexpr size_t MiB = 1u << 20;
constexpr size_t WS_CTL = 0, CTL_ZERO_BYTES = 1 * MiB;
constexpr size_t WS_BT1 = 2 * MiB;
constexpr size_t WS_BTQ = 11 * MiB;
constexpr size_t WS_BTG = 12 * MiB;
constexpr size_t WS_BTOA = 13 * MiB;
constexpr size_t WS_BTOP = 15 * MiB;
constexpr size_t WS_BTOUT = 16 * MiB;
constexpr size_t WS_ROPE = 18 * MiB;
constexpr size_t WS_QSS = 23 * MiB;
constexpr size_t WS_DPART = 24 * MiB;
constexpr size_t WS_H = 32 * MiB;
constexpr size_t WS_QLAT = 65 * MiB;
constexpr size_t WS_KVRAW = 74 * MiB;
constexpr size_t WS_KB = 87 * MiB;
constexpr size_t WS_SZ = 94 * MiB;
constexpr size_t WS_U = 143 * MiB;
constexpr size_t WS_SGA = 176 * MiB;
constexpr size_t WS_SGP = 209 * MiB;
constexpr size_t WS_OLPL = 242 * MiB;
constexpr size_t WS_QA = 291 * MiB;
constexpr size_t WS_QR = 324 * MiB;
constexpr size_t WS_G12 = 341 * MiB;
constexpr size_t WS_M1 = 390 * MiB;
constexpr size_t WS_MG = 456 * MiB;
constexpr size_t WS_END = 489 * MiB;
static_assert(WS_BT1 + (size_t)N1 * 1024 * 2 <= WS_BTQ && WS_BTQ + 1536 * 256 * 2 <= WS_BTG && WS_BTG + 1536 * 256 * 2 <= WS_BTOA && WS_ROPE + (size_t)(SEQ + 1) * 32 * 8 <= WS_QSS &&
              WS_QSS + (size_t)MPAD * 16 <= WS_DPART && WS_DPART + (size_t)NS * 8 * 8 * 130 * 4 <= WS_H && WS_H + (size_t)MPAD * 2048 <= WS_QLAT && WS_QLAT + (size_t)MPAD * 512 <= WS_KVRAW &&
              WS_KVRAW + (size_t)MPAD * 768 <= WS_KB && WS_KB + (size_t)MPAD * 384 <= WS_SZ && WS_SZ + (size_t)MPAD * 3072 <= WS_U && WS_U + (size_t)MPAD * 2048 <= WS_SGA &&
              WS_SGA + (size_t)MPAD * 2048 <= WS_SGP && WS_SGP + (size_t)MPAD * 2048 <= WS_OLPL && WS_OLPL + (size_t)MPAD * 3072 <= WS_QA && WS_QA + (size_t)MPAD * 2048 <= WS_QR &&
              WS_QR + (size_t)MPAD * 1024 <= WS_G12 && WS_G12 + (size_t)MPAD * 3072 <= WS_M1 && WS_M1 + (size_t)MPAD * 4096 <= WS_MG && WS_MG + (size_t)MPAD * 2048 <= WS_END, "d_ws map");
constexpr int CW_QPROMPT = 1024, CW_QDEC = 1088;
constexpr int DSPLIT = 4;
#ifndef ND_FIRST
#define ND_FIRST 64
#endif
constexpr int CW_BAR = 4096;
constexpr int RING_OFF = 0, RING_BYTES = 131072;
constexpr int LDSCTL_OFF = RING_BYTES, MISC_OFF = LDSCTL_OFF + 320;
constexpr int LDS_BYTES = 147456;
constexpr int NWAVES = 8;

#define LDS_WAIT() asm volatile("s_waitcnt lgkmcnt(0)" ::: "memory")
#define VM_WAIT() asm volatile("s_waitcnt vmcnt(0)" ::: "memory")
#define SBAR() __builtin_amdgcn_sched_barrier(0)
__device__ __forceinline__ unsigned cvtpk(float lo, float hi) { unsigned r; asm("v_cvt_pk_bf16_f32 %0, %1, %2" : "=v"(r) : "v"(lo), "v"(hi)); return r; }
__device__ __forceinline__ float bflo(unsigned w) { return __builtin_bit_cast(float, w << 16); }
__device__ __forceinline__ float bfhi(unsigned w) { return __builtin_bit_cast(float, w & 0xffff0000u); }
__device__ __forceinline__ float bf2f(bf16 b) { return __builtin_bit_cast(float, (unsigned)b << 16); }
__device__ __forceinline__ float sigmoidf_(float x) { return __builtin_amdgcn_rcpf(1.f + __builtin_amdgcn_exp2f(-1.4426950408889634f * x)); }
__device__ __forceinline__ float wave_sum(float v) {
#pragma unroll
    for (int o = 1; o < 64; o <<= 1) v += __shfl_xor(v, o);
    return v;
}

namespace pg8 {
#define PG8_LAS __attribute__((address_space(3)))
typedef unsigned short bf16_t;
constexpr int BM = 256, BK = 64, HALF = 128, HTB = HALF * BK * 2  , STAGE_BYTES = 8 * HTB, NXCD = 8, WGM = 8;
__host__ __device__ __forceinline__ int lds_byte(int r, int c) { const int st = (r >> 4) * 2 + (c >> 5), rr = r & 15, cc = c & 31, ob = rr * 64 + cc * 2; return st * 1024 + (ob ^ (((ob >> 9) & 1) << 5)); }
__host__ __device__ __forceinline__ void stage_rc(int b, int& R, int& C) { const int st = b / 1024, sb = b % 1024, swz = sb ^ (((sb >> 9) & 1) << 5); R = (st >> 1) * 16 + swz / 64; C = (st & 1) * 32 + (swz % 64) / 2; }
__host__ __device__ __forceinline__ int perm32(int rho) { const int n = rho >> 4, i = rho & 15; return 8 * (i >> 2) + 4 * n + (i & 3); }
struct Unit { int pm, pn; };
struct Gemm { const bf16_t* A; const bf16_t* Bt; int lda, ldb, K, a_pn_off; };
struct StaticOrder {
    int nM, nN, nwg, G, c;
    __host__ __device__ void init(int M, int N, int G_, int c_) { nM = M / BM; nN = N / BM; nwg = nM * nN; G = G_; c = c_; }
    __host__ __device__ bool next(int i, Unit& u) const {
        const long L = (long)i * G + c; if (L >= nwg) return false;
        int wgid = (int)L; { const int q = nwg / NXCD, r = nwg % NXCD, xcd = wgid % NXCD, off = wgid / NXCD; wgid = (xcd < r ? xcd * (q + 1) : r * (q + 1) + (xcd - r) * q) + off; }
        const int nig = WGM * nN, gid = wgid / nig, fm = gid * WGM, gsz = (nM - fm) < WGM ? (nM - fm) : WGM;
        u.pm = fm + ((wgid % nig) % gsz); u.pn = (wgid % nig) / gsz; return true;
    }
    __device__ __forceinline__ void a_ready(const Unit&) const {}
    __device__ __forceinline__ void done(const Unit&) const {}
};
#define EPI_PACK8(v0, v1) ((u32x4){cvtpk((v0)[0], (v0)[1]), cvtpk((v0)[2], (v0)[3]), cvtpk((v1)[0], (v1)[1]), cvtpk((v1)[2], (v1)[3])})
#define EPI_UNPK_LO(g) ((f32x4){bflo((g).x), bfhi((g).x), bflo((g).y), bfhi((g).y)})
#define EPI_UNPK_HI(g) ((f32x4){bflo((g).z), bfhi((g).z), bflo((g).w), bfhi((g).w)})
struct Epi1 {
    static constexpr bool PERM = true, AFTER_DRAIN = false;
    bf16_t* QLAT; float* QSS; float* KVRAW; bf16_t* SZ; float* U; bf16_t* SGA; bf16_t* SGP;
    __device__ __forceinline__ void operator()(const f32x4 (&acc)[2][2][4][2], const Unit& u, int wr, int wc, int fr, int fq) const {
        const int pn = u.pn, row0 = u.pm * BM + wr * 64 + fr, c0 = wc * 32 + 8 * fq;
        if (pn == 0) {
#pragma unroll
            for (int ai = 0; ai < 2; ++ai)
#pragma unroll
                for (int m = 0; m < 4; ++m) { const size_t row = (size_t)(row0 + ai * HALF + m * 16); float ss = 0.f;
#pragma unroll
                    for (int bj = 0; bj < 2; ++bj) { const f32x4 v0 = acc[ai][bj][m][0], v1 = acc[ai][bj][m][1];
                        ss += (v0[0] * v0[0] + v0[1] * v0[1]) + (v0[2] * v0[2] + v0[3] * v0[3]) + (v1[0] * v1[0] + v1[1] * v1[1]) + (v1[2] * v1[2] + v1[3] * v1[3]);
                        *(u32x4*)(QLAT + row * 256 + bj * HALF + c0) = EPI_PACK8(v0, v1); }
                    ss += __shfl_xor(ss, 16); ss += __shfl_xor(ss, 32);
                    if (fq == 0) QSS[row * 4 + wc] = ss; }
        } else if (pn == 1) {
#pragma unroll
            for (int ai = 0; ai < 2; ++ai)
#pragma unroll
                for (int m = 0; m < 4; ++m) { const size_t row = (size_t)(row0 + ai * HALF + m * 16);
#pragma unroll
                    for (int bj = 0; bj < 2; ++bj) { const int c = bj * HALF + c0;
                        if (c < QKD) { *(f32x4*)(KVRAW + row * QKD + c) = acc[ai][bj][m][0]; *(f32x4*)(KVRAW + row * QKD + c + 4) = acc[ai][bj][m][1]; } } }
        } else if (pn == 6 || pn == 7) {
#pragma unroll
            for (int ai = 0; ai < 2; ++ai)
#pragma unroll
                for (int m = 0; m < 4; ++m) { const size_t row = (size_t)(row0 + ai * HALF + m * 16);
#pragma unroll
                    for (int bj = 0; bj < 2; ++bj) { float* p = U + row * POOLW + (pn - 6) * 256 + bj * HALF + c0;
                        *(f32x4*)p = acc[ai][bj][m][0]; *(f32x4*)(p + 4) = acc[ai][bj][m][1]; } }
        } else {
            bf16_t* dst; int ld; bool sig;
            if (pn < 6) { dst = SZ + (pn - 2) * 256; ld = GW; sig = false; }
            else if (pn < 10) { dst = SZ + ATTW + (pn - 8) * 256; ld = GW; sig = false; }
            else if (pn < 14) { dst = SGA + (pn - 10) * 256; ld = DM; sig = true; }
            else { dst = SGP + (pn - 14) * 256; ld = DM; sig = true; }
#pragma unroll
            for (int ai = 0; ai < 2; ++ai)
#pragma unroll
                for (int m = 0; m < 4; ++m) { const size_t row = (size_t)(row0 + ai * HALF + m * 16);
#pragma unroll
                    for (int bj = 0; bj < 2; ++bj) { f32x4 v0 = acc[ai][bj][m][0], v1 = acc[ai][bj][m][1];
#pragma unroll
                        for (int e = 0; e < 4; ++e) { const float s0 = sigmoidf_(v0[e]), s1 = sigmoidf_(v1[e]); v0[e] = sig ? s0 : v0[e] * s0; v1[e] = sig ? s1 : v1[e] * s1; }
                        *(u32x4*)(dst + row * ld + bj * HALF + c0) = EPI_PACK8(v0, v1); } }
        }
    }
};
struct Epi2 {
    static constexpr bool PERM = true, AFTER_DRAIN = false;
    bf16_t* QA; bf16_t* QR; const float* QSS; const float* ROPET;
    __device__ __forceinline__ void operator()(const f32x4 (&acc)[2][2][4][2], const Unit& u, int wr, int wc, int fr, int fq) const {
        const int pn = u.pn, row0 = u.pm * BM + wr * 64 + fr, c0 = wc * 32 + 8 * fq;
#pragma unroll
        for (int ai = 0; ai < 2; ++ai)
#pragma unroll
            for (int m = 0; m < 4; ++m) { const size_t row = (size_t)(row0 + ai * HALF + m * 16);
                const f32x4 q4 = *(const f32x4*)(QSS + row * 4);
                const float s = C2 * __builtin_amdgcn_rsqf(((q4[0] + q4[1]) + (q4[2] + q4[3])) * (1.f / QRANK) + EPS);
                if (pn < 4) {
#pragma unroll
                    for (int bj = 0; bj < 2; ++bj) { const f32x4 v0 = acc[ai][bj][m][0] * s, v1 = acc[ai][bj][m][1] * s;
                        *(u32x4*)(QA + row * ATTW + pn * 256 + bj * HALF + c0) = EPI_PACK8(v0, v1); }
                } else {
                    const int pos = row < SEQ ? (int)row : SEQ;
                    const float* rp = ROPET + ((size_t)pos * 32 + 8 * fq) * 2;
                    bf16_t* q = QR + row * (NH * ROPE) + (4 * (pn - 4) + wc) * ROPE + 8 * fq;
#pragma unroll
                    for (int n = 0; n < 2; ++n) {
                        const f32x4 t0 = *(const f32x4*)(rp + 8 * n), t1 = *(const f32x4*)(rp + 8 * n + 4);
                        const f32x4 a = acc[ai][0][m][n], b = acc[ai][1][m][n];
                        u32x2 lo, hi2;
                        lo.x = cvtpk((a[0] * t0[0] - b[0] * t0[1]) * s, (a[1] * t0[2] - b[1] * t0[3]) * s); lo.y = cvtpk((a[2] * t1[0] - b[2] * t1[1]) * s, (a[3] * t1[2] - b[3] * t1[3]) * s);
                        hi2.x = cvtpk((b[0] * t0[0] + a[0] * t0[1]) * s, (b[1] * t0[2] + a[1] * t0[3]) * s); hi2.y = cvtpk((b[2] * t1[0] + a[2] * t1[1]) * s, (b[3] * t1[2] + a[3] * t1[3]) * s);
                        *(u32x2*)(q + 4 * n) = lo; *(u32x2*)(q + 32 + 4 * n) = hi2; }
                }
                if (m & 1) __builtin_amdgcn_sched_barrier(0);
            }
    }
};
struct Epi5 {
    static constexpr bool PERM = true, AFTER_DRAIN = false;
    bf16_t* G12; const bf16_t* SZ; const float* pool_scale;
    __device__ __forceinline__ void operator()(const f32x4 (&acc)[2][2][4][2], const Unit& u, int wr, int wc, int fr, int fq) const {
        const int pn = u.pn, row0 = u.pm * BM + wr * 64 + fr, c0 = wc * 32 + 8 * fq;
#pragma unroll
        for (int bj = 0; bj < 2; ++bj) { const int c = pn * 256 + bj * HALF + c0;
            f32x4 p0 = {1.f, 1.f, 1.f, 1.f}, p1 = p0;
            if (pn >= 4) { p0 = *(const f32x4*)(pool_scale + c - ATTW); p1 = *(const f32x4*)(pool_scale + c - ATTW + 4); }
#pragma unroll
            for (int ai = 0; ai < 2; ++ai)
#pragma unroll
                for (int m = 0; m < 4; ++m) { const size_t row = (size_t)(row0 + ai * HALF + m * 16);
                    const u32x4 g = *(const u32x4*)(SZ + row * GW + c);
                    const f32x4 v0 = acc[ai][bj][m][0] * p0 * EPI_UNPK_LO(g), v1 = acc[ai][bj][m][1] * p1 * EPI_UNPK_HI(g);
                    *(u32x4*)(G12 + row * GW + c) = EPI_PACK8(v0, v1); } }
    }
};
template <bool SECOND> struct Epi6 {
    static constexpr bool PERM = true, AFTER_DRAIN = false;
    float* M1; bf16_t* MG; const bf16_t* SG;
    __device__ __forceinline__ void operator()(const f32x4 (&acc)[2][2][4][2], const Unit& u, int wr, int wc, int fr, int fq) const {
        const int pn = u.pn, row0 = u.pm * BM + wr * 64 + fr, c0 = wc * 32 + 8 * fq;
#pragma unroll
        for (int ai = 0; ai < 2; ++ai)
#pragma unroll
            for (int m = 0; m < 4; ++m) { const size_t row = (size_t)(row0 + ai * HALF + m * 16);
#pragma unroll
                for (int bj = 0; bj < 2; ++bj) { const size_t o = row * DM + pn * 256 + bj * HALF + c0;
                    const u32x4 g = *(const u32x4*)(SG + o);
                    f32x4 v0 = acc[ai][bj][m][0] * EPI_UNPK_LO(g), v1 = acc[ai][bj][m][1] * EPI_UNPK_HI(g);
                    if (!SECOND) { *(f32x4*)(M1 + o) = v0; *(f32x4*)(M1 + o + 4) = v1; }
                    else { v0 += *(const f32x4*)(M1 + o); v1 += *(const f32x4*)(M1 + o + 4); *(u32x4*)(MG + o) = EPI_PACK8(v0, v1); } } }
    }
};
struct Epi7 {
    static constexpr bool PERM = true, AFTER_DRAIN = false;
    const float* xp; const float* xs; float* out;
    __device__ __forceinline__ void operator()(const f32x4 (&acc)[2][2][4][2], const Unit& u, int wr, int wc, int fr, int fq) const {
        const int pn = u.pn, row0 = u.pm * BM + wr * 64 + fr, c0 = wc * 32 + 8 * fq;
#pragma unroll
        for (int ai = 0; ai < 2; ++ai)
#pragma unroll
            for (int m = 0; m < 4; ++m) { const int row = row0 + ai * HALF + m * 16;
                if (row < MTOT) {
                    const float* x = row < SEQ ? xp + (size_t)row * DM : xs + (size_t)(row - SEQ) * DM;
                    float* y = row < SEQ ? out + O_YP + (size_t)row * DM : out + O_YS + (size_t)(row - SEQ) * DM;
#pragma unroll
                    for (int bj = 0; bj < 2; ++bj) { const int c = pn * 256 + bj * HALF + c0;
                        *(f32x4*)(y + c) = *(const f32x4*)(x + c) + acc[ai][bj][m][0]; *(f32x4*)(y + c + 4) = *(const f32x4*)(x + c + 4) + acc[ai][bj][m][1]; } } }
    }
};
template <class Epi, class Sched, bool ALIGN_EPI = false, bool SP2 = false>
__device__ __forceinline__ void gemm_phase(PG8_LAS unsigned char* lds, const Gemm g, const Sched& S, const Epi& E) {
    int tid_ = threadIdx.x; asm volatile("" : "+v"(tid_));
    const int tid = tid_, wid = __builtin_amdgcn_readfirstlane(tid >> 6), lane = tid & 63, wr = wid >> 2, wc = wid & 3, fr = lane & 15, fq = lane >> 4;
    const int K = g.K, nt = K / BK;
    unsigned voffA[2], voffB[2];
#pragma unroll
    for (int i = 0; i < 2; ++i) { int R, C; stage_rc(tid * 16 + i * 8192, R, C); const int Rb = Epi::PERM ? ((R & ~31) + perm32(R & 31)) : R;
        voffA[i] = (unsigned)(R * g.lda + C) * 2u; voffB[i] = (unsigned)(Rb * g.ldb + C) * 2u; }
    const size_t kstep = (size_t)(BK * 2);
    const size_t hA = (size_t)HALF * g.lda * 2, hB = (size_t)HALF * g.ldb * 2;
    const size_t tA = 2 * hA, tB = 2 * hB, pA = (size_t)g.a_pn_off * 2;
    const unsigned ldsw = (unsigned)wid * 1024u;
    const int aoff = lds_byte(wr * 64 + fr, fq * 8), boff = lds_byte(wc * 32 + fr, fq * 8);
#define PG8_SA(b, h) (((b) * 2 + (h)) * HTB)
#define PG8_SB(b, h) ((4 + (b) * 2 + (h)) * HTB)
#define PG8_STAGE(bufoff, gbase, voff) do { _Pragma("unroll") for (int _i = 0; _i < 2; ++_i) \
        __builtin_amdgcn_global_load_lds((const unsigned*)((const char*)(gbase) + (voff)[_i]), (PG8_LAS unsigned*)(lds + (bufoff) + ldsw + _i * 8192), 16, 0, 0); } while (0)
#define PG8_LDA(dst, b, h) do { _Pragma("unroll") for (int m = 0; m < 4; ++m) _Pragma("unroll") for (int k = 0; k < 2; ++k) dst[m][k] = *(const PG8_LAS bf16x8*)(lds + PG8_SA(b, h) + aoff + m * 2048 + k * 1024); } while (0)
#define PG8_LDB(dst, b, h) do { _Pragma("unroll") for (int n = 0; n < 2; ++n) _Pragma("unroll") for (int k = 0; k < 2; ++k) dst[n][k] = *(const PG8_LAS bf16x8*)(lds + PG8_SB(b, h) + boff + n * 2048 + k * 1024); } while (0)
#define PG8_MMA(ai, bj, At, Bt) do { __builtin_amdgcn_s_setprio(1); _Pragma("unroll") for (int m = 0; m < 4; ++m) _Pragma("unroll") for (int n = 0; n < 2; ++n) _Pragma("unroll") for (int k = 0; k < 2; ++k) \
        acc[ai][bj][m][n] = __builtin_amdgcn_mfma_f32_16x16x32_bf16(Bt[n][k], At[m][k], acc[ai][bj][m][n], 0, 0, 0); __builtin_amdgcn_s_setprio(0); } while (0)
#define PG8_WAIT_V(n) asm volatile("s_waitcnt vmcnt(" #n ")" ::: "memory")
#define PG8_WAIT_L(n) asm volatile("s_waitcnt lgkmcnt(" #n ")" ::: "memory")
#define PG8_BAR __builtin_amdgcn_s_barrier()
#define PG8_SCHED __builtin_amdgcn_sched_barrier(0)
    Unit cur, nxt; int ui = 0;
    if (!S.next(0, cur)) return;
    f32x4 acc[2][2][4][2];
#pragma unroll
    for (int a = 0; a < 2; ++a)
#pragma unroll
        for (int b = 0; b < 2; ++b)
#pragma unroll
            for (int m = 0; m < 4; ++m)
#pragma unroll
                for (int n = 0; n < 2; ++n) acc[a][b][m][n] = (f32x4){0.f, 0.f, 0.f, 0.f};
    bf16x8 At[4][2], B0[2][2], B1[2][2];
    const char* cA = (const char*)g.A + (size_t)cur.pm * tA + (size_t)cur.pn * pA; const char* cB = (const char*)g.Bt + (size_t)cur.pn * tB;
    S.a_ready(cur);
    if constexpr (SP2) {
        PG8_STAGE(PG8_SB(0, 0), cB, voffB); PG8_STAGE(PG8_SB(0, 1), cB + hB, voffB); PG8_STAGE(PG8_SA(0, 0), cA, voffA); PG8_STAGE(PG8_SA(0, 1), cA + hA, voffA);
        if (wr == 1) PG8_BAR;
        PG8_WAIT_V(2); PG8_BAR;
        PG8_STAGE(PG8_SB(1, 0), cB + kstep, voffB); PG8_STAGE(PG8_SA(1, 0), cA + kstep, voffA); PG8_STAGE(PG8_SB(1, 1), cB + hB + kstep, voffB);
        PG8_WAIT_V(6); PG8_BAR;
    } else {
        PG8_STAGE(PG8_SB(0, 0), cB, voffB); PG8_STAGE(PG8_SA(0, 0), cA, voffA); PG8_STAGE(PG8_SB(0, 1), cB + hB, voffB); PG8_STAGE(PG8_SA(0, 1), cA + hA, voffA);
        if (wr == 1) PG8_BAR;
        PG8_WAIT_V(4); PG8_BAR;
        PG8_STAGE(PG8_SB(1, 0), cB + kstep, voffB); PG8_STAGE(PG8_SA(1, 0), cA + kstep, voffA); PG8_STAGE(PG8_SB(1, 1), cB + hB + kstep, voffB);
        PG8_WAIT_V(6); PG8_BAR;
    }
    for (;;) {
        const bool has_next = S.next(ui + 1, nxt);
        const char* nA = has_next ? (const char*)g.A + (size_t)nxt.pm * tA + (size_t)nxt.pn * pA : cA; const char* nB = has_next ? (const char*)g.Bt + (size_t)nxt.pn * tB : cB;
        for (int t = 0; t < nt; t += 2) {
            const bool last = (t == nt - 2);
            const char* a1 = cA + (size_t)(t + 1) * kstep;
            const char* a2 = last ? nA : cA + (size_t)(t + 2) * kstep; const char* b2 = last ? nB : cB + (size_t)(t + 2) * kstep;
            const char* a3 = a2 + kstep; const char* b3 = b2 + kstep;
            if (last && has_next) S.a_ready(nxt);
            if constexpr (SP2) {
            PG8_LDB(B0, 0, 0); PG8_LDB(B1, 0, 1); PG8_SCHED; PG8_LDA(At, 0, 0); PG8_STAGE(PG8_SA(1, 1), a1 + hA, voffA);
            PG8_WAIT_V(8); PG8_WAIT_L(0); PG8_BAR; PG8_MMA(0, 0, At, B0); PG8_MMA(0, 1, At, B1); PG8_BAR; PG8_SCHED;
            PG8_LDA(At, 0, 1); PG8_STAGE(PG8_SB(0, 0), b2, voffB); PG8_STAGE(PG8_SB(0, 1), b2 + hB, voffB); PG8_STAGE(PG8_SA(0, 0), a2, voffA);
            PG8_WAIT_V(8); PG8_WAIT_L(0); PG8_BAR; PG8_MMA(1, 0, At, B0); PG8_MMA(1, 1, At, B1); PG8_BAR; PG8_SCHED;
            PG8_LDB(B0, 1, 0); PG8_LDB(B1, 1, 1); PG8_SCHED; PG8_LDA(At, 1, 0); PG8_STAGE(PG8_SA(0, 1), a2 + hA, voffA);
            PG8_WAIT_V(8); PG8_WAIT_L(0); PG8_BAR; PG8_MMA(0, 0, At, B0); PG8_MMA(0, 1, At, B1); PG8_BAR; PG8_SCHED;
            PG8_LDA(At, 1, 1); PG8_STAGE(PG8_SB(1, 0), b3, voffB); PG8_STAGE(PG8_SB(1, 1), b3 + hB, voffB); PG8_STAGE(PG8_SA(1, 0), a3, voffA);
            PG8_WAIT_V(8); PG8_WAIT_L(0); PG8_BAR; PG8_MMA(1, 0, At, B0); PG8_MMA(1, 1, At, B1); PG8_BAR; PG8_SCHED;
            } else {
            PG8_LDB(B0, 0, 0); PG8_SCHED; PG8_LDA(At, 0, 0); PG8_STAGE(PG8_SA(1, 1), a1 + hA, voffA);
            PG8_WAIT_L(8); PG8_BAR; PG8_WAIT_L(0); PG8_MMA(0, 0, At, B0); PG8_BAR; PG8_SCHED;
            PG8_LDB(B1, 0, 1); PG8_STAGE(PG8_SB(0, 0), b2, voffB);
            PG8_BAR; PG8_WAIT_L(0); PG8_MMA(0, 1, At, B1); PG8_BAR;
            PG8_LDA(At, 0, 1); PG8_STAGE(PG8_SA(0, 0), a2, voffA);
            PG8_BAR; PG8_WAIT_L(0); PG8_MMA(1, 0, At, B0); PG8_BAR; PG8_SCHED;
            PG8_STAGE(PG8_SB(0, 1), b2 + hB, voffB);
            PG8_WAIT_V(6); PG8_BAR; PG8_MMA(1, 1, At, B1); PG8_BAR;
            PG8_LDB(B0, 1, 0); PG8_SCHED; PG8_LDA(At, 1, 0); PG8_STAGE(PG8_SA(0, 1), a2 + hA, voffA);
            PG8_WAIT_L(8); PG8_BAR; PG8_WAIT_L(0); PG8_MMA(0, 0, At, B0); PG8_BAR; PG8_SCHED;
            PG8_LDB(B1, 1, 1); PG8_STAGE(PG8_SB(1, 0), b3, voffB);
            PG8_BAR; PG8_WAIT_L(0); PG8_MMA(0, 1, At, B1); PG8_BAR;
            PG8_LDA(At, 1, 1); PG8_STAGE(PG8_SA(1, 0), a3, voffA);
            PG8_BAR; PG8_WAIT_L(0); PG8_MMA(1, 0, At, B0); PG8_BAR; PG8_SCHED;
            PG8_STAGE(PG8_SB(1, 1), b3 + hB, voffB);
            PG8_WAIT_V(6); PG8_BAR; PG8_MMA(1, 1, At, B1); PG8_BAR;
            }
        }
        if constexpr (ALIGN_EPI) { if (wr == 0) PG8_BAR; }
        if constexpr (!Epi::AFTER_DRAIN) { int l_; asm volatile("v_mbcnt_lo_u32_b32 %0, -1, 0\n\tv_mbcnt_hi_u32_b32 %0, -1, %0" : "=v"(l_));
            E(acc, cur, wr, wc, l_ & 15, l_ >> 4); S.done(cur); }
        if (!has_next) break;
#pragma unroll
        for (int a = 0; a < 2; ++a)
#pragma unroll
            for (int b = 0; b < 2; ++b)
#pragma unroll
                for (int m = 0; m < 4; ++m)
#pragma unroll
                    for (int n = 0; n < 2; ++n) acc[a][b][m][n] = (f32x4){0.f, 0.f, 0.f, 0.f};
        cur = nxt; cA = nA; cB = nB; ++ui;
        if constexpr (ALIGN_EPI) { if (wr == 1) PG8_BAR; }
    }
    PG8_WAIT_V(0);
    if constexpr (!ALIGN_EPI) { if (wr == 0) PG8_BAR; }
    PG8_BAR;
    if constexpr (Epi::AFTER_DRAIN) { E.fused(acc, cur, wr, wc, fr, fq, lds, wid, lane); S.done(cur); }
#undef PG8_SA
#undef PG8_SB
#undef PG8_STAGE
#undef PG8_LDA
#undef PG8_LDB
#undef PG8_MMA
#undef PG8_WAIT_V
#undef PG8_WAIT_L
#undef PG8_BAR
#undef PG8_SCHED
}
}
namespace att {
constexpr int SHM_K = 64 * 384, SHM_V = 64 * 256;
constexpr int L_V = 0, L_K = 2 * SHM_V, L_WS = L_K + 2 * SHM_K, L_QR = L_WS + NWAVES * 256, LDS_NEED = L_QR + NWAVES * 4096;
constexpr int DROW = 400, DIMG = 32 * DROW;
static_assert(LDS_NEED <= RING_BYTES && NWAVES * DIMG + 12 * 17 * 16 <= RING_BYTES, "attention LDS");
constexpr float THR2 = 8.f * 1.4426950408889634f;
__device__ __forceinline__ int crow(int r, int hi) { return (r & 3) + 8 * (r >> 2) + 4 * hi; }
__device__ __forceinline__ int v_st(int k, int c) { const int kk = (k & ~0xC) | ((k & 4) << 1) | ((k & 8) >> 1); return ((kk >> 3) * 4 + (c >> 5)) * 512 + ((kk & 7) * 32 + (c & 31)) * 2; }
__device__ __forceinline__ int v_rd_base(int lane) { return ((lane & 3) << 3) | (((lane >> 2) & 3) << 6) | (((lane >> 4) & 1) << 5) | (((lane >> 5) & 1) << 8); }
constexpr int v_rd_off(int d0, int ks, int half) { return d0 * 512 + ks * 4096 + half * 2048; }
__device__ __forceinline__ float pl_swap_max(float v) { auto rr = __builtin_amdgcn_permlane32_swap(__float_as_uint(v), __float_as_uint(v), false, false); return fmaxf(__uint_as_float(rr[0]), __uint_as_float(rr[1])); }
__device__ __forceinline__ float pl_swap_add(float v) { auto rr = __builtin_amdgcn_permlane32_swap(__float_as_uint(v), __float_as_uint(v), false, false); return __uint_as_float(rr[0]) + __uint_as_float(rr[1]); }
#define ATT_PK4(P, B_, OUT) do { unsigned a0 = cvtpk(P[B_+0], P[B_+1]), a1 = cvtpk(P[B_+2], P[B_+3]);                          \
        unsigned b0 = cvtpk(P[B_+4], P[B_+5]), b1 = cvtpk(P[B_+6], P[B_+7]);                                             \
        auto r0 = __builtin_amdgcn_permlane32_swap(a0, b0, false, false); auto r1 = __builtin_amdgcn_permlane32_swap(a1, b1, false, false); \
        u32x4 w = {r0[0], r1[0], r0[1], r1[1]}; OUT = __builtin_bit_cast(bf16x8, w); } while (0)
#define ATT_TRRD(dst, addr, off) asm volatile("ds_read_b64_tr_b16 %0, %1 offset:%2" : "=&v"(dst) : "v"(addr), "i"(off) : "memory")
#define ATT_PK(L, H) ((bf16x8){L[0], L[1], L[2], L[3], H[0], H[1], H[2], H[3]})

__device__ __forceinline__ void mask_tile(f32x16& p0, f32x16& p1, int dq) {
    const float NEG = -__builtin_inff();
#pragma unroll
    for (int r = 0; r < 16; ++r) { const int c = (r & 3) + 8 * (r >> 2);
        if (dq - c < 0) p0[r] = NEG;
        if (dq - c - 32 < 0) p1[r] = NEG; }
}
__device__ __forceinline__ void partialSM(f32x16& p0, f32x16& p1, float& m_reg, float& alpha) {
    float pmax = p0[0];
#pragma unroll
    for (int r = 1; r < 16; ++r) pmax = fmaxf(pmax, p0[r]);
#pragma unroll
    for (int r = 0; r < 16; ++r) pmax = fmaxf(pmax, p1[r]);
    pmax = pl_swap_max(pmax);
    float mn;
    if (__builtin_expect(__all(pmax - m_reg <= THR2), 1)) { mn = m_reg; alpha = 1.f; }
    else { mn = fmaxf(m_reg, pmax); alpha = __builtin_amdgcn_exp2f(m_reg - mn); m_reg = mn; }
#pragma unroll
    for (int r = 0; r < 16; ++r) p0[r] = __builtin_amdgcn_exp2f(p0[r] - mn);
#pragma unroll
    for (int r = 0; r < 16; ++r) p1[r] = p1[r] - mn;
}
__device__ __forceinline__ void finishSM(f32x16& p0, f32x16& p1, float alpha, float& l_reg, bf16x8& pa0, bf16x8& pa1, bf16x8& pa2, bf16x8& pa3) {
#pragma unroll
    for (int r = 0; r < 16; ++r) p1[r] = __builtin_amdgcn_exp2f(p1[r]);
    float ps = 0.f;
#pragma unroll
    for (int r = 0; r < 16; ++r) ps += p0[r];
#pragma unroll
    for (int r = 0; r < 16; ++r) ps += p1[r];
    ps = pl_swap_add(ps);
    l_reg = l_reg * alpha + ps;
    ATT_PK4(p0, 0, pa0); ATT_PK4(p0, 8, pa1); ATT_PK4(p1, 0, pa2); ATT_PK4(p1, 8, pa3);
}
template <int KB>
__device__ __forceinline__ void qkt(f32x16& p0, f32x16& p1, const LAS unsigned char* lds, int r32, int hi, const bf16x8* qr, const LAS unsigned char* qlds) {
    p0 = f32x16{}; p1 = f32x16{};
    const int sw = ((r32 >> 1) & 7) << 4;
    const LAS unsigned char* kb[4];
#pragma unroll
    for (int dd = 0; dd < 4; ++dd) kb[dd] = lds + L_K + KB * SHM_K + r32 * 384 + ((dd * 32 + hi * 16) ^ sw);
#pragma unroll
    for (int d0 = 0; d0 < 12; ++d0) { const LAS unsigned char* a = kb[d0 & 3] + (d0 >> 2) * 128;
        const bf16x8 b0 = *(const LAS bf16x8*)a, b1 = *(const LAS bf16x8*)(a + 32 * 384);
        const bf16x8 qf = d0 < 8 ? qr[d0 & 7] : *(const LAS bf16x8*)(qlds + (d0 - 8) * 1024);
        p0 = __builtin_amdgcn_mfma_f32_32x32x16_bf16(b0, qf, p0, 0, 0, 0);
        p1 = __builtin_amdgcn_mfma_f32_32x32x16_bf16(b1, qf, p1, 0, 0, 0); }
}
template <int VB>
__device__ __forceinline__ void pv_tile(f32x16* o, int vb0, bf16x8 pa0, bf16x8 pa1, bf16x8 pa2, bf16x8 pa3) {
#define ATT_PV_D0(d0) do { s16x4 l0, l1, l2, l3, h0, h1, h2, h3; constexpr int b_ = L_V + VB * SHM_V + v_rd_off(d0, 0, 0); \
        ATT_TRRD(l0, vb0, b_); ATT_TRRD(h0, vb0, b_ + 2048); ATT_TRRD(l1, vb0, b_ + 4096); ATT_TRRD(h1, vb0, b_ + 6144); ATT_TRRD(l2, vb0, b_ + 8192); ATT_TRRD(h2, vb0, b_ + 10240); ATT_TRRD(l3, vb0, b_ + 12288); ATT_TRRD(h3, vb0, b_ + 14336); \
        asm volatile("s_waitcnt lgkmcnt(0)" ::: "memory"); SBAR(); \
        o[d0] = __builtin_amdgcn_mfma_f32_32x32x16_bf16(pa0, ATT_PK(l0, h0), o[d0], 0, 0, 0); \
        o[d0] = __builtin_amdgcn_mfma_f32_32x32x16_bf16(pa1, ATT_PK(l1, h1), o[d0], 0, 0, 0); \
        o[d0] = __builtin_amdgcn_mfma_f32_32x32x16_bf16(pa2, ATT_PK(l2, h2), o[d0], 0, 0, 0); \
        o[d0] = __builtin_amdgcn_mfma_f32_32x32x16_bf16(pa3, ATT_PK(l3, h3), o[d0], 0, 0, 0); } while (0)
    ATT_PV_D0(0); ATT_PV_D0(1); ATT_PV_D0(2); ATT_PV_D0(3);
#undef ATT_PV_D0
}

__device__ __forceinline__ void prompt_unit(int q0, const bf16* __restrict__ QA, const bf16* __restrict__ QR, const bf16* __restrict__ KBm, bf16* __restrict__ OL, LAS unsigned char* lds, int tid, int wid, int lane) {
    const int r32 = lane & 31, hi = lane >> 5;
    const int NT = (q0 >> 6) + 1;
    bf16x8 qr[8];
    LAS unsigned char* qlds = lds + L_QR + wid * 4096 + lane * 16;
    { const bf16* qa = QA + (size_t)(q0 + r32) * ATTW + wid * NOPE + hi * 8; const bf16* qq = QR + (size_t)(q0 + r32) * (NH * ROPE) + wid * ROPE + hi * 8;
#pragma unroll
      for (int d0 = 0; d0 < 8; ++d0) qr[d0] = *(const bf16x8*)(qa + d0 * 16);
#pragma unroll
      for (int d0 = 0; d0 < 4; ++d0) *(LAS bf16x8*)(qlds + d0 * 1024) = *(const bf16x8*)(qq + d0 * 16); }
    LAS float* wsf = (LAS float*)(lds + L_WS) + wid * 64; LAS float* li_l = wsf; LAS float* al_l = wsf + 32;
    float m_reg = -1e30f, l_reg = 0.f; f32x16 o[4] = {};
    const int skey = tid >> 3, sc8 = tid & 7;
    const int kw0 = skey * 384 + ((sc8 * 16) ^ (((skey >> 1) & 7) << 4));
    const int vw0 = v_st(skey, sc8 * 8);
    const int vb0 = (int)(uintptr_t)lds + v_rd_base(lane);
    const int qm = q0 + r32 - 4 * hi;
    const bf16* ksrc = KBm + (size_t)skey * QKD + sc8 * 8;
    bf16x8 st0, st1, st2;
#define ATT_SLOAD(t) do { const bf16* p_ = ksrc + (size_t)(t) * (64 * QKD); st0 = *(const bf16x8*)p_; st1 = *(const bf16x8*)(p_ + 64); st2 = *(const bf16x8*)(p_ + 128); } while (0)
#define ATT_SWRITE(bf) do { LAS unsigned char* k_ = lds + L_K + (bf) * SHM_K + kw0; *(LAS bf16x8*)k_ = st0; *(LAS bf16x8*)(k_ + 128) = st1; *(LAS bf16x8*)(k_ + 256) = st2; \
        LAS unsigned char* v_ = lds + L_V + (bf) * SHM_V + vw0; *(LAS bf16x8*)v_ = st0; *(LAS bf16x8*)(v_ + 1024) = st1; } while (0)
#define ATT_RESC(a) do { if (__any((a) < 1.f)) { if (hi == 0) al_l[r32] = (a); LDS_WAIT(); \
        _Pragma("unroll") for (int d_ = 0; d_ < 4; ++d_) _Pragma("unroll") for (int r = 0; r < 16; ++r) o[d_][r] *= al_l[crow(r, hi)]; } } while (0)
#define ATT_MASKT(P0_, P1_, t) do { if ((t) == NT - 1) mask_tile(P0_, P1_, qm - 64 * (t)); } while (0)
    f32x16 pA0, pA1, pB0, pB1; float alA, alB; bf16x8 pa0, pa1, pa2, pa3;
    ATT_SLOAD(0); VM_WAIT(); ATT_SWRITE(0); SBAR();
    if (NT > 1) ATT_SLOAD(1);
    __syncthreads();
    SBAR(); qkt<0>(pA0, pA1, lds, r32, hi, qr, qlds);
    ATT_MASKT(pA0, pA1, 0); partialSM(pA0, pA1, m_reg, alA);
    if (NT > 1) { VM_WAIT(); ATT_SWRITE(1); }
    __syncthreads();
#define ATT_HALF_STEP(PX0, PX1, alX, PY0, PY1, alY, t, KB, VB, SB) do {                                          \
        SBAR(); qkt<KB>(PX0, PX1, lds, r32, hi, qr, qlds);                                                         \
        finishSM(PY0, PY1, alY, l_reg, pa0, pa1, pa2, pa3); SBAR();                                              \
        if ((t) + 1 < NT) { ATT_SLOAD((t) + 1); SBAR(); }                                                        \
        pv_tile<VB>(o, vb0, pa0, pa1, pa2, pa3); ATT_MASKT(PX0, PX1, (t)); partialSM(PX0, PX1, m_reg, alX);      \
        __syncthreads();                                                                                         \
        if ((t) + 1 < NT) { VM_WAIT(); ATT_SWRITE(SB); }                                                         \
        ATT_RESC(alX); __syncthreads(); } while (0)
    for (int t = 1; t + 1 < NT; t += 2) {
        ATT_HALF_STEP(pB0, pB1, alB, pA0, pA1, alA, t, 1, 0, 0);
        ATT_HALF_STEP(pA0, pA1, alA, pB0, pB1, alB, t + 1, 0, 1, 1);
    }
    const bool even = (NT & 1) == 0;
    if (even) { SBAR(); qkt<1>(pB0, pB1, lds, r32, hi, qr, qlds); SBAR(); }
    finishSM(pA0, pA1, alA, l_reg, pa0, pa1, pa2, pa3); SBAR();
    pv_tile<0>(o, vb0, pa0, pa1, pa2, pa3);
    if (even) { ATT_MASKT(pB0, pB1, NT - 1); partialSM(pB0, pB1, m_reg, alB); ATT_RESC(alB);
        finishSM(pB0, pB1, alB, l_reg, pa0, pa1, pa2, pa3); SBAR(); pv_tile<1>(o, vb0, pa0, pa1, pa2, pa3); }
    if (hi == 0) li_l[r32] = l_reg; LDS_WAIT();
    float rli[16];
#pragma unroll
    for (int r = 0; r < 16; ++r) rli[r] = __builtin_amdgcn_rcpf(li_l[crow(r, hi)]);
    bf16* Ow = OL + (size_t)q0 * GW + wid * VD;
#pragma unroll
    for (int r = 0; r < 16; ++r) { const int orow = crow(r, hi);
#pragma unroll
        for (int d0 = 0; d0 < 4; ++d0) { const float v = o[d0][r] * rli[r]; const float vn = __shfl_xor(v, 1);
            if ((r32 & 1) == 0) *(unsigned*)(Ow + (size_t)orow * GW + d0 * 32 + r32) = cvtpk(v, vn); } }
    __syncthreads();
#undef ATT_SLOAD
#undef ATT_SWRITE
#undef ATT_RESC
#undef ATT_MASKT
#undef ATT_HALF_STEP
}

__device__ __forceinline__ void decode_item(int item, const float* __restrict__ cckv, const float* __restrict__ ckr, const int* __restrict__ ptab, const bf16* __restrict__ QA, const bf16* __restrict__ QR,
                                            float* __restrict__ DPART, LAS unsigned char* lds, int tid, int wid, int lane) {
    constexpr int PPI = NPG / DSPLIT, NSTEP = 4 * PPI / NWAVES;
    const int b = item / DSPLIT, part = item % DSPLIT, r32 = lane & 31, hi = lane >> 5;
    constexpr int QOFF = NWAVES * DIMG, QSTR = 17 * 16;
    if (wid == 0) { const size_t qrow = (size_t)(SEQ + b);
        if (r32 < 8) { const bf16* qa = QA + qrow * ATTW + r32 * NOPE + hi * 8; const bf16* qq = QR + qrow * (NH * ROPE) + r32 * ROPE + hi * 8; LAS unsigned char* d = lds + QOFF + (hi * 8 + r32) * 16;
#pragma unroll
            for (int d0 = 0; d0 < 8; ++d0) *(LAS bf16x8*)(d + d0 * QSTR) = *(const bf16x8*)(qa + d0 * 16);
#pragma unroll
            for (int d0 = 0; d0 < 4; ++d0) *(LAS bf16x8*)(d + (8 + d0) * QSTR) = *(const bf16x8*)(qq + d0 * 16); }
        else if (lane == 8) { const bf16x8 z = {0, 0, 0, 0, 0, 0, 0, 0};
#pragma unroll
            for (int d0 = 0; d0 < 12; ++d0) *(LAS bf16x8*)(lds + QOFF + 256 + d0 * QSTR) = z; } }
    __syncthreads();
    const LAS unsigned char* qsl = lds + QOFF + (r32 < 8 ? (hi * 8 + r32) * 16 : 256);
    LAS unsigned char* img = lds + wid * DIMG;
    const int kaddr = r32 * DROW + 16 * hi;
    const int vaddr = (int)(uintptr_t)img + (8 * (lane >> 5) + ((lane >> 2) & 3)) * DROW + (16 * ((lane >> 4) & 1) + 4 * (lane & 3)) * 2;
    const int woA = (lane >> 5) * DROW + (lane & 31) * 8, woB = (lane >> 4) * DROW + 256 + (lane & 15) * 8;
    float m_reg = -1e30f, l_reg = 0.f; f32x16 o[4] = {};
    f32x4 sa[16], sb[8];
#define DEC_LOAD(s_) do { const int pg_ = PPI * part + wid + 8 * ((s_) >> 2); const int phys_ = __builtin_amdgcn_readfirstlane(ptab[b * NPG + pg_]); \
        const float* pc_ = cckv + (size_t)phys_ * (PAGE * KVR) + ((s_) & 3) * (32 * KVR) + lane * 4; const float* pk_ = ckr + (size_t)phys_ * (PAGE * ROPE) + ((s_) & 3) * (32 * ROPE) + lane * 4; \
        _Pragma("unroll") for (int i = 0; i < 16; ++i) sa[i] = __builtin_nontemporal_load((const f32x4*)(pc_ + i * 256)); \
        _Pragma("unroll") for (int i = 0; i < 8; ++i) sb[i] = __builtin_nontemporal_load((const f32x4*)(pk_ + i * 256)); } while (0)
    DEC_LOAD(0);
    for (int s = 0; s < NSTEP; ++s) {
#pragma unroll
        for (int i = 0; i < 16; ++i) *(LAS u32x2*)(img + woA + i * (2 * DROW)) = (u32x2){cvtpk(sa[i][0], sa[i][1]), cvtpk(sa[i][2], sa[i][3])};
#pragma unroll
        for (int i = 0; i < 8; ++i) *(LAS u32x2*)(img + woB + i * (4 * DROW)) = (u32x2){cvtpk(sb[i][0], sb[i][1]), cvtpk(sb[i][2], sb[i][3])};
        SBAR();
        if (s + 1 < NSTEP) DEC_LOAD(s + 1);
        SBAR();
        f32x16 p0 = {};
#pragma unroll
        for (int d0 = 0; d0 < 12; ++d0) { const bf16x8 a = *(const LAS bf16x8*)(img + kaddr + 32 * d0); const bf16x8 qf = *(const LAS bf16x8*)(qsl + d0 * QSTR); p0 = __builtin_amdgcn_mfma_f32_32x32x16_bf16(a, qf, p0, 0, 0, 0); }
        float pmax = p0[0];
#pragma unroll
        for (int r = 1; r < 16; ++r) pmax = fmaxf(pmax, p0[r]);
        pmax = pl_swap_max(pmax);
        float mn, alpha;
        if (__builtin_expect(__all(pmax - m_reg <= THR2), 1)) { mn = m_reg; alpha = 1.f; }
        else { mn = fmaxf(m_reg, pmax); alpha = __builtin_amdgcn_exp2f(m_reg - mn); m_reg = mn; }
        float ps = 0.f;
#pragma unroll
        for (int r = 0; r < 16; ++r) { p0[r] = __builtin_amdgcn_exp2f(p0[r] - mn); ps += p0[r]; }
        ps = pl_swap_add(ps);
        l_reg = l_reg * alpha + ps;
        bf16x8 pa0, pa1; ATT_PK4(p0, 0, pa0); ATT_PK4(p0, 8, pa1);
        if (__any(alpha < 1.f)) {
#pragma unroll
            for (int r = 0; r < 4; ++r) { const float a = __shfl(alpha, r + 4 * hi);
#pragma unroll
                for (int d = 0; d < 4; ++d) o[d][r] *= a; } }
#define DEC_PV_D0(d0) do { s16x4 l0, h0, l1, h1; ATT_TRRD(l0, vaddr, (d0) * 64); ATT_TRRD(h0, vaddr, (d0) * 64 + 4 * DROW); ATT_TRRD(l1, vaddr, (d0) * 64 + 16 * DROW); ATT_TRRD(h1, vaddr, (d0) * 64 + 20 * DROW); \
        asm volatile("s_waitcnt lgkmcnt(0)" ::: "memory"); SBAR(); \
        o[d0] = __builtin_amdgcn_mfma_f32_32x32x16_bf16(pa0, ATT_PK(l0, h0), o[d0], 0, 0, 0); \
        o[d0] = __builtin_amdgcn_mfma_f32_32x32x16_bf16(pa1, ATT_PK(l1, h1), o[d0], 0, 0, 0); } while (0)
        DEC_PV_D0(0); DEC_PV_D0(1); DEC_PV_D0(2); DEC_PV_D0(3);
#undef DEC_PV_D0
        asm volatile("" ::: "memory");
    }
#undef DEC_LOAD
    LDS_WAIT();
    { LAS float* Ow = (LAS float*)img; LAS float* ml = (LAS float*)(img + 4096);
#pragma unroll
      for (int r = 0; r < 4; ++r)
#pragma unroll
          for (int d = 0; d < 4; ++d) Ow[(r + 4 * hi) * VD + d * 32 + r32] = o[d][r];
      if (lane < 8) { ml[2 * lane] = m_reg; ml[2 * lane + 1] = l_reg; } }
    __syncthreads();
    { const int head = tid >> 6, c = tid & 63; float M = -1e30f;
#pragma unroll
      for (int w = 0; w < NWAVES; ++w) M = fmaxf(M, ((LAS float*)(lds + w * DIMG + 4096))[2 * head]);
      float L = 0.f, O0 = 0.f, O1 = 0.f;
#pragma unroll
      for (int w = 0; w < NWAVES; ++w) { LAS float* ml = (LAS float*)(lds + w * DIMG + 4096); LAS float* Ow = (LAS float*)(lds + w * DIMG) + head * VD;
          const float f = __builtin_amdgcn_exp2f(ml[2 * head] - M); L += ml[2 * head + 1] * f; O0 += Ow[c] * f; O1 += Ow[c + 64] * f; }
      float* dp = DPART + ((size_t)item * NH + head) * 130; dp[c] = O0; dp[c + 64] = O1; if (c == 0) { dp[128] = M; dp[129] = L; } }
    __syncthreads();
}
}
#define XB_TMO      128
#define XB_XCNT(j)  (256  + 64 * (j))
#define XB_XSUB(j)  (1280 + 64 * (j))
#define XB_XGEN(j)  (2304 + 64 * (j))
#define XB_TOP      3328
#define XB_TOPGEN   3392
#define XCD_BAR_WORDS 3456
#define XB_SPIN_CAP (1u << 18)

__device__ __forceinline__ unsigned xb_ld(unsigned* p)              { return __hip_atomic_load(p, __ATOMIC_RELAXED, __HIP_MEMORY_SCOPE_AGENT); }
__device__ __forceinline__ unsigned xb_add(unsigned* p, unsigned v) { return __hip_atomic_fetch_add(p, v, __ATOMIC_RELAXED, __HIP_MEMORY_SCOPE_AGENT); }
__device__ __forceinline__ unsigned xb_xcc_id() { return (unsigned)__builtin_amdgcn_s_getreg((3 << 11) | 20) & 0xFu; }
#define XB_SPIN(cond, bar) do { unsigned _sp = 0; while (cond) { __builtin_amdgcn_s_sleep(1); \
    if ((++_sp & 255u) == 0u) { if (xb_ld(&(bar)[XB_TMO])) break; if (_sp > XB_SPIN_CAP) { atomicAdd(&(bar)[XB_TMO], 1u); break; } } } } while (0)

struct XcdBarrier {
    unsigned* bar; unsigned x;
    volatile LAS unsigned* st;
};

__device__ __forceinline__ XcdBarrier xcd_barrier_post(unsigned* bar, volatile LAS unsigned* st) {
    XcdBarrier b; b.bar = bar; b.x = xb_xcc_id(); b.st = st;
    if (threadIdx.x == 0) (void)xb_add(&bar[XB_XCNT(b.x)], 1u);
    return b;
}
__device__ __forceinline__ void xcd_barrier_complete(unsigned* bar, unsigned x, unsigned& nloc, unsigned& nx) {
    const unsigned G = gridDim.x * gridDim.y * gridDim.z;
    unsigned sum, cnt, mine, sp = 0u;
    for (;;) {
        sum = 0u; cnt = 0u; mine = 0u;
#pragma unroll
        for (unsigned j = 0; j < 16; ++j) { const unsigned c = xb_ld(&bar[XB_XCNT(j)]); sum += c; cnt += (c > 0u) ? 1u : 0u; mine = (j == x) ? c : mine; }
        if (sum == G) break;
        __builtin_amdgcn_s_sleep(1);
        if ((++sp & 255u) == 0u) { if (xb_ld(&bar[XB_TMO])) break; if (sp > XB_SPIN_CAP) { atomicAdd(&bar[XB_TMO], 1u); break; } }
    }
    nloc = mine > 0u ? mine : 1u; nx = cnt > 0u ? cnt : 1u;
}

__device__ __forceinline__ void xcd_barrier(const XcdBarrier& b) {
    asm volatile("s_waitcnt vmcnt(0)" ::: "memory");
    __syncthreads();
    if (threadIdx.x == 0) {
        unsigned* bar = b.bar;
        __builtin_amdgcn_s_waitcnt(0);
        unsigned nloc = b.st[0], nx = b.st[1];
        if (nloc == 0u) { xcd_barrier_complete(bar, b.x, nloc, nx); b.st[0] = nloc; b.st[1] = nx; }
        const unsigned old = xb_add(&bar[XB_XSUB(b.x)], 1u);
        const unsigned gen = old / nloc;
        if (old + 1u == (gen + 1u) * nloc) {
            __builtin_amdgcn_fence(__ATOMIC_RELEASE, "agent");
            asm volatile("s_waitcnt vmcnt(0)" ::: "memory");
            const unsigned og = xb_add(&bar[XB_TOP], 1u);
            const unsigned tg = og / nx;
            if (og + 1u == (tg + 1u) * nx) xb_add(&bar[XB_TOPGEN], 1u);
            else XB_SPIN(xb_ld(&bar[XB_TOPGEN]) == tg, bar);
            __builtin_amdgcn_fence(__ATOMIC_ACQUIRE, "agent");
            xb_add(&bar[XB_XGEN(b.x)], 1u);
            asm volatile("s_waitcnt vmcnt(0)" ::: "memory");
        } else {
            XB_SPIN(xb_ld(&bar[XB_XGEN(b.x)]) == gen, bar);
            __builtin_amdgcn_fence(__ATOMIC_ACQUIRE, "agent");
            asm volatile("s_waitcnt vmcnt(0)" ::: "memory");
        }
    }
    __syncthreads();
}

struct Args { const float* in[19]; float* out; unsigned char* ws; int ph_lo, ph_hi; };
enum { I_XP = 0, I_XS, I_CKV, I_CKR, I_SPOOL, I_PTAB, I_GPRE, I_WIN, I_GQ, I_WUQ, I_GKV, I_WUK, I_WUV, I_WOATT, I_WPOOL, I_PSCALE, I_WOPOOL, I_WOUT, I_GFINAL };
constexpr int N_PHASES = 9;

__device__ __forceinline__ void p0_transpose_item(const float* __restrict__ W, int K, int N, bf16* __restrict__ WT, int row_off, LAS float* scr, int item, int lane) {
    const int nblk = N / 32, kb = item / nblk, nb = item % nblk, k0 = 64 * kb, n0 = 32 * nb;
#pragma unroll 8
    for (int i = 0; i < 32; ++i) { const int kk = 2 * i + (lane >> 5); scr[kk * 33 + (lane & 31)] = W[(size_t)(k0 + kk) * N + n0 + (lane & 31)]; }
    LDS_WAIT(); asm volatile("" ::: "memory");
    const int c = lane & 7;
#pragma unroll
    for (int j = 0; j < 4; ++j) { const int n = (lane >> 3) + 8 * j; const LAS float* s = scr + (8 * c) * 33 + n;
        u32x4 o; o.x = cvtpk(s[0 * 33], s[1 * 33]); o.y = cvtpk(s[2 * 33], s[3 * 33]); o.z = cvtpk(s[4 * 33], s[5 * 33]); o.w = cvtpk(s[6 * 33], s[7 * 33]);
        *(u32x4*)(WT + (size_t)(row_off + n0 + n) * K + k0 + 8 * c) = o; }
    LDS_WAIT(); asm volatile("" ::: "memory");
}


#define PHASE_ARGS() \
    int tid_ = threadIdx.x; asm volatile("" : "+v"(tid_)); const int tid = tid_, lane = tid & 63, wave = __builtin_amdgcn_readfirstlane(tid >> 6); (void)lane; \
    const __attribute__((address_space(4))) Args* ap_ = (const __attribute__((address_space(4))) Args*)__builtin_amdgcn_kernarg_segment_ptr(); asm volatile("" : "+s"(ap_)); const __attribute__((address_space(4))) Args& args = *ap_; \
    unsigned char* ws = args.ws; float* out = args.out; (void)out; \
    bf16* BT1 = (bf16*)(ws + WS_BT1); bf16* BTQ = (bf16*)(ws + WS_BTQ); bf16* BTG = (bf16*)(ws + WS_BTG); bf16* BTOA = (bf16*)(ws + WS_BTOA); bf16* BTOP = (bf16*)(ws + WS_BTOP); bf16* BTOUT = (bf16*)(ws + WS_BTOUT); \
    float* ROPET = (float*)(ws + WS_ROPE); float* QSS = (float*)(ws + WS_QSS); float* DPART = (float*)(ws + WS_DPART); \
    bf16* H = (bf16*)(ws + WS_H); bf16* QLAT = (bf16*)(ws + WS_QLAT); float* KVRAW = (float*)(ws + WS_KVRAW); bf16* KB = (bf16*)(ws + WS_KB); bf16* SZ = (bf16*)(ws + WS_SZ); \
    float* U = (float*)(ws + WS_U); bf16* SGA = (bf16*)(ws + WS_SGA); bf16* SGP = (bf16*)(ws + WS_SGP); bf16* OLPL = (bf16*)(ws + WS_OLPL); bf16* QA = (bf16*)(ws + WS_QA); bf16* QR = (bf16*)(ws + WS_QR); \
    bf16* G12 = (bf16*)(ws + WS_G12); float* M1 = (float*)(ws + WS_M1); bf16* MG = (bf16*)(ws + WS_MG); \
    (void)BT1; (void)BTQ; (void)BTG; (void)BTOA; (void)BTOP; (void)BTOUT; (void)ROPET; (void)QSS; (void)DPART; (void)H; (void)QLAT; (void)KVRAW; (void)KB; (void)SZ; (void)U; (void)SGA; (void)SGP; (void)OLPL; (void)QA; (void)QR; (void)G12; (void)M1; (void)MG; \
    const int G = gridDim.x, bx = blockIdx.x; const int vcu = (G % 8 == 0) ? (bx % 8) * (G / 8) + bx / 8 : bx; const int gw = vcu * NWAVES + wave, NGW = G * NWAVES; (void)gw; (void)NGW;

__global__ void __launch_bounds__(NWAVES * 64, 2) mk_fwd(Args args_in) {
    extern __shared__ __attribute__((aligned(16))) unsigned char lds_raw[];
    LAS unsigned char* lds = (LAS unsigned char*)lds_raw;
    volatile LAS unsigned* MISC = (volatile LAS unsigned*)(lds + MISC_OFF);
    for (int u = threadIdx.x; u < (LDS_BYTES - LDSCTL_OFF) / 4; u += NWAVES * 64) ((LAS unsigned*)(lds + LDSCTL_OFF))[u] = 0u;
    __syncthreads();
    const int lo = args_in.ph_lo, hi = args_in.ph_hi;
    XcdBarrier bar = xcd_barrier_post((unsigned*)(args_in.ws + WS_CTL) + CW_BAR + lo * XCD_BAR_WORDS, MISC + 8);
#ifndef PH_MASK
#define PH_MASK 0x1ff
#endif
#define IN(k) (((PH_MASK >> (k)) & 1) && lo <= (k) && (k) < hi)
#define SEAM(k) do { if (IN(k) && IN((k) + 1)) xcd_barrier(bar); } while (0)
#ifdef MK_CHECK
#define STAMP(k) do { if (blockIdx.x == 0 && threadIdx.x == 0) ((unsigned long long*)((unsigned*)(args_in.ws + WS_CTL) + 131072 + 64))[(k)] = __builtin_amdgcn_s_memrealtime(); } while (0)
#else
#define STAMP(k) do { } while (0)
#endif
#ifdef MK_CHECK
#define STAMPX(k) do { if (threadIdx.x == 0) ((unsigned long long*)((unsigned*)(args_in.ws + WS_CTL) + 131072 + 64))[(k)] = __builtin_amdgcn_s_memrealtime(); } while (0)
#else
#define STAMPX(k) do { } while (0)
#endif
    STAMP(0);

    if (IN(0)) { PHASE_ARGS()
        LAS float* scr = (LAS float*)(lds + RING_OFF + wave * 16384);
        { constexpr int I_1 = (DM / 64) * (INC / 32), I_OA = (ATTW / 64) * (DM / 32), I_OP = (POOLW / 64) * (DM / 32), I_OUT = (DM / 64) * (DM / 32), NIT = I_1 + I_OA + I_OP + I_OUT;
          for (int it = gw; it < NIT; it += NGW) { int r = it;
              if (r < I_1) { const int nb = r % (INC / 32); p0_transpose_item(args.in[I_WIN], DM, INC, BT1, (32 * nb >= 448) ? 64 : 0, scr, r, lane); continue; } r -= I_1;
              if (r < I_OA) { p0_transpose_item(args.in[I_WOATT], ATTW, DM, BTOA, 0, scr, r, lane); continue; } r -= I_OA;
              if (r < I_OP) { p0_transpose_item(args.in[I_WOPOOL], POOLW, DM, BTOP, 0, scr, r, lane); continue; } r -= I_OP;
              p0_transpose_item(args.in[I_WOUT], DM, DM, BTOUT, 0, scr, r, lane); } }
        for (int i = bx * 512 + tid; i < 64 * DM / 8; i += G * 512) *(u32x4*)(BT1 + (size_t)448 * DM + (size_t)i * 8) = (u32x4){0u, 0u, 0u, 0u};
        for (int it = gw; it < 1536; it += NGW) {
            const float* wuq = args.in[I_WUQ]; const float* gq = args.in[I_GQ];
            if (it < 1024) { const int h = it >> 7, r = it & 127; const float* uk = args.in[I_WUK] + ((size_t)r * NH + h) * NOPE;
                float a[4] = {0.f, 0.f, 0.f, 0.f};
#pragma unroll 8
                for (int n = 0; n < NOPE; n += 4) { const f32x4 k4 = *(const f32x4*)(uk + n);
#pragma unroll
                    for (int j = 0; j < 4; ++j) { const f32x4 q4 = *(const f32x4*)(wuq + (size_t)(lane + 64 * j) * (NH * (NOPE + ROPE)) + h * (NOPE + ROPE) + n);
                        a[j] += (q4[0] * k4[0] + q4[1] * k4[1]) + (q4[2] * k4[2] + q4[3] * k4[3]); } }
#pragma unroll
                for (int j = 0; j < 4; ++j) { const int k = lane + 64 * j; BTQ[(size_t)it * QRANK + k] = (bf16)(cvtpk(a[j] * gq[k], 0.f) & 0xffffu); }
            } else { const int j2 = it - 1024, pn = j2 >> 8, jj = j2 & 255, bj = jj >> 7, x = jj & 127, head = 4 * pn + (x >> 5), dim = (x & 31) + 32 * bj;
#pragma unroll
                for (int j = 0; j < 4; ++j) { const int k = lane + 64 * j; BTQ[(size_t)it * QRANK + k] = (bf16)(cvtpk(gq[k] * wuq[(size_t)k * (NH * (NOPE + ROPE)) + head * (NOPE + ROPE) + NOPE + dim], 0.f) & 0xffffu); } }
        }
        for (int it = gw; it < 1536; it += NGW) {
#pragma unroll
            for (int j = 0; j < 4; ++j) { const int kk = lane + 64 * j; float v = 0.f;
                if (it < 1024) { const int h = it >> 7, vv = it & 127; if ((kk >> 7) == (h & 1)) v = args.in[I_WUV][((size_t)(kk & 127) * NH + h) * VD + vv]; }
                else { const int n = it - 1024, g = n >> 7, d = n & 127; if ((kk >> 7) == (g & 1)) v = args.in[I_WPOOL][((size_t)g * 128 + (kk & 127)) * 128 + d]; }
                BTG[(size_t)it * 256 + kk] = (bf16)(cvtpk(v, 0.f) & 0xffffu); }
        }
        for (int e = gw * 64 + lane; e < (SEQ + 1) * 32; e += NGW * 64) { const int pos = e >> 5, i = e & 31;
            const float inv = powf(10000.0f, -(float)i / 32.0f); const float ang = (float)pos * inv;
            ROPET[2 * (size_t)e] = (float)cos((double)ang); ROPET[2 * (size_t)e + 1] = (float)sin((double)ang); }
        for (int m0 = gw; m0 < MTOT; m0 += 2 * NGW) {
            const f32x4* gr = (const f32x4*)args.in[I_GPRE] + lane;
            f32x4 v[2][4]; float s[2] = {0.f, 0.f};
#pragma unroll
            for (int u = 0; u < 2; ++u) { const int m = m0 + u * NGW; if (m < MTOT) {
                const float* xrow = m < SEQ ? args.in[I_XP] + (size_t)m * DM : args.in[I_XS] + (size_t)(m - SEQ) * DM; const f32x4* xr = (const f32x4*)xrow + lane;
#pragma unroll
                for (int j = 0; j < 4; ++j) v[u][j] = __builtin_nontemporal_load(xr + 64 * j); } }
#pragma unroll
            for (int u = 0; u < 2; ++u) { const int m = m0 + u * NGW; if (m < MTOT) {
#pragma unroll
                for (int j = 0; j < 4; ++j) s[u] += (v[u][j][0] * v[u][j][0] + v[u][j][1] * v[u][j][1]) + (v[u][j][2] * v[u][j][2] + v[u][j][3] * v[u][j][3]);
                const float rs = 1.0f / sqrtf(wave_sum(s[u]) * (1.f / DM) + EPS);
                unsigned long long* o8 = (unsigned long long*)(H + (size_t)m * DM) + lane;
#pragma unroll
                for (int j = 0; j < 4; ++j) { const f32x4 g = gr[64 * j]; o8[64 * j] = (unsigned long long)cvtpk(v[u][j][0] * rs * g[0], v[u][j][1] * rs * g[1]) | ((unsigned long long)cvtpk(v[u][j][2] * rs * g[2], v[u][j][3] * rs * g[3]) << 32); } } }
        }
        VM_WAIT(); __syncthreads();
    }
    SEAM(0); STAMP(1);

    if (IN(1)) { PHASE_ARGS()
        pg8::Gemm g{H, BT1, DM, DM, DM, 0}; pg8::StaticOrder S; S.init(MPAD, N1, G, bx);
        pg8::Epi1 E{QLAT, QSS, KVRAW, SZ, U, SGA, SGP};
        pg8::gemm_phase<pg8::Epi1, pg8::StaticOrder, true, true>(lds + RING_OFF, g, S, E);
    }
    SEAM(1); STAMP(2);

    if (IN(2)) { PHASE_ARGS()
#ifndef P2_NO_ELEM
        for (int r0 = gw; r0 < MTOT; r0 += 2 * NGW) {
            float v0[2], v1[2], x1[2], x2[2], cs[2], sn[2];
#pragma unroll
            for (int u = 0; u < 2; ++u) { const int row = r0 + u * NGW < MTOT ? r0 + u * NGW : r0; const float* src = KVRAW + (size_t)row * QKD; const int pos = row < SEQ ? row : SEQ;
                v0[u] = src[lane]; v1[u] = src[lane + 64]; x1[u] = src[KVR + (lane & 31)]; x2[u] = src[KVR + 32 + (lane & 31)];
                cs[u] = ROPET[2 * ((size_t)pos * 32 + (lane & 31))]; sn[u] = ROPET[2 * ((size_t)pos * 32 + (lane & 31)) + 1]; }
#pragma unroll
            for (int u = 0; u < 2; ++u) { const int row = r0 + u * NGW; if (row < MTOT) {
                float* ckv_o = row < SEQ ? out + O_CKVP + (size_t)row * KVR : out + O_CKVS + (size_t)(row - SEQ) * KVR;
                float* kr_o = row < SEQ ? out + O_KRP + (size_t)row * ROPE : out + O_KRS + (size_t)(row - SEQ) * ROPE;
                const float rs = 1.0f / sqrtf(wave_sum(v0[u] * v0[u] + v1[u] * v1[u]) * (1.f / KVR) + EPS);
                const float c0 = v0[u] * rs * args.in[I_GKV][lane], c1 = v1[u] * rs * args.in[I_GKV][lane + 64];
                ckv_o[lane] = c0; ckv_o[lane + 64] = c1;
                bf16* kb = KB + (size_t)row * QKD; kb[lane] = (bf16)(cvtpk(c0, 0.f) & 0xffffu); kb[lane + 64] = (bf16)(cvtpk(c1, 0.f) & 0xffffu);
                if (lane < 32) { const float o1 = x1[u] * cs[u] - x2[u] * sn[u], o2 = x2[u] * cs[u] + x1[u] * sn[u];
                    kr_o[lane] = o1; kr_o[lane + 32] = o2; kb[KVR + lane] = (bf16)(cvtpk(o1, 0.f) & 0xffffu); kb[KVR + 32 + lane] = (bf16)(cvtpk(o2, 0.f) & 0xffffu); } } }
        }
        for (int it = gw; it < (SEQ / 32) * 4; it += NGW) { const int q = it & 3, t0 = (it >> 2) * 32, w = 2 << q, c = 128 * q + 2 * lane;
            const float* __restrict__ Uc = U + c; bf16* __restrict__ Oc = OLPL + ATTW + c;
            f32x2 sum = {0.f, 0.f};
            for (int i = 1; i < w; ++i) { const int t = t0 - i; if (t >= 0) sum += *(const f32x2*)(Uc + (size_t)t * POOLW); }
            for (int tb = t0; tb < t0 + 32; tb += 8) { f32x2 un[8], uo[8];
#pragma unroll
                for (int j = 0; j < 8; ++j) { un[j] = *(const f32x2*)(Uc + (size_t)(tb + j) * POOLW); const int told = tb + j - (w - 1); uo[j] = (f32x2){0.f, 0.f}; if (told >= 0) uo[j] = *(const f32x2*)(Uc + (size_t)told * POOLW); }
#pragma unroll
                for (int j = 0; j < 8; ++j) { const int t = tb + j; sum += un[j]; const float rc = 1.0f / (float)(t + 1 < w ? t + 1 : w);
                    *(unsigned*)(Oc + (size_t)t * GW) = cvtpk(sum[0] * rc - un[j][0], sum[1] * rc - un[j][1]); sum -= uo[j]; } }
        }
        for (int it = gw; it < NS * 4; it += NGW) { const int q = it & 3, b = it >> 2, w = 2 << q, c = 128 * q + 2 * lane;
            const f32x2 u = *(const f32x2*)(U + (size_t)(SEQ + b) * POOLW + c); f32x2 sum = u;
            for (int i = 0; i < w - 1; ++i) sum += *(const f32x2*)(args.in[I_SPOOL] + ((size_t)b * PHIST + (PHIST - 1 - i)) * POOLW + c);
            const float rc = 1.0f / (float)w;
            *(unsigned*)(OLPL + (size_t)(SEQ + b) * GW + ATTW + c) = cvtpk(sum[0] * rc - u[0], sum[1] * rc - u[1]); }
        for (int e = gw * 64 + lane; e < (PHIST * POOLW + NS * PHIST * POOLW) / 4; e += NGW * 64) {
            if (e < PHIST * POOLW / 4) { *(f32x4*)(out + O_POOLP + (size_t)e * 4) = *(const f32x4*)(U + (size_t)(SEQ - PHIST) * POOLW + (size_t)e * 4); }
            else { const int e2 = e - PHIST * POOLW / 4, b = e2 / (PHIST * POOLW / 4), r = e2 % (PHIST * POOLW / 4), j = r / (POOLW / 4), c4 = r % (POOLW / 4);
                const f32x4 v = j < PHIST - 1 ? *(const f32x4*)(args.in[I_SPOOL] + ((size_t)b * PHIST + j + 1) * POOLW + c4 * 4) : *(const f32x4*)(U + (size_t)(SEQ + b) * POOLW + c4 * 4);
                *(f32x4*)(out + O_POOLS + (size_t)e2 * 4) = v; } }
#endif
#ifndef P2_NO_GEMM
        pg8::Gemm g{QLAT, BTQ, QRANK, QRANK, QRANK, 0}; pg8::StaticOrder S; S.init(MPAD, 1536, G, bx);
        pg8::Epi2 E{QA, QR, QSS, ROPET};
        pg8::gemm_phase<pg8::Epi2, pg8::StaticOrder, true, true>(lds + RING_OFF, g, S, E);
#endif
    }
    SEAM(2); STAMP(3);

    if (IN(3)) { PHASE_ARGS()
        gu32* qp = (gu32*)(ws + WS_CTL) + CW_QPROMPT; gu32* qd = (gu32*)(ws + WS_CTL) + CW_QDEC;
        volatile LAS unsigned* slot = (volatile LAS unsigned*)(lds + MISC_OFF) + 16;
#define GRAB(q_, v_) do { if (tid == 0) *slot = __hip_atomic_fetch_add((q_), 1u, __ATOMIC_RELAXED, __HIP_MEMORY_SCOPE_AGENT); __syncthreads(); (v_) = (int)*slot; __syncthreads(); } while (0)
        int mode = bx < ND_FIRST ? 0 : 1;
        for (int done = 0; done < 2;) {
            int it;
            const __attribute__((address_space(4))) Args* a2 = (const __attribute__((address_space(4))) Args*)__builtin_amdgcn_kernarg_segment_ptr(); asm volatile("" : "+s"(a2));
            unsigned char* w2 = a2->ws;
            int t2 = tid; asm volatile("" : "+v"(t2)); const int l2 = t2 & 63;
            if (mode == 0) { GRAB(qd, it); if (it >= NS * DSPLIT) { if (it == NS * DSPLIT) STAMPX(12); mode = 1; ++done; continue; }
                att::decode_item(it, a2->in[I_CKV], a2->in[I_CKR], (const int*)a2->in[I_PTAB], (const bf16*)(w2 + WS_QA), (const bf16*)(w2 + WS_QR), (float*)(w2 + WS_DPART), lds + RING_OFF, t2, wave, l2); }
            else { GRAB(qp, it); if (it >= SEQ / 32) { if (it == SEQ / 32) STAMPX(13); mode = 0; ++done; continue; }
                att::prompt_unit(32 * (SEQ / 32 - 1 - it), (const bf16*)(w2 + WS_QA), (const bf16*)(w2 + WS_QR), (const bf16*)(w2 + WS_KB), (bf16*)(w2 + WS_OLPL), lds + RING_OFF, t2, wave, l2); }
        }
#undef GRAB
    }
    SEAM(3); STAMP(4);

    if (IN(4)) { PHASE_ARGS()
        for (int it = gw; it < NS * NH; it += NGW) { const int b = it >> 3, h = it & 7; const size_t row = (size_t)(SEQ + b);
            const float* dp = DPART + ((size_t)(b * DSPLIT) * NH + h) * 130;
            const bf16* qa = QA + row * ATTW + h * NOPE; const bf16* qq = QR + row * (NH * ROPE) + h * ROPE; const bf16* kb = KB + row * QKD;
            float ts = bf2f(qa[lane]) * bf2f(kb[lane]) + bf2f(qa[lane + 64]) * bf2f(kb[lane + 64]) + bf2f(qq[lane]) * bf2f(kb[KVR + lane]);
            ts = wave_sum(ts);
            float M = ts;
#pragma unroll
            for (int p = 0; p < DSPLIT; ++p) M = fmaxf(M, dp[p * NH * 130 + 128]);
            const float wsf = __builtin_amdgcn_exp2f(ts - M);
            float L = wsf, o0 = wsf * bf2f(kb[lane]), o1 = wsf * bf2f(kb[lane + 64]);
#pragma unroll
            for (int p = 0; p < DSPLIT; ++p) { const float* d = dp + p * NH * 130; const float w = __builtin_amdgcn_exp2f(d[128] - M); L += d[129] * w; o0 += d[lane] * w; o1 += d[lane + 64] * w; }
            const float rl = 1.0f / L;
            OLPL[row * GW + h * VD + lane] = (bf16)(cvtpk(o0 * rl, 0.f) & 0xffffu); OLPL[row * GW + h * VD + lane + 64] = (bf16)(cvtpk(o1 * rl, 0.f) & 0xffffu);
        }
        VM_WAIT(); __syncthreads();
    }
    SEAM(4); STAMP(5);

    if (IN(5)) { PHASE_ARGS()
        pg8::Gemm g{OLPL, BTG, GW, 256, 256, 256}; pg8::StaticOrder S; S.init(MPAD, GW, G, bx);
        pg8::Epi5 E{G12, SZ, args.in[I_PSCALE]};
        pg8::gemm_phase<pg8::Epi5, pg8::StaticOrder, true, true>(lds + RING_OFF, g, S, E);
    }
    SEAM(5); STAMP(6);

    if (IN(6)) { PHASE_ARGS()
        { pg8::Gemm g{G12, BTOA, GW, ATTW, ATTW, 0}; pg8::StaticOrder S; S.init(MPAD, DM, G, bx);
          pg8::Epi6<false> E{M1, MG, SGA};
          pg8::gemm_phase<pg8::Epi6<false>, pg8::StaticOrder, true, true>(lds + RING_OFF, g, S, E); }
        VM_WAIT(); __syncthreads();
        { pg8::Gemm g{G12 + ATTW, BTOP, GW, POOLW, POOLW, 0}; pg8::StaticOrder S; S.init(MPAD, DM, G, bx);
          pg8::Epi6<true> E{M1, MG, SGP};
          pg8::gemm_phase<pg8::Epi6<true>, pg8::StaticOrder, true, true>(lds + RING_OFF, g, S, E); }
    }
    SEAM(6); STAMP(7);

    if (IN(7)) { PHASE_ARGS()
        pg8::Gemm g{MG, BTOUT, DM, DM, DM, 0}; pg8::StaticOrder S; S.init(MPAD, DM, G, bx);
        pg8::Epi7 E{args.in[I_XP], args.in[I_XS], out};
        pg8::gemm_phase<pg8::Epi7, pg8::StaticOrder, true, true>(lds + RING_OFF, g, S, E);
    }
    SEAM(7); STAMP(8);

    if (IN(8)) { PHASE_ARGS()
        for (int m = gw; m < MTOT; m += NGW) {
            float* y = m < SEQ ? out + O_YP + (size_t)m * DM : out + O_YS + (size_t)(m - SEQ) * DM;
            f32x4* yr = (f32x4*)y + lane; const f32x4* gr = (const f32x4*)args.in[I_GFINAL] + lane;
            f32x4 v[4]; float s = 0.f;
#pragma unroll
            for (int j = 0; j < 4; ++j) { v[j] = yr[64 * j]; s += (v[j][0] * v[j][0] + v[j][1] * v[j][1]) + (v[j][2] * v[j][2] + v[j][3] * v[j][3]); }
            const float rs = 1.0f / sqrtf(wave_sum(s) * (1.f / DM) + EPS);
#pragma unroll
            for (int j = 0; j < 4; ++j) yr[64 * j] = v[j] * rs * gr[64 * j];
        }
    }
    STAMP(9);
#undef IN
#undef SEAM
}

#ifndef MK_CUTS
#define MK_CUTS 0
#endif
extern "C" void kernel_launch(void* const* d_in, const int* in_sizes, int n_in, void* d_out, int out_size, void* d_ws, size_t ws_size, hipStream_t stream) {
    static int grid = 0;
    if (grid == 0) {
        if (n_in != 19 || out_size != (int)O_END || ws_size < WS_END) { fprintf(stderr, "kernel_launch: built for 19 inputs, %zu outputs, >= %zu bytes of workspace; got %d, %d, %zu\n", (size_t)O_END, (size_t)WS_END, n_in, out_size, ws_size); grid = -1; return; }
        int dev = 0, cus = 0, per_cu = 0;
        if (hipGetDevice(&dev) != hipSuccess || hipDeviceGetAttribute(&cus, hipDeviceAttributeMultiprocessorCount, dev) != hipSuccess) { grid = -1; return; }
        if (hipFuncSetAttribute((const void*)mk_fwd, hipFuncAttributeMaxDynamicSharedMemorySize, LDS_BYTES) != hipSuccess) { fprintf(stderr, "kernel_launch: hipFuncSetAttribute failed\n"); grid = -1; return; }
        if (hipOccupancyMaxActiveBlocksPerMultiprocessor(&per_cu, (const void*)mk_fwd, NWAVES * 64, LDS_BYTES) != hipSuccess || per_cu < 1) { fprintf(stderr, "kernel_launch: occupancy query says %d workgroups per CU\n", per_cu); }
        (void)hipGetLastError();
        grid = cus;
    }
    if (grid < 0) return;
    (void)hipMemsetAsync((char*)d_ws + WS_CTL, 0, CTL_ZERO_BYTES, stream);
    Args a{};
    for (int i = 0; i < 19; ++i) a.in[i] = (const float*)d_in[i];
    a.out = (float*)d_out; a.ws = (unsigned char*)d_ws;
#if MK_CUTS
    for (int p = 0; p < N_PHASES; ++p) { a.ph_lo = p; a.ph_hi = p + 1; hipLaunchKernelGGL(mk_fwd, dim3(grid), dim3(NWAVES * 64), LDS_BYTES, stream, a); }
#else
    a.ph_lo = 0; a.ph_hi = N_PHASES; hipLaunchKernelGGL(mk_fwd, dim3(grid), dim3(NWAVES * 64), LDS_BYTES, stream, a);
#endif
#ifdef MK_CHECK
    { static bool once = false; if (!once) { once = true; (void)hipFuncSetAttribute((const void*)chk_attn, hipFuncAttributeMaxDynamicSharedMemorySize, 68000); }
#ifndef CHK_NOERR
      hipLaunchKernelGGL(chk_attn, dim3(160 * 8), dim3(256), 68000, stream, a);
      hipLaunchKernelGGL(chk_chain, dim3(64), dim3(256), 0, stream, a);
#endif
      hipLaunchKernelGGL(chk_report, dim3(64), dim3(256), 0, stream, a); }
#endif
    const hipError_t le = hipPeekAtLastError();
    if (le != hipSuccess) fprintf(stderr, "kernel_launch: launch failed: %s\n", hipGetErrorName(le));
}
```

```cpp
#include <hip/hip_runtime.h>
#include <cstdio>
#include <cstdint>

#define GAS __attribute__((address_space(1)))
#define LAS __attribute__((address_space(3)))
typedef unsigned short bf16;
typedef short bf16x8 __attribute__((ext_vector_type(8)));
typedef short s16x4 __attribute__((ext_vector_type(4)));
typedef float f32x2 __attribute__((ext_vector_type(2)));
typedef float f32x4 __attribute__((ext_vector_type(4)));
typedef float f32x16 __attribute__((ext_vector_type(16)));
typedef unsigned u32x2 __attribute__((ext_vector_type(2)));
typedef unsigned u32x4 __attribute__((ext_vector_type(4)));
typedef GAS unsigned gu32;

constexpr int DM = 1024, SEQ = 16384, NS = 128, PAST = 16384, PAGE = 128, NPG = PAST / PAGE;
constexpr int MTOT = SEQ + NS;
constexpr int MPAD = 65 * 256;
constexpr int NH = 8, NOPE = 128, ROPE = 64, VD = 128, QRANK = 256, KVR = 128, ATTW = NH * VD, POOLW = 512, PHIST = 15;
constexpr int QKD = KVR + ROPE;
constexpr int INC = 4544, N1 = 4608;
constexpr int GW = ATTW + POOLW;
constexpr float EPS = 1e-6f;
constexpr float C2 = 0.07216878364870322f * 1.4426950408889634f;
constexpr size_t O_YP = 0, O_YS = O_YP + (size_t)SEQ * DM, O_CKVP = O_YS + (size_t)NS * DM, O_KRP = O_CKVP + (size_t)SEQ * KVR, O_POOLP = O_KRP + (size_t)SEQ * ROPE,
                 O_CKVS = O_POOLP + (size_t)PHIST * POOLW, O_KRS = O_CKVS + (size_t)NS * KVR, O_POOLS = O_KRS + (size_t)NS * ROPE, O_END = O_POOLS + (size_t)NS * PHIST * POOLW;
static_assert(O_END == 21069312, "d_out map");
constexpr size_t MiB = 1u << 20;
constexpr size_t WS_CTL = 0, CTL_ZERO_BYTES = 1 * MiB;
constexpr size_t WS_BT1 = 2 * MiB;
constexpr size_t WS_BTQ = 11 * MiB;
constexpr size_t WS_BTG = 12 * MiB;
constexpr size_t WS_BTOA = 13 * MiB;
constexpr size_t WS_BTOP = 15 * MiB;
constexpr size_t WS_BTOUT = 16 * MiB;
constexpr size_t WS_ROPE = 18 * MiB;
constexpr size_t WS_QSS = 23 * MiB;
constexpr size_t WS_DPART = 24 * MiB;
constexpr size_t WS_H = 32 * MiB;
constexpr size_t WS_QLAT = 65 * MiB;
constexpr size_t WS_KVRAW = 74 * MiB;
constexpr size_t WS_KB = 87 * MiB;
constexpr size_t WS_SZ = 94 * MiB;
constexpr size_t WS_U = 143 * MiB;
constexpr size_t WS_SGA = 176 * MiB;
constexpr size_t WS_SGP = 209 * MiB;
constexpr size_t WS_OLPL = 242 * MiB;
constexpr size_t WS_QA = 291 * MiB;
constexpr size_t WS_QR = 324 * MiB;
constexpr size_t WS_G12 = 341 * MiB;
constexpr size_t WS_M1 = 390 * MiB;
constexpr size_t WS_MG = 456 * MiB;
constexpr size_t WS_END = 489 * MiB;
static_assert(WS_BT1 + (size_t)N1 * 1024 * 2 <= WS_BTQ && WS_BTQ + 1536 * 256 * 2 <= WS_BTG && WS_BTG + 1536 * 256 * 2 <= WS_BTOA && WS_ROPE + (size_t)(SEQ + 1) * 32 * 8 <= WS_QSS &&
              WS_QSS + (size_t)MPAD * 16 <= WS_DPART && WS_DPART + (size_t)NS * 8 * 8 * 130 * 4 <= WS_H && WS_H + (size_t)MPAD * 2048 <= WS_QLAT && WS_QLAT + (size_t)MPAD * 512 <= WS_KVRAW &&
              WS_KVRAW + (size_t)MPAD * 768 <= WS_KB && WS_KB + (size_t)MPAD * 384 <= WS_SZ && WS_SZ + (size_t)MPAD * 3072 <= WS_U && WS_U + (size_t)MPAD * 2048 <= WS_SGA &&
              WS_SGA + (size_t)MPAD * 2048 <= WS_SGP && WS_SGP + (size_t)MPAD * 2048 <= WS_OLPL && WS_OLPL + (size_t)MPAD * 3072 <= WS_QA && WS_QA + (size_t)MPAD * 2048 <= WS_QR &&
              WS_QR + (size_t)MPAD * 1024 <= WS_G12 && WS_G12 + (size_t)MPAD * 3072 <= WS_M1 && WS_M1 + (size_t)MPAD * 4096 <= WS_MG && WS_MG + (size_t)MPAD * 2048 <= WS_END, "d_ws map");
constexpr int CW_QPROMPT = 1024, CW_QDEC = 1088;
constexpr int DSPLIT = 4;
#ifndef ND_FIRST
#define ND_FIRST 64
#endif
constexpr int CW_BAR = 4096;
constexpr int RING_OFF = 0, RING_BYTES = 131072;
constexpr int LDSCTL_OFF = RING_BYTES, MISC_OFF = LDSCTL_OFF + 320;
constexpr int LDS_BYTES = 147456;
constexpr int NWAVES = 8;

#define LDS_WAIT() asm volatile("s_waitcnt lgkmcnt(0)" ::: "memory")
#define VM_WAIT() asm volatile("s_waitcnt vmcnt(0)" ::: "memory")
#define SBAR() __builtin_amdgcn_sched_barrier(0)
__device__ __forceinline__ unsigned cvtpk(float lo, float hi) { unsigned r; asm("v_cvt_pk_bf16_f32 %0, %1, %2" : "=v"(r) : "v"(lo), "v"(hi)); return r; }
__device__ __forceinline__ float bflo(unsigned w) { return __builtin_bit_cast(float, w << 16); }
__device__ __forceinline__ float bfhi(unsigned w) { return __builtin_bit_cast(float, w & 0xffff0000u); }
__device__ __forceinline__ float bf2f(bf16 b) { return __builtin_bit_cast(float, (unsigned)b << 16); }
__device__ __forceinline__ float sigmoidf_(float x) { return __builtin_amdgcn_rcpf(1.f + __builtin_amdgcn_exp2f(-1.4426950408889634f * x)); }
__device__ __forceinline__ float wave_sum(float v) {
#pragma unroll
    for (int o = 1; o < 64; o <<= 1) v += __shfl_xor(v, o);
    return v;
}

namespace pg8 {
#define PG8_LAS __attribute__((address_space(3)))
typedef unsigned short bf16_t;
constexpr int BM = 256, BK = 64, HALF = 128, HTB = HALF * BK * 2  , STAGE_BYTES = 8 * HTB, NXCD = 8, WGM = 8;
__host__ __device__ __forceinline__ int lds_byte(int r, int c) { const int st = (r >> 4) * 2 + (c >> 5), rr = r & 15, cc = c & 31, ob = rr * 64 + cc * 2; return st * 1024 + (ob ^ (((ob >> 9) & 1) << 5)); }
__host__ __device__ __forceinline__ void stage_rc(int b, int& R, int& C) { const int st = b / 1024, sb = b % 1024, swz = sb ^ (((sb >> 9) & 1) << 5); R = (st >> 1) * 16 + swz / 64; C = (st & 1) * 32 + (swz % 64) / 2; }
__host__ __device__ __forceinline__ int perm32(int rho) { const int n = rho >> 4, i = rho & 15; return 8 * (i >> 2) + 4 * n + (i & 3); }
struct Unit { int pm, pn; };
struct Gemm { const bf16_t* A; const bf16_t* Bt; int lda, ldb, K, a_pn_off; };
struct StaticOrder {
    int nM, nN, nwg, G, c;
    __host__ __device__ void init(int M, int N, int G_, int c_) { nM = M / BM; nN = N / BM; nwg = nM * nN; G = G_; c = c_; }
    __host__ __device__ bool next(int i, Unit& u) const {
        const long L = (long)i * G + c; if (L >= nwg) return false;
        int wgid = (int)L; { const int q = nwg / NXCD, r = nwg % NXCD, xcd = wgid % NXCD, off = wgid / NXCD; wgid = (xcd < r ? xcd * (q + 1) : r * (q + 1) + (xcd - r) * q) + off; }
        const int nig = WGM * nN, gid = wgid / nig, fm = gid * WGM, gsz = (nM - fm) < WGM ? (nM - fm) : WGM;
        u.pm = fm + ((wgid % nig) % gsz); u.pn = (wgid % nig) / gsz; return true;
    }
    __device__ __forceinline__ void a_ready(const Unit&) const {}
    __device__ __forceinline__ void done(const Unit&) const {}
};
#define EPI_PACK8(v0, v1) ((u32x4){cvtpk((v0)[0], (v0)[1]), cvtpk((v0)[2], (v0)[3]), cvtpk((v1)[0], (v1)[1]), cvtpk((v1)[2], (v1)[3])})
#define EPI_UNPK_LO(g) ((f32x4){bflo((g).x), bfhi((g).x), bflo((g).y), bfhi((g).y)})
#define EPI_UNPK_HI(g) ((f32x4){bflo((g).z), bfhi((g).z), bflo((g).w), bfhi((g).w)})
struct Epi1 {
    static constexpr bool PERM = true, AFTER_DRAIN = false;
    bf16_t* QLAT; float* QSS; float* KVRAW; bf16_t* SZ; float* U; bf16_t* SGA; bf16_t* SGP;
    __device__ __forceinline__ void operator()(const f32x4 (&acc)[2][2][4][2], const Unit& u, int wr, int wc, int fr, int fq) const {
        const int pn = u.pn, row0 = u.pm * BM + wr * 64 + fr, c0 = wc * 32 + 8 * fq;
        if (pn == 0) {
#pragma unroll
            for (int ai = 0; ai < 2; ++ai)
#pragma unroll
                for (int m = 0; m < 4; ++m) { const size_t row = (size_t)(row0 + ai * HALF + m * 16); float ss = 0.f;
#pragma unroll
                    for (int bj = 0; bj < 2; ++bj) { const f32x4 v0 = acc[ai][bj][m][0], v1 = acc[ai][bj][m][1];
                        ss += (v0[0] * v0[0] + v0[1] * v0[1]) + (v0[2] * v0[2] + v0[3] * v0[3]) + (v1[0] * v1[0] + v1[1] * v1[1]) + (v1[2] * v1[2] + v1[3] * v1[3]);
                        *(u32x4*)(QLAT + row * 256 + bj * HALF + c0) = EPI_PACK8(v0, v1); }
                    ss += __shfl_xor(ss, 16); ss += __shfl_xor(ss, 32);
                    if (fq == 0) QSS[row * 4 + wc] = ss; }
        } else if (pn == 1) {
#pragma unroll
            for (int ai = 0; ai < 2; ++ai)
#pragma unroll
                for (int m = 0; m < 4; ++m) { const size_t row = (size_t)(row0 + ai * HALF + m * 16);
#pragma unroll
                    for (int bj = 0; bj < 2; ++bj) { const int c = bj * HALF + c0;
                        if (c < QKD) { *(f32x4*)(KVRAW + row * QKD + c) = acc[ai][bj][m][0]; *(f32x4*)(KVRAW + row * QKD + c + 4) = acc[ai][bj][m][1]; } } }
        } else if (pn == 6 || pn == 7) {
#pragma unroll
            for (int ai = 0; ai < 2; ++ai)
#pragma unroll
                for (int m = 0; m < 4; ++m) { const size_t row = (size_t)(row0 + ai * HALF + m * 16);
#pragma unroll
                    for (int bj = 0; bj < 2; ++bj) { float* p = U + row * POOLW + (pn - 6) * 256 + bj * HALF + c0;
                        *(f32x4*)p = acc[ai][bj][m][0]; *(f32x4*)(p + 4) = acc[ai][bj][m][1]; } }
        } else {
            bf16_t* dst; int ld; bool sig;
            if (pn < 6) { dst = SZ + (pn - 2) * 256; ld = GW; sig = false; }
            else if (pn < 10) { dst = SZ + ATTW + (pn - 8) * 256; ld = GW; sig = false; }
            else if (pn < 14) { dst = SGA + (pn - 10) * 256; ld = DM; sig = true; }
            else { dst = SGP + (pn - 14) * 256; ld = DM; sig = true; }
#pragma unroll
            for (int ai = 0; ai < 2; ++ai)
#pragma unroll
                for (int m = 0; m < 4; ++m) { const size_t row = (size_t)(row0 + ai * HALF + m * 16);
#pragma unroll
                    for (int bj = 0; bj < 2; ++bj) { f32x4 v0 = acc[ai][bj][m][0], v1 = acc[ai][bj][m][1];
#pragma unroll
                        for (int e = 0; e < 4; ++e) { const float s0 = sigmoidf_(v0[e]), s1 = sigmoidf_(v1[e]); v0[e] = sig ? s0 : v0[e] * s0; v1[e] = sig ? s1 : v1[e] * s1; }
                        *(u32x4*)(dst + row * ld + bj * HALF + c0) = EPI_PACK8(v0, v1); } }
        }
    }
};
struct Epi2 {
    static constexpr bool PERM = true, AFTER_DRAIN = false;
    bf16_t* QA; bf16_t* QR; const float* QSS; const float* ROPET;
    __device__ __forceinline__ void operator()(const f32x4 (&acc)[2][2][4][2], const Unit& u, int wr, int wc, int fr, int fq) const {
        const int pn = u.pn, row0 = u.pm * BM + wr * 64 + fr, c0 = wc * 32 + 8 * fq;
#pragma unroll
        for (int ai = 0; ai < 2; ++ai)
#pragma unroll
            for (int m = 0; m < 4; ++m) { const size_t row = (size_t)(row0 + ai * HALF + m * 16);
                const f32x4 q4 = *(const f32x4*)(QSS + row * 4);
                const float s = C2 * __builtin_amdgcn_rsqf(((q4[0] + q4[1]) + (q4[2] + q4[3])) * (1.f / QRANK) + EPS);
                if (pn < 4) {
#pragma unroll
                    for (int bj = 0; bj < 2; ++bj) { const f32x4 v0 = acc[ai][bj][m][0] * s, v1 = acc[ai][bj][m][1] * s;
                        *(u32x4*)(QA + row * ATTW + pn * 256 + bj * HALF + c0) = EPI_PACK8(v0, v1); }
                } else {
                    const int pos = row < SEQ ? (int)row : SEQ;
                    const float* rp = ROPET + ((size_t)pos * 32 + 8 * fq) * 2;
                    bf16_t* q = QR + row * (NH * ROPE) + (4 * (pn - 4) + wc) * ROPE + 8 * fq;
#pragma unroll
                    for (int n = 0; n < 2; ++n) {
                        const f32x4 t0 = *(const f32x4*)(rp + 8 * n), t1 = *(const f32x4*)(rp + 8 * n + 4);
                        const f32x4 a = acc[ai][0][m][n], b = acc[ai][1][m][n];
                        u32x2 lo, hi2;
                        lo.x = cvtpk((a[0] * t0[0] - b[0] * t0[1]) * s, (a[1] * t0[2] - b[1] * t0[3]) * s); lo.y = cvtpk((a[2] * t1[0] - b[2] * t1[1]) * s, (a[3] * t1[2] - b[3] * t1[3]) * s);
                        hi2.x = cvtpk((b[0] * t0[0] + a[0] * t0[1]) * s, (b[1] * t0[2] + a[1] * t0[3]) * s); hi2.y = cvtpk((b[2] * t1[0] + a[2] * t1[1]) * s, (b[3] * t1[2] + a[3] * t1[3]) * s);
                        *(u32x2*)(q + 4 * n) = lo; *(u32x2*)(q + 32 + 4 * n) = hi2; }
                }
                if (m & 1) __builtin_amdgcn_sched_barrier(0);
            }
    }
};
struct Epi5 {
    static constexpr bool PERM = true, AFTER_DRAIN = false;
    bf16_t* G12; const bf16_t* SZ; const float* pool_scale;
    __device__ __forceinline__ void operator()(const f32x4 (&acc)[2][2][4][2], const Unit& u, int wr, int wc, int fr, int fq) const {
        const int pn = u.pn, row0 = u.pm * BM + wr * 64 + fr, c0 = wc * 32 + 8 * fq;
#pragma unroll
        for (int bj = 0; bj < 2; ++bj) { const int c = pn * 256 + bj * HALF + c0;
            f32x4 p0 = {1.f, 1.f, 1.f, 1.f}, p1 = p0;
            if (pn >= 4) { p0 = *(const f32x4*)(pool_scale + c - ATTW); p1 = *(const f32x4*)(pool_scale + c - ATTW + 4); }
#pragma unroll
            for (int ai = 0; ai < 2; ++ai)
#pragma unroll
                for (int m = 0; m < 4; ++m) { const size_t row = (size_t)(row0 + ai * HALF + m * 16);
                    const u32x4 g = *(const u32x4*)(SZ + row * GW + c);
                    const f32x4 v0 = acc[ai][bj][m][0] * p0 * EPI_UNPK_LO(g), v1 = acc[ai][bj][m][1] * p1 * EPI_UNPK_HI(g);
                    *(u32x4*)(G12 + row * GW + c) = EPI_PACK8(v0, v1); } }
    }
};
template <bool SECOND> struct Epi6 {
    static constexpr bool PERM = true, AFTER_DRAIN = false;
    float* M1; bf16_t* MG; const bf16_t* SG;
    __device__ __forceinline__ void operator()(const f32x4 (&acc)[2][2][4][2], const Unit& u, int wr, int wc, int fr, int fq) const {
        const int pn = u.pn, row0 = u.pm * BM + wr * 64 + fr, c0 = wc * 32 + 8 * fq;
#pragma unroll
        for (int ai = 0; ai < 2; ++ai)
#pragma unroll
            for (int m = 0; m < 4; ++m) { const size_t row = (size_t)(row0 + ai * HALF + m * 16);
#pragma unroll
                for (int bj = 0; bj < 2; ++bj) { const size_t o = row * DM + pn * 256 + bj * HALF + c0;
                    const u32x4 g = *(const u32x4*)(SG + o);
                    f32x4 v0 = acc[ai][bj][m][0] * EPI_UNPK_LO(g), v1 = acc[ai][bj][m][1] * EPI_UNPK_HI(g);
                    if (!SECOND) { *(f32x4*)(M1 + o) = v0; *(f32x4*)(M1 + o + 4) = v1; }
                    else { v0 += *(const f32x4*)(M1 + o); v1 += *(const f32x4*)(M1 + o + 4); *(u32x4*)(MG + o) = EPI_PACK8(v0, v1); } } }
    }
};
struct Epi7 {
    static constexpr bool PERM = true, AFTER_DRAIN = false;
    const float* xp; const float* xs; float* out;
    __device__ __forceinline__ void operator()(const f32x4 (&acc)[2][2][4][2], const Unit& u, int wr, int wc, int fr, int fq) const {
        const int pn = u.pn, row0 = u.pm * BM + wr * 64 + fr, c0 = wc * 32 + 8 * fq;
#pragma unroll
        for (int ai = 0; ai < 2; ++ai)
#pragma unroll
            for (int m = 0; m < 4; ++m) { const int row = row0 + ai * HALF + m * 16;
                if (row < MTOT) {
                    const float* x = row < SEQ ? xp + (size_t)row * DM : xs + (size_t)(row - SEQ) * DM;
                    float* y = row < SEQ ? out + O_YP + (size_t)row * DM : out + O_YS + (size_t)(row - SEQ) * DM;
#pragma unroll
                    for (int bj = 0; bj < 2; ++bj) { const int c = pn * 256 + bj * HALF + c0;
                        *(f32x4*)(y + c) = *(const f32x4*)(x + c) + acc[ai][bj][m][0]; *(f32x4*)(y + c + 4) = *(const f32x4*)(x + c + 4) + acc[ai][bj][m][1]; } } }
    }
};
template <class Epi, class Sched, bool ALIGN_EPI = false, bool SP2 = false>
__device__ __forceinline__ void gemm_phase(PG8_LAS unsigned char* lds, const Gemm g, const Sched& S, const Epi& E) {
    int tid_ = threadIdx.x; asm volatile("" : "+v"(tid_));
    const int tid = tid_, wid = __builtin_amdgcn_readfirstlane(tid >> 6), lane = tid & 63, wr = wid >> 2, wc = wid & 3, fr = lane & 15, fq = lane >> 4;
    const int K = g.K, nt = K / BK;
    unsigned voffA[2], voffB[2];
#pragma unroll
    for (int i = 0; i < 2; ++i) { int R, C; stage_rc(tid * 16 + i * 8192, R, C); const int Rb = Epi::PERM ? ((R & ~31) + perm32(R & 31)) : R;
        voffA[i] = (unsigned)(R * g.lda + C) * 2u; voffB[i] = (unsigned)(Rb * g.ldb + C) * 2u; }
    const size_t kstep = (size_t)(BK * 2);
    const size_t hA = (size_t)HALF * g.lda * 2, hB = (size_t)HALF * g.ldb * 2;
    const size_t tA = 2 * hA, tB = 2 * hB, pA = (size_t)g.a_pn_off * 2;
    const unsigned ldsw = (unsigned)wid * 1024u;
    const int aoff = lds_byte(wr * 64 + fr, fq * 8), boff = lds_byte(wc * 32 + fr, fq * 8);
#define PG8_SA(b, h) (((b) * 2 + (h)) * HTB)
#define PG8_SB(b, h) ((4 + (b) * 2 + (h)) * HTB)
#define PG8_STAGE(bufoff, gbase, voff) do { _Pragma("unroll") for (int _i = 0; _i < 2; ++_i) \
        __builtin_amdgcn_global_load_lds((const unsigned*)((const char*)(gbase) + (voff)[_i]), (PG8_LAS unsigned*)(lds + (bufoff) + ldsw + _i * 8192), 16, 0, 0); } while (0)
#define PG8_LDA(dst, b, h) do { _Pragma("unroll") for (int m = 0; m < 4; ++m) _Pragma("unroll") for (int k = 0; k < 2; ++k) dst[m][k] = *(const PG8_LAS bf16x8*)(lds + PG8_SA(b, h) + aoff + m * 2048 + k * 1024); } while (0)
#define PG8_LDB(dst, b, h) do { _Pragma("unroll") for (int n = 0; n < 2; ++n) _Pragma("unroll") for (int k = 0; k < 2; ++k) dst[n][k] = *(const PG8_LAS bf16x8*)(lds + PG8_SB(b, h) + boff + n * 2048 + k * 1024); } while (0)
#define PG8_MMA(ai, bj, At, Bt) do { __builtin_amdgcn_s_setprio(1); _Pragma("unroll") for (int m = 0; m < 4; ++m) _Pragma("unroll") for (int n = 0; n < 2; ++n) _Pragma("unroll") for (int k = 0; k < 2; ++k) \
        acc[ai][bj][m][n] = __builtin_amdgcn_mfma_f32_16x16x32_bf16(Bt[n][k], At[m][k], acc[ai][bj][m][n], 0, 0, 0); __builtin_amdgcn_s_setprio(0); } while (0)
#define PG8_WAIT_V(n) asm volatile("s_waitcnt vmcnt(" #n ")" ::: "memory")
#define PG8_WAIT_L(n) asm volatile("s_waitcnt lgkmcnt(" #n ")" ::: "memory")
#define PG8_BAR __builtin_amdgcn_s_barrier()
#define PG8_SCHED __builtin_amdgcn_sched_barrier(0)
    Unit cur, nxt; int ui = 0;
    if (!S.next(0, cur)) return;
    f32x4 acc[2][2][4][2];
#pragma unroll
    for (int a = 0; a < 2; ++a)
#pragma unroll
        for (int b = 0; b < 2; ++b)
#pragma unroll
            for (int m = 0; m < 4; ++m)
#pragma unroll
                for (int n = 0; n < 2; ++n) acc[a][b][m][n] = (f32x4){0.f, 0.f, 0.f, 0.f};
    bf16x8 At[4][2], B0[2][2], B1[2][2];
    const char* cA = (const char*)g.A + (size_t)cur.pm * tA + (size_t)cur.pn * pA; const char* cB = (const char*)g.Bt + (size_t)cur.pn * tB;
    S.a_ready(cur);
    if constexpr (SP2) {
        PG8_STAGE(PG8_SB(0, 0), cB, voffB); PG8_STAGE(PG8_SB(0, 1), cB + hB, voffB); PG8_STAGE(PG8_SA(0, 0), cA, voffA); PG8_STAGE(PG8_SA(0, 1), cA + hA, voffA);
        if (wr == 1) PG8_BAR;
        PG8_WAIT_V(2); PG8_BAR;
        PG8_STAGE(PG8_SB(1, 0), cB + kstep, voffB); PG8_STAGE(PG8_SA(1, 0), cA + kstep, voffA); PG8_STAGE(PG8_SB(1, 1), cB + hB + kstep, voffB);
        PG8_WAIT_V(6); PG8_BAR;
    } else {
        PG8_STAGE(PG8_SB(0, 0), cB, voffB); PG8_STAGE(PG8_SA(0, 0), cA, voffA); PG8_STAGE(PG8_SB(0, 1), cB + hB, voffB); PG8_STAGE(PG8_SA(0, 1), cA + hA, voffA);
        if (wr == 1) PG8_BAR;
        PG8_WAIT_V(4); PG8_BAR;
        PG8_STAGE(PG8_SB(1, 0), cB + kstep, voffB); PG8_STAGE(PG8_SA(1, 0), cA + kstep, voffA); PG8_STAGE(PG8_SB(1, 1), cB + hB + kstep, voffB);
        PG8_WAIT_V(6); PG8_BAR;
    }
    for (;;) {
        const bool has_next = S.next(ui + 1, nxt);
        const char* nA = has_next ? (const char*)g.A + (size_t)nxt.pm * tA + (size_t)nxt.pn * pA : cA; const char* nB = has_next ? (const char*)g.Bt + (size_t)nxt.pn * tB : cB;
        for (int t = 0; t < nt; t += 2) {
            const bool last = (t == nt - 2);
            const char* a1 = cA + (size_t)(t + 1) * kstep;
            const char* a2 = last ? nA : cA + (size_t)(t + 2) * kstep; const char* b2 = last ? nB : cB + (size_t)(t + 2) * kstep;
            const char* a3 = a2 + kstep; const char* b3 = b2 + kstep;
            if (last && has_next) S.a_ready(nxt);
            if constexpr (SP2) {
            PG8_LDB(B0, 0, 0); PG8_LDB(B1, 0, 1); PG8_SCHED; PG8_LDA(At, 0, 0); PG8_STAGE(PG8_SA(1, 1), a1 + hA, voffA);
            PG8_WAIT_V(8); PG8_WAIT_L(0); PG8_BAR; PG8_MMA(0, 0, At, B0); PG8_MMA(0, 1, At, B1); PG8_BAR; PG8_SCHED;
            PG8_LDA(At, 0, 1); PG8_STAGE(PG8_SB(0, 0), b2, voffB); PG8_STAGE(PG8_SB(0, 1), b2 + hB, voffB); PG8_STAGE(PG8_SA(0, 0), a2, voffA);
            PG8_WAIT_V(8); PG8_WAIT_L(0); PG8_BAR; PG8_MMA(1, 0, At, B0); PG8_MMA(1, 1, At, B1); PG8_BAR; PG8_SCHED;
            PG8_LDB(B0, 1, 0); PG8_LDB(B1, 1, 1); PG8_SCHED; PG8_LDA(At, 1, 0); PG8_STAGE(PG8_SA(0, 1), a2 + hA, voffA);
            PG8_WAIT_V(8); PG8_WAIT_L(0); PG8_BAR; PG8_MMA(0, 0, At, B0); PG8_MMA(0, 1, At, B1); PG8_BAR; PG8_SCHED;
            PG8_LDA(At, 1, 1); PG8_STAGE(PG8_SB(1, 0), b3, voffB); PG8_STAGE(PG8_SB(1, 1), b3 + hB, voffB); PG8_STAGE(PG8_SA(1, 0), a3, voffA);
            PG8_WAIT_V(8); PG8_WAIT_L(0); PG8_BAR; PG8_MMA(1, 0, At, B0); PG8_MMA(1, 1, At, B1); PG8_BAR; PG8_SCHED;
            } else {
            PG8_LDB(B0, 0, 0); PG8_SCHED; PG8_LDA(At, 0, 0); PG8_STAGE(PG8_SA(1, 1), a1 + hA, voffA);
            PG8_WAIT_L(8); PG8_BAR; PG8_WAIT_L(0); PG8_MMA(0, 0, At, B0); PG8_BAR; PG8_SCHED;
            PG8_LDB(B1, 0, 1); PG8_STAGE(PG8_SB(0, 0), b2, voffB);
            PG8_BAR; PG8_WAIT_L(0); PG8_MMA(0, 1, At, B1); PG8_BAR;
            PG8_LDA(At, 0, 1); PG8_STAGE(PG8_SA(0, 0), a2, voffA);
            PG8_BAR; PG8_WAIT_L(0); PG8_MMA(1, 0, At, B0); PG8_BAR; PG8_SCHED;
            PG8_STAGE(PG8_SB(0, 1), b2 + hB, voffB);
            PG8_WAIT_V(6); PG8_BAR; PG8_MMA(1, 1, At, B1); PG8_BAR;
            PG8_LDB(B0, 1, 0); PG8_SCHED; PG8_LDA(At, 1, 0); PG8_STAGE(PG8_SA(0, 1), a2 + hA, voffA);
            PG8_WAIT_L(8); PG8_BAR; PG8_WAIT_L(0); PG8_MMA(0, 0, At, B0); PG8_BAR; PG8_SCHED;
            PG8_LDB(B1, 1, 1); PG8_STAGE(PG8_SB(1, 0), b3, voffB);
            PG8_BAR; PG8_WAIT_L(0); PG8_MMA(0, 1, At, B1); PG8_BAR;
            PG8_LDA(At, 1, 1); PG8_STAGE(PG8_SA(1, 0), a3, voffA);
            PG8_BAR; PG8_WAIT_L(0); PG8_MMA(1, 0, At, B0); PG8_BAR; PG8_SCHED;
            PG8_STAGE(PG8_SB(1, 1), b3 + hB, voffB);
            PG8_WAIT_V(6); PG8_BAR; PG8_MMA(1, 1, At, B1); PG8_BAR;
            }
        }
        if constexpr (ALIGN_EPI) { if (wr == 0) PG8_BAR; }
        if constexpr (!Epi::AFTER_DRAIN) { int l_; asm volatile("v_mbcnt_lo_u32_b32 %0, -1, 0\n\tv_mbcnt_hi_u32_b32 %0, -1, %0" : "=v"(l_));
            E(acc, cur, wr, wc, l_ & 15, l_ >> 4); S.done(cur); }
        if (!has_next) break;
#pragma unroll
        for (int a = 0; a < 2; ++a)
#pragma unroll
            for (int b = 0; b < 2; ++b)
#pragma unroll
                for (int m = 0; m < 4; ++m)
#pragma unroll
                    for (int n = 0; n < 2; ++n) acc[a][b][m][n] = (f32x4){0.f, 0.f, 0.f, 0.f};
        cur = nxt; cA = nA; cB = nB; ++ui;
        if constexpr (ALIGN_EPI) { if (wr == 1) PG8_BAR; }
    }
    PG8_WAIT_V(0);
    if constexpr (!ALIGN_EPI) { if (wr == 0) PG8_BAR; }
    PG8_BAR;
    if constexpr (Epi::AFTER_DRAIN) { E.fused(acc, cur, wr, wc, fr, fq, lds, wid, lane); S.done(cur); }
#undef PG8_SA
#undef PG8_SB
#undef PG8_STAGE
#undef PG8_LDA
#undef PG8_LDB
#undef PG8_MMA
#undef PG8_WAIT_V
#undef PG8_WAIT_L
#undef PG8_BAR
#undef PG8_SCHED
}
}
namespace att {
constexpr int SHM_K = 64 * 384, SHM_V = 64 * 256;
constexpr int L_V = 0, L_K = 2 * SHM_V, L_WS = L_K + 2 * SHM_K, L_QR = L_WS + NWAVES * 256, LDS_NEED = L_QR + NWAVES * 4096;
constexpr int DROW = 400, DIMG = 32 * DROW;
static_assert(LDS_NEED <= RING_BYTES && NWAVES * DIMG + 12 * 17 * 16 <= RING_BYTES, "attention LDS");
constexpr float THR2 = 8.f * 1.4426950408889634f;
__device__ __forceinline__ int crow(int r, int hi) { return (r & 3) + 8 * (r >> 2) + 4 * hi; }
__device__ __forceinline__ int v_st(int k, int c) { const int kk = (k & ~0xC) | ((k & 4) << 1) | ((k & 8) >> 1); return ((kk >> 3) * 4 + (c >> 5)) * 512 + ((kk & 7) * 32 + (c & 31)) * 2; }
__device__ __forceinline__ int v_rd_base(int lane) { return ((lane & 3) << 3) | (((lane >> 2) & 3) << 6) | (((lane >> 4) & 1) << 5) | (((lane >> 5) & 1) << 8); }
constexpr int v_rd_off(int d0, int ks, int half) { return d0 * 512 + ks * 4096 + half * 2048; }
__device__ __forceinline__ float pl_swap_max(float v) { auto rr = __builtin_amdgcn_permlane32_swap(__float_as_uint(v), __float_as_uint(v), false, false); return fmaxf(__uint_as_float(rr[0]), __uint_as_float(rr[1])); }
__device__ __forceinline__ float pl_swap_add(float v) { auto rr = __builtin_amdgcn_permlane32_swap(__float_as_uint(v), __float_as_uint(v), false, false); return __uint_as_float(rr[0]) + __uint_as_float(rr[1]); }
#define ATT_PK4(P, B_, OUT) do { unsigned a0 = cvtpk(P[B_+0], P[B_+1]), a1 = cvtpk(P[B_+2], P[B_+3]);                          \
        unsigned b0 = cvtpk(P[B_+4], P[B_+5]), b1 = cvtpk(P[B_+6], P[B_+7]);                                             \
        auto r0 = __builtin_amdgcn_permlane32_swap(a0, b0, false, false); auto r1 = __builtin_amdgcn_permlane32_swap(a1, b1, false, false); \
        u32x4 w = {r0[0], r1[0], r0[1], r1[1]}; OUT = __builtin_bit_cast(bf16x8, w); } while (0)
#define ATT_TRRD(dst, addr, off) asm volatile("ds_read_b64_tr_b16 %0, %1 offset:%2" : "=&v"(dst) : "v"(addr), "i"(off) : "memory")
#define ATT_PK(L, H) ((bf16x8){L[0], L[1], L[2], L[3], H[0], H[1], H[2], H[3]})

__device__ __forceinline__ void mask_tile(f32x16& p0, f32x16& p1, int dq) {
    const float NEG = -__builtin_inff();
#pragma unroll
    for (int r = 0; r < 16; ++r) { const int c = (r & 3) + 8 * (r >> 2);
        if (dq - c < 0) p0[r] = NEG;
        if (dq - c - 32 < 0) p1[r] = NEG; }
}
__device__ __forceinline__ void partialSM(f32x16& p0, f32x16& p1, float& m_reg, float& alpha) {
    float pmax = p0[0];
#pragma unroll
    for (int r = 1; r < 16; ++r) pmax = fmaxf(pmax, p0[r]);
#pragma unroll
    for (int r = 0; r < 16; ++r) pmax = fmaxf(pmax, p1[r]);
    pmax = pl_swap_max(pmax);
    float mn;
    if (__builtin_expect(__all(pmax - m_reg <= THR2), 1)) { mn = m_reg; alpha = 1.f; }
    else { mn = fmaxf(m_reg, pmax); alpha = __builtin_amdgcn_exp2f(m_reg - mn); m_reg = mn; }
#pragma unroll
    for (int r = 0; r < 16; ++r) p0[r] = __builtin_amdgcn_exp2f(p0[r] - mn);
#pragma unroll
    for (int r = 0; r < 16; ++r) p1[r] = p1[r] - mn;
}
__device__ __forceinline__ void finishSM(f32x16& p0, f32x16& p1, float alpha, float& l_reg, bf16x8& pa0, bf16x8& pa1, bf16x8& pa2, bf16x8& pa3) {
#pragma unroll
    for (int r = 0; r < 16; ++r) p1[r] = __builtin_amdgcn_exp2f(p1[r]);
    float ps = 0.f;
#pragma unroll
    for (int r = 0; r < 16; ++r) ps += p0[r];
#pragma unroll
    for (int r = 0; r < 16; ++r) ps += p1[r];
    ps = pl_swap_add(ps);
    l_reg = l_reg * alpha + ps;
    ATT_PK4(p0, 0, pa0); ATT_PK4(p0, 8, pa1); ATT_PK4(p1, 0, pa2); ATT_PK4(p1, 8, pa3);
}
template <int KB>
__device__ __forceinline__ void qkt(f32x16& p0, f32x16& p1, const LAS unsigned char* lds, int r32, int hi, const bf16x8* qr, const LAS unsigned char* qlds) {
    p0 = f32x16{}; p1 = f32x16{};
    const int sw = ((r32 >> 1) & 7) << 4;
    const LAS unsigned char* kb[4];
#pragma unroll
    for (int dd = 0; dd < 4; ++dd) kb[dd] = lds + L_K + KB * SHM_K + r32 * 384 + ((dd * 32 + hi * 16) ^ sw);
#pragma unroll
    for (int d0 = 0; d0 < 12; ++d0) { const LAS unsigned char* a = kb[d0 & 3] + (d0 >> 2) * 128;
        const bf16x8 b0 = *(const LAS bf16x8*)a, b1 = *(const LAS bf16x8*)(a + 32 * 384);
        const bf16x8 qf = d0 < 8 ? qr[d0 & 7] : *(const LAS bf16x8*)(qlds + (d0 - 8) * 1024);
        p0 = __builtin_amdgcn_mfma_f32_32x32x16_bf16(b0, qf, p0, 0, 0, 0);
        p1 = __builtin_amdgcn_mfma_f32_32x32x16_bf16(b1, qf, p1, 0, 0, 0); }
}
template <int VB>
__device__ __forceinline__ void pv_tile(f32x16* o, int vb0, bf16x8 pa0, bf16x8 pa1, bf16x8 pa2, bf16x8 pa3) {
#define ATT_PV_D0(d0) do { s16x4 l0, l1, l2, l3, h0, h1, h2, h3; constexpr int b_ = L_V + VB * SHM_V + v_rd_off(d0, 0, 0); \
        ATT_TRRD(l0, vb0, b_); ATT_TRRD(h0, vb0, b_ + 2048); ATT_TRRD(l1, vb0, b_ + 4096); ATT_TRRD(h1, vb0, b_ + 6144); ATT_TRRD(l2, vb0, b_ + 8192); ATT_TRRD(h2, vb0, b_ + 10240); ATT_TRRD(l3, vb0, b_ + 12288); ATT_TRRD(h3, vb0, b_ + 14336); \
        asm volatile("s_waitcnt lgkmcnt(0)" ::: "memory"); SBAR(); \
        o[d0] = __builtin_amdgcn_mfma_f32_32x32x16_bf16(pa0, ATT_PK(l0, h0), o[d0], 0, 0, 0); \
        o[d0] = __builtin_amdgcn_mfma_f32_32x32x16_bf16(pa1, ATT_PK(l1, h1), o[d0], 0, 0, 0); \
        o[d0] = __builtin_amdgcn_mfma_f32_32x32x16_bf16(pa2, ATT_PK(l2, h2), o[d0], 0, 0, 0); \
        o[d0] = __builtin_amdgcn_mfma_f32_32x32x16_bf16(pa3, ATT_PK(l3, h3), o[d0], 0, 0, 0); } while (0)
    ATT_PV_D0(0); ATT_PV_D0(1); ATT_PV_D0(2); ATT_PV_D0(3);
#undef ATT_PV_D0
}

__device__ __forceinline__ void prompt_unit(int q0, const bf16* __restrict__ QA, const bf16* __restrict__ QR, const bf16* __restrict__ KBm, bf16* __restrict__ OL, LAS unsigned char* lds, int tid, int wid, int lane) {
    const int r32 = lane & 31, hi = lane >> 5;
    const int NT = (q0 >> 6) + 1;
    bf16x8 qr[8];
    LAS unsigned char* qlds = lds + L_QR + wid * 4096 + lane * 16;
    { const bf16* qa = QA + (size_t)(q0 + r32) * ATTW + wid * NOPE + hi * 8; const bf16* qq = QR + (size_t)(q0 + r32) * (NH * ROPE) + wid * ROPE + hi * 8;
#pragma unroll
      for (int d0 = 0; d0 < 8; ++d0) qr[d0] = *(const bf16x8*)(qa + d0 * 16);
#pragma unroll
      for (int d0 = 0; d0 < 4; ++d0) *(LAS bf16x8*)(qlds + d0 * 1024) = *(const bf16x8*)(qq + d0 * 16); }
    LAS float* wsf = (LAS float*)(lds + L_WS) + wid * 64; LAS float* li_l = wsf; LAS float* al_l = wsf + 32;
    float m_reg = -1e30f, l_reg = 0.f; f32x16 o[4] = {};
    const int skey = tid >> 3, sc8 = tid & 7;
    const int kw0 = skey * 384 + ((sc8 * 16) ^ (((skey >> 1) & 7) << 4));
    const int vw0 = v_st(skey, sc8 * 8);
    const int vb0 = (int)(uintptr_t)lds + v_rd_base(lane);
    const int qm = q0 + r32 - 4 * hi;
    const bf16* ksrc = KBm + (size_t)skey * QKD + sc8 * 8;
    bf16x8 st0, st1, st2;
#define ATT_SLOAD(t) do { const bf16* p_ = ksrc + (size_t)(t) * (64 * QKD); st0 = *(const bf16x8*)p_; st1 = *(const bf16x8*)(p_ + 64); st2 = *(const bf16x8*)(p_ + 128); } while (0)
#define ATT_SWRITE(bf) do { LAS unsigned char* k_ = lds + L_K + (bf) * SHM_K + kw0; *(LAS bf16x8*)k_ = st0; *(LAS bf16x8*)(k_ + 128) = st1; *(LAS bf16x8*)(k_ + 256) = st2; \
        LAS unsigned char* v_ = lds + L_V + (bf) * SHM_V + vw0; *(LAS bf16x8*)v_ = st0; *(LAS bf16x8*)(v_ + 1024) = st1; } while (0)
#define ATT_RESC(a) do { if (__any((a) < 1.f)) { if (hi == 0) al_l[r32] = (a); LDS_WAIT(); \
        _Pragma("unroll") for (int d_ = 0; d_ < 4; ++d_) _Pragma("unroll") for (int r = 0; r < 16; ++r) o[d_][r] *= al_l[crow(r, hi)]; } } while (0)
#define ATT_MASKT(P0_, P1_, t) do { if ((t) == NT - 1) mask_tile(P0_, P1_, qm - 64 * (t)); } while (0)
    f32x16 pA0, pA1, pB0, pB1; float alA, alB; bf16x8 pa0, pa1, pa2, pa3;
    ATT_SLOAD(0); VM_WAIT(); ATT_SWRITE(0); SBAR();
    if (NT > 1) ATT_SLOAD(1);
    __syncthreads();
    SBAR(); qkt<0>(pA0, pA1, lds, r32, hi, qr, qlds);
    ATT_MASKT(pA0, pA1, 0); partialSM(pA0, pA1, m_reg, alA);
    if (NT > 1) { VM_WAIT(); ATT_SWRITE(1); }
    __syncthreads();
#define ATT_HALF_STEP(PX0, PX1, alX, PY0, PY1, alY, t, KB, VB, SB) do {                                          \
        SBAR(); qkt<KB>(PX0, PX1, lds, r32, hi, qr, qlds);                                                         \
        finishSM(PY0, PY1, alY, l_reg, pa0, pa1, pa2, pa3); SBAR();                                              \
        if ((t) + 1 < NT) { ATT_SLOAD((t) + 1); SBAR(); }                                                        \
        pv_tile<VB>(o, vb0, pa0, pa1, pa2, pa3); ATT_MASKT(PX0, PX1, (t)); partialSM(PX0, PX1, m_reg, alX);      \
        __syncthreads();                                                                                         \
        if ((t) + 1 < NT) { VM_WAIT(); ATT_SWRITE(SB); }                                                         \
        ATT_RESC(alX); __syncthreads(); } while (0)
    for (int t = 1; t + 1 < NT; t += 2) {
        ATT_HALF_STEP(pB0, pB1, alB, pA0, pA1, alA, t, 1, 0, 0);
        ATT_HALF_STEP(pA0, pA1, alA, pB0, pB1, alB, t + 1, 0, 1, 1);
    }
    const bool even = (NT & 1) == 0;
    if (even) { SBAR(); qkt<1>(pB0, pB1, lds, r32, hi, qr, qlds); SBAR(); }
    finishSM(pA0, pA1, alA, l_reg, pa0, pa1, pa2, pa3); SBAR();
    pv_tile<0>(o, vb0, pa0, pa1, pa2, pa3);
    if (even) { ATT_MASKT(pB0, pB1, NT - 1); partialSM(pB0, pB1, m_reg, alB); ATT_RESC(alB);
        finishSM(pB0, pB1, alB, l_reg, pa0, pa1, pa2, pa3); SBAR(); pv_tile<1>(o, vb0, pa0, pa1, pa2, pa3); }
    if (hi == 0) li_l[r32] = l_reg; LDS_WAIT();
    float rli[16];
#pragma unroll
    for (int r = 0; r < 16; ++r) rli[r] = __builtin_amdgcn_rcpf(li_l[crow(r, hi)]);
    bf16* Ow = OL + (size_t)q0 * GW + wid * VD;
#pragma unroll
    for (int r = 0; r < 16; ++r) { const int orow = crow(r, hi);
#pragma unroll
        for (int d0 = 0; d0 < 4; ++d0) { const float v = o[d0][r] * rli[r]; const float vn = __shfl_xor(v, 1);
            if ((r32 & 1) == 0) *(unsigned*)(Ow + (size_t)orow * GW + d0 * 32 + r32) = cvtpk(v, vn); } }
    __syncthreads();
#undef ATT_SLOAD
#undef ATT_SWRITE
#undef ATT_RESC
#undef ATT_MASKT
#undef ATT_HALF_STEP
}

__device__ __forceinline__ void decode_item(int item, const float* __restrict__ cckv, const float* __restrict__ ckr, const int* __restrict__ ptab, const bf16* __restrict__ QA, const bf16* __restrict__ QR,
                                            float* __restrict__ DPART, LAS unsigned char* lds, int tid, int wid, int lane) {
    constexpr int PPI = NPG / DSPLIT, NSTEP = 4 * PPI / NWAVES;
    const int b = item / DSPLIT, part = item % DSPLIT, r32 = lane & 31, hi = lane >> 5;
    constexpr int QOFF = NWAVES * DIMG, QSTR = 17 * 16;
    if (wid == 0) { const size_t qrow = (size_t)(SEQ + b);
        if (r32 < 8) { const bf16* qa = QA + qrow * ATTW + r32 * NOPE + hi * 8; const bf16* qq = QR + qrow * (NH * ROPE) + r32 * ROPE + hi * 8; LAS unsigned char* d = lds + QOFF + (hi * 8 + r32) * 16;
#pragma unroll
            for (int d0 = 0; d0 < 8; ++d0) *(LAS bf16x8*)(d + d0 * QSTR) = *(const bf16x8*)(qa + d0 * 16);
#pragma unroll
            for (int d0 = 0; d0 < 4; ++d0) *(LAS bf16x8*)(d + (8 + d0) * QSTR) = *(const bf16x8*)(qq + d0 * 16); }
        else if (lane == 8) { const bf16x8 z = {0, 0, 0, 0, 0, 0, 0, 0};
#pragma unroll
            for (int d0 = 0; d0 < 12; ++d0) *(LAS bf16x8*)(lds + QOFF + 256 + d0 * QSTR) = z; } }
    __syncthreads();
    const LAS unsigned char* qsl = lds + QOFF + (r32 < 8 ? (hi * 8 + r32) * 16 : 256);
    LAS unsigned char* img = lds + wid * DIMG;
    const int kaddr = r32 * DROW + 16 * hi;
    const int vaddr = (int)(uintptr_t)img + (8 * (lane >> 5) + ((lane >> 2) & 3)) * DROW + (16 * ((lane >> 4) & 1) + 4 * (lane & 3)) * 2;
    const int woA = (lane >> 5) * DROW + (lane & 31) * 8, woB = (lane >> 4) * DROW + 256 + (lane & 15) * 8;
    float m_reg = -1e30f, l_reg = 0.f; f32x16 o[4] = {};
    f32x4 sa[16], sb[8];
#define DEC_LOAD(s_) do { const int pg_ = PPI * part + wid + 8 * ((s_) >> 2); const int phys_ = __builtin_amdgcn_readfirstlane(ptab[b * NPG + pg_]); \
        const float* pc_ = cckv + (size_t)phys_ * (PAGE * KVR) + ((s_) & 3) * (32 * KVR) + lane * 4; const float* pk_ = ckr + (size_t)phys_ * (PAGE * ROPE) + ((s_) & 3) * (32 * ROPE) + lane * 4; \
        _Pragma("unroll") for (int i = 0; i < 16; ++i) sa[i] = __builtin_nontemporal_load((const f32x4*)(pc_ + i * 256)); \
        _Pragma("unroll") for (int i = 0; i < 8; ++i) sb[i] = __builtin_nontemporal_load((const f32x4*)(pk_ + i * 256)); } while (0)
    DEC_LOAD(0);
    for (int s = 0; s < NSTEP; ++s) {
#pragma unroll
        for (int i = 0; i < 16; ++i) *(LAS u32x2*)(img + woA + i * (2 * DROW)) = (u32x2){cvtpk(sa[i][0], sa[i][1]), cvtpk(sa[i][2], sa[i][3])};
#pragma unroll
        for (int i = 0; i < 8; ++i) *(LAS u32x2*)(img + woB + i * (4 * DROW)) = (u32x2){cvtpk(sb[i][0], sb[i][1]), cvtpk(sb[i][2], sb[i][3])};
        SBAR();
        if (s + 1 < NSTEP) DEC_LOAD(s + 1);
        SBAR();
        f32x16 p0 = {};
#pragma unroll
        for (int d0 = 0; d0 < 12; ++d0) { const bf16x8 a = *(const LAS bf16x8*)(img + kaddr + 32 * d0); const bf16x8 qf = *(const LAS bf16x8*)(qsl + d0 * QSTR); p0 = __builtin_amdgcn_mfma_f32_32x32x16_bf16(a, qf, p0, 0, 0, 0); }
        float pmax = p0[0];
#pragma unroll
        for (int r = 1; r < 16; ++r) pmax = fmaxf(pmax, p0[r]);
        pmax = pl_swap_max(pmax);
        float mn, alpha;
        if (__builtin_expect(__all(pmax - m_reg <= THR2), 1)) { mn = m_reg; alpha = 1.f; }
        else { mn = fmaxf(m_reg, pmax); alpha = __builtin_amdgcn_exp2f(m_reg - mn); m_reg = mn; }
        float ps = 0.f;
#pragma unroll
        for (int r = 0; r < 16; ++r) { p0[r] = __builtin_amdgcn_exp2f(p0[r] - mn); ps += p0[r]; }
        ps = pl_swap_add(ps);
        l_reg = l_reg * alpha + ps;
        bf16x8 pa0, pa1; ATT_PK4(p0, 0, pa0); ATT_PK4(p0, 8, pa1);
        if (__any(alpha < 1.f)) {
#pragma unroll
            for (int r = 0; r < 4; ++r) { const float a = __shfl(alpha, r + 4 * hi);
#pragma unroll
                for (int d = 0; d < 4; ++d) o[d][r] *= a; } }
#define DEC_PV_D0(d0) do { s16x4 l0, h0, l1, h1; ATT_TRRD(l0, vaddr, (d0) * 64); ATT_TRRD(h0, vaddr, (d0) * 64 + 4 * DROW); ATT_TRRD(l1, vaddr, (d0) * 64 + 16 * DROW); ATT_TRRD(h1, vaddr, (d0) * 64 + 20 * DROW); \
        asm volatile("s_waitcnt lgkmcnt(0)" ::: "memory"); SBAR(); \
        o[d0] = __builtin_amdgcn_mfma_f32_32x32x16_bf16(pa0, ATT_PK(l0, h0), o[d0], 0, 0, 0); \
        o[d0] = __builtin_amdgcn_mfma_f32_32x32x16_bf16(pa1, ATT_PK(l1, h1), o[d0], 0, 0, 0); } while (0)
        DEC_PV_D0(0); DEC_PV_D0(1); DEC_PV_D0(2); DEC_PV_D0(3);
#undef DEC_PV_D0
        asm volatile("" ::: "memory");
    }
#undef DEC_LOAD
    LDS_WAIT();
    { LAS float* Ow = (LAS float*)img; LAS float* ml = (LAS float*)(img + 4096);
#pragma unroll
      for (int r = 0; r < 4; ++r)
#pragma unroll
          for (int d = 0; d < 4; ++d) Ow[(r + 4 * hi) * VD + d * 32 + r32] = o[d][r];
      if (lane < 8) { ml[2 * lane] = m_reg; ml[2 * lane + 1] = l_reg; } }
    __syncthreads();
    { const int head = tid >> 6, c = tid & 63; float M = -1e30f;
#pragma unroll
      for (int w = 0; w < NWAVES; ++w) M = fmaxf(M, ((LAS float*)(lds + w * DIMG + 4096))[2 * head]);
      float L = 0.f, O0 = 0.f, O1 = 0.f;
#pragma unroll
      for (int w = 0; w < NWAVES; ++w) { LAS float* ml = (LAS float*)(lds + w * DIMG + 4096); LAS float* Ow = (LAS float*)(lds + w * DIMG) + head * VD;
          const float f = __builtin_amdgcn_exp2f(ml[2 * head] - M); L += ml[2 * head + 1] * f; O0 += Ow[c] * f; O1 += Ow[c + 64] * f; }
      float* dp = DPART + ((size_t)item * NH + head) * 130; dp[c] = O0; dp[c + 64] = O1; if (c == 0) { dp[128] = M; dp[129] = L; } }
    __syncthreads();
}
}
#define XB_TMO      128
#define XB_XCNT(j)  (256  + 64 * (j))
#define XB_XSUB(j)  (1280 + 64 * (j))
#define XB_XGEN(j)  (2304 + 64 * (j))
#define XB_TOP      3328
#define XB_TOPGEN   3392
#define XCD_BAR_WORDS 3456
#define XB_SPIN_CAP (1u << 18)

__device__ __forceinline__ unsigned xb_ld(unsigned* p)              { return __hip_atomic_load(p, __ATOMIC_RELAXED, __HIP_MEMORY_SCOPE_AGENT); }
__device__ __forceinline__ unsigned xb_add(unsigned* p, unsigned v) { return __hip_atomic_fetch_add(p, v, __ATOMIC_RELAXED, __HIP_MEMORY_SCOPE_AGENT); }
__device__ __forceinline__ unsigned xb_xcc_id() { return (unsigned)__builtin_amdgcn_s_getreg((3 << 11) | 20) & 0xFu; }
#define XB_SPIN(cond, bar) do { unsigned _sp = 0; while (cond) { __builtin_amdgcn_s_sleep(1); \
    if ((++_sp & 255u) == 0u) { if (xb_ld(&(bar)[XB_TMO])) break; if (_sp > XB_SPIN_CAP) { atomicAdd(&(bar)[XB_TMO], 1u); break; } } } } while (0)

struct XcdBarrier {
    unsigned* bar; unsigned x;
    volatile LAS unsigned* st;
};

__device__ __forceinline__ XcdBarrier xcd_barrier_post(unsigned* bar, volatile LAS unsigned* st) {
    XcdBarrier b; b.bar = bar; b.x = xb_xcc_id(); b.st = st;
    if (threadIdx.x == 0) (void)xb_add(&bar[XB_XCNT(b.x)], 1u);
    return b;
}
__device__ __forceinline__ void xcd_barrier_complete(unsigned* bar, unsigned x, unsigned& nloc, unsigned& nx) {
    const unsigned G = gridDim.x * gridDim.y * gridDim.z;
    unsigned sum, cnt, mine, sp = 0u;
    for (;;) {
        sum = 0u; cnt = 0u; mine = 0u;
#pragma unroll
        for (unsigned j = 0; j < 16; ++j) { const unsigned c = xb_ld(&bar[XB_XCNT(j)]); sum += c; cnt += (c > 0u) ? 1u : 0u; mine = (j == x) ? c : mine; }
        if (sum == G) break;
        __builtin_amdgcn_s_sleep(1);
        if ((++sp & 255u) == 0u) { if (xb_ld(&bar[XB_TMO])) break; if (sp > XB_SPIN_CAP) { atomicAdd(&bar[XB_TMO], 1u); break; } }
    }
    nloc = mine > 0u ? mine : 1u; nx = cnt > 0u ? cnt : 1u;
}

__device__ __forceinline__ void xcd_barrier(const XcdBarrier& b) {
    asm volatile("s_waitcnt vmcnt(0)" ::: "memory");
    __syncthreads();
    if (threadIdx.x == 0) {
        unsigned* bar = b.bar;
        __builtin_amdgcn_s_waitcnt(0);
        unsigned nloc = b.st[0], nx = b.st[1];
        if (nloc == 0u) { xcd_barrier_complete(bar, b.x, nloc, nx); b.st[0] = nloc; b.st[1] = nx; }
        const unsigned old = xb_add(&bar[XB_XSUB(b.x)], 1u);
        const unsigned gen = old / nloc;
        if (old + 1u == (gen + 1u) * nloc) {
            __builtin_amdgcn_fence(__ATOMIC_RELEASE, "agent");
            asm volatile("s_waitcnt vmcnt(0)" ::: "memory");
            const unsigned og = xb_add(&bar[XB_TOP], 1u);
            const unsigned tg = og / nx;
            if (og + 1u == (tg + 1u) * nx) xb_add(&bar[XB_TOPGEN], 1u);
            else XB_SPIN(xb_ld(&bar[XB_TOPGEN]) == tg, bar);
            __builtin_amdgcn_fence(__ATOMIC_ACQUIRE, "agent");
            xb_add(&bar[XB_XGEN(b.x)], 1u);
            asm volatile("s_waitcnt vmcnt(0)" ::: "memory");
        } else {
            XB_SPIN(xb_ld(&bar[XB_XGEN(b.x)]) == gen, bar);
            __builtin_amdgcn_fence(__ATOMIC_ACQUIRE, "agent");
            asm volatile("s_waitcnt vmcnt(0)" ::: "memory");
        }
    }
    __syncthreads();
}

struct Args { const float* in[19]; float* out; unsigned char* ws; int ph_lo, ph_hi; };
enum { I_XP = 0, I_XS, I_CKV, I_CKR, I_SPOOL, I_PTAB, I_GPRE, I_WIN, I_GQ, I_WUQ, I_GKV, I_WUK, I_WUV, I_WOATT, I_WPOOL, I_PSCALE, I_WOPOOL, I_WOUT, I_GFINAL };
constexpr int N_PHASES = 9;

__device__ __forceinline__ void p0_transpose_item(const float* __restrict__ W, int K, int N, bf16* __restrict__ WT, int row_off, LAS float* scr, int item, int lane) {
    const int nblk = N / 32, kb = item / nblk, nb = item % nblk, k0 = 64 * kb, n0 = 32 * nb;
#pragma unroll 8
    for (int i = 0; i < 32; ++i) { const int kk = 2 * i + (lane >> 5); scr[kk * 33 + (lane & 31)] = W[(size_t)(k0 + kk) * N + n0 + (lane & 31)]; }
    LDS_WAIT(); asm volatile("" ::: "memory");
    const int c = lane & 7;
#pragma unroll
    for (int j = 0; j < 4; ++j) { const int n = (lane >> 3) + 8 * j; const LAS float* s = scr + (8 * c) * 33 + n;
        u32x4 o; o.x = cvtpk(s[0 * 33], s[1 * 33]); o.y = cvtpk(s[2 * 33], s[3 * 33]); o.z = cvtpk(s[4 * 33], s[5 * 33]); o.w = cvtpk(s[6 * 33], s[7 * 33]);
        *(u32x4*)(WT + (size_t)(row_off + n0 + n) * K + k0 + 8 * c) = o; }
    LDS_WAIT(); asm volatile("" ::: "memory");
}


#define PHASE_ARGS() \
    int tid_ = threadIdx.x; asm volatile("" : "+v"(tid_)); const int tid = tid_, lane = tid & 63, wave = __builtin_amdgcn_readfirstlane(tid >> 6); (void)lane; \
    const __attribute__((address_space(4))) Args* ap_ = (const __attribute__((address_space(4))) Args*)__builtin_amdgcn_kernarg_segment_ptr(); asm volatile("" : "+s"(ap_)); const __attribute__((address_space(4))) Args& args = *ap_; \
    unsigned char* ws = args.ws; float* out = args.out; (void)out; \
    bf16* BT1 = (bf16*)(ws + WS_BT1); bf16* BTQ = (bf16*)(ws + WS_BTQ); bf16* BTG = (bf16*)(ws + WS_BTG); bf16* BTOA = (bf16*)(ws + WS_BTOA); bf16* BTOP = (bf16*)(ws + WS_BTOP); bf16* BTOUT = (bf16*)(ws + WS_BTOUT); \
    float* ROPET = (float*)(ws + WS_ROPE); float* QSS = (float*)(ws + WS_QSS); float* DPART = (float*)(ws + WS_DPART); \
    bf16* H = (bf16*)(ws + WS_H); bf16* QLAT = (bf16*)(ws + WS_QLAT); float* KVRAW = (float*)(ws + WS_KVRAW); bf16* KB = (bf16*)(ws + WS_KB); bf16* SZ = (bf16*)(ws + WS_SZ); \
    float* U = (float*)(ws + WS_U); bf16* SGA = (bf16*)(ws + WS_SGA); bf16* SGP = (bf16*)(ws + WS_SGP); bf16* OLPL = (bf16*)(ws + WS_OLPL); bf16* QA = (bf16*)(ws + WS_QA); bf16* QR = (bf16*)(ws + WS_QR); \
    bf16* G12 = (bf16*)(ws + WS_G12); float* M1 = (float*)(ws + WS_M1); bf16* MG = (bf16*)(ws + WS_MG); \
    (void)BT1; (void)BTQ; (void)BTG; (void)BTOA; (void)BTOP; (void)BTOUT; (void)ROPET; (void)QSS; (void)DPART; (void)H; (void)QLAT; (void)KVRAW; (void)KB; (void)SZ; (void)U; (void)SGA; (void)SGP; (void)OLPL; (void)QA; (void)QR; (void)G12; (void)M1; (void)MG; \
    const int G = gridDim.x, bx = blockIdx.x; const int vcu = (G % 8 == 0) ? (bx % 8) * (G / 8) + bx / 8 : bx; const int gw = vcu * NWAVES + wave, NGW = G * NWAVES; (void)gw; (void)NGW;


__device__ __forceinline__ f32x4 skinny_tile(const bf16* __restrict__ A, int lda, const bf16* __restrict__ Bt, int ldb, int K, f32x4 acc, int lane) {
    const bf16* ap = A + (size_t)(lane & 15) * lda + (lane >> 4) * 8; const bf16* bp = Bt + (size_t)(lane & 15) * ldb + (lane >> 4) * 8;
#pragma unroll 8
    for (int k = 0; k < K; k += 32) acc = __builtin_amdgcn_mfma_f32_16x16x32_bf16(*(const bf16x8*)(bp + k), *(const bf16x8*)(ap + k), acc, 0, 0, 0);
    return acc;
}
__device__ __forceinline__ f32x4 unpk4(u32x2 g) { return (f32x4){bflo(g.x), bfhi(g.x), bflo(g.y), bfhi(g.y)}; }

__global__ void __launch_bounds__(NWAVES * 64, 2) mk_fwd(Args args_in) {
    extern __shared__ __attribute__((aligned(16))) unsigned char lds_raw[];
    LAS unsigned char* lds = (LAS unsigned char*)lds_raw;
    volatile LAS unsigned* MISC = (volatile LAS unsigned*)(lds + MISC_OFF);
    for (int u = threadIdx.x; u < (LDS_BYTES - LDSCTL_OFF) / 4; u += NWAVES * 64) ((LAS unsigned*)(lds + LDSCTL_OFF))[u] = 0u;
    __syncthreads();
    const int lo = args_in.ph_lo, hi = args_in.ph_hi;
    XcdBarrier bar = xcd_barrier_post((unsigned*)(args_in.ws + WS_CTL) + CW_BAR + lo * XCD_BAR_WORDS, MISC + 8);
#ifndef PH_MASK
#define PH_MASK 0x1ff
#endif
#define IN(k) (((PH_MASK >> (k)) & 1) && lo <= (k) && (k) < hi)
#define SEAM(k) do { if (IN(k) && IN((k) + 1)) xcd_barrier(bar); } while (0)
#ifdef MK_CHECK
#define STAMP(k) do { if (blockIdx.x == 0 && threadIdx.x == 0) ((unsigned long long*)((unsigned*)(args_in.ws + WS_CTL) + 131072 + 64))[(k)] = __builtin_amdgcn_s_memrealtime(); } while (0)
#else
#define STAMP(k) do { } while (0)
#endif
#ifdef MK_CHECK
#define STAMPX(k) do { if (threadIdx.x == 0) ((unsigned long long*)((unsigned*)(args_in.ws + WS_CTL) + 131072 + 64))[(k)] = __builtin_amdgcn_s_memrealtime(); } while (0)
#else
#define STAMPX(k) do { } while (0)
#endif
    STAMP(0);

    if (IN(0)) { PHASE_ARGS()
        LAS float* scr = (LAS float*)(lds + RING_OFF + wave * 16384);
        for (int it = gw; it < (DM / 64) * (INC / 32); it += NGW) { const int nb = it % (INC / 32); p0_transpose_item(args.in[I_WIN], DM, INC, BT1, (32 * nb >= 448) ? 64 : 0, scr, it, lane); }
        for (int i = bx * 512 + tid; i < 64 * DM / 8; i += G * 512) *(u32x4*)(BT1 + (size_t)448 * DM + (size_t)i * 8) = (u32x4){0u, 0u, 0u, 0u};
        for (int m0 = gw; m0 < MTOT; m0 += 2 * NGW) {
            const f32x4* gr = (const f32x4*)args.in[I_GPRE] + lane;
            f32x4 v[2][4]; float s[2] = {0.f, 0.f};
#pragma unroll
            for (int u = 0; u < 2; ++u) { const int m = m0 + u * NGW; if (m < MTOT) {
                const float* xrow = m < SEQ ? args.in[I_XP] + (size_t)m * DM : args.in[I_XS] + (size_t)(m - SEQ) * DM; const f32x4* xr = (const f32x4*)xrow + lane;
#pragma unroll
                for (int j = 0; j < 4; ++j) v[u][j] = __builtin_nontemporal_load(xr + 64 * j); } }
#pragma unroll
            for (int u = 0; u < 2; ++u) { const int m = m0 + u * NGW; if (m < MTOT) {
#pragma unroll
                for (int j = 0; j < 4; ++j) s[u] += (v[u][j][0] * v[u][j][0] + v[u][j][1] * v[u][j][1]) + (v[u][j][2] * v[u][j][2] + v[u][j][3] * v[u][j][3]);
                const float rs = 1.0f / sqrtf(wave_sum(s[u]) * (1.f / DM) + EPS);
                unsigned long long* o8 = (unsigned long long*)(H + (size_t)m * DM) + lane;
#pragma unroll
                for (int j = 0; j < 4; ++j) { const f32x4 g = gr[64 * j]; o8[64 * j] = (unsigned long long)cvtpk(v[u][j][0] * rs * g[0], v[u][j][1] * rs * g[1]) | ((unsigned long long)cvtpk(v[u][j][2] * rs * g[2], v[u][j][3] * rs * g[3]) << 32); } } }
        }
        VM_WAIT(); __syncthreads();
    }
    SEAM(0); STAMP(1);

    if (IN(1)) { PHASE_ARGS()
        pg8::Gemm g{H, BT1, DM, DM, DM, 0}; pg8::StaticOrder S; S.init(MPAD, N1, G, bx);
        pg8::Epi1 E{QLAT, QSS, KVRAW, SZ, U, SGA, SGP};
        pg8::gemm_phase<pg8::Epi1, pg8::StaticOrder, true, true>(lds + RING_OFF, g, S, E);
        { int first = S.nwg - (S.nwg / G) * G, cnt = G - first; if (S.nwg % G == 0) { first = 0; cnt = G; }
          if (bx >= first) { const int sw = (bx - first) * NWAVES + wave, NSW = cnt * NWAVES;
        for (int it = sw; it < 1536; it += NSW) {
            const float* wuq = args.in[I_WUQ]; const float* gq = args.in[I_GQ];
            if (it < 1024) { const int h = it >> 7, r = it & 127; const float* uk = args.in[I_WUK] + ((size_t)r * NH + h) * NOPE;
                float a[4] = {0.f, 0.f, 0.f, 0.f};
#pragma unroll 8
                for (int n = 0; n < NOPE; n += 4) { const f32x4 k4 = *(const f32x4*)(uk + n);
#pragma unroll
                    for (int j = 0; j < 4; ++j) { const f32x4 q4 = *(const f32x4*)(wuq + (size_t)(lane + 64 * j) * (NH * (NOPE + ROPE)) + h * (NOPE + ROPE) + n);
                        a[j] += (q4[0] * k4[0] + q4[1] * k4[1]) + (q4[2] * k4[2] + q4[3] * k4[3]); } }
#pragma unroll
                for (int j = 0; j < 4; ++j) { const int k = lane + 64 * j; BTQ[(size_t)it * QRANK + k] = (bf16)(cvtpk(a[j] * gq[k], 0.f) & 0xffffu); }
            } else { const int j2 = it - 1024, pn = j2 >> 8, jj = j2 & 255, bj = jj >> 7, x = jj & 127, head = 4 * pn + (x >> 5), dim = (x & 31) + 32 * bj;
#pragma unroll
                for (int j = 0; j < 4; ++j) { const int k = lane + 64 * j; BTQ[(size_t)it * QRANK + k] = (bf16)(cvtpk(gq[k] * wuq[(size_t)k * (NH * (NOPE + ROPE)) + head * (NOPE + ROPE) + NOPE + dim], 0.f) & 0xffffu); } }
        }
        for (int it = sw; it < 1536; it += NSW) {
#pragma unroll
            for (int j = 0; j < 4; ++j) { const int kk = lane + 64 * j; float v = 0.f;
                if (it < 1024) { const int h = it >> 7, vv = it & 127; if ((kk >> 7) == (h & 1)) v = args.in[I_WUV][((size_t)(kk & 127) * NH + h) * VD + vv]; }
                else { const int n = it - 1024, g = n >> 7, d = n & 127; if ((kk >> 7) == (g & 1)) v = args.in[I_WPOOL][((size_t)g * 128 + (kk & 127)) * 128 + d]; }
                BTG[(size_t)it * 256 + kk] = (bf16)(cvtpk(v, 0.f) & 0xffffu); }
        }
        for (int e = sw * 64 + lane; e < (SEQ + 1) * 32; e += NSW * 64) { const int pos = e >> 5, i = e & 31;
            const float inv = powf(10000.0f, -(float)i / 32.0f); const float ang = (float)pos * inv;
            ROPET[2 * (size_t)e] = (float)cos((double)ang); ROPET[2 * (size_t)e + 1] = (float)sin((double)ang); }
          } }
        VM_WAIT(); __syncthreads();
    }
    SEAM(1); STAMP(2);

    if (IN(2)) { PHASE_ARGS()
#ifndef P2_NO_ELEM
        for (int r0 = gw; r0 < MTOT; r0 += 2 * NGW) {
            float v0[2], v1[2], x1[2], x2[2], cs[2], sn[2];
#pragma unroll
            for (int u = 0; u < 2; ++u) { const int row = r0 + u * NGW < MTOT ? r0 + u * NGW : r0; const float* src = KVRAW + (size_t)row * QKD; const int pos = row < SEQ ? row : SEQ;
                v0[u] = src[lane]; v1[u] = src[lane + 64]; x1[u] = src[KVR + (lane & 31)]; x2[u] = src[KVR + 32 + (lane & 31)];
                cs[u] = ROPET[2 * ((size_t)pos * 32 + (lane & 31))]; sn[u] = ROPET[2 * ((size_t)pos * 32 + (lane & 31)) + 1]; }
#pragma unroll
            for (int u = 0; u < 2; ++u) { const int row = r0 + u * NGW; if (row < MTOT) {
                float* ckv_o = row < SEQ ? out + O_CKVP + (size_t)row * KVR : out + O_CKVS + (size_t)(row - SEQ) * KVR;
                float* kr_o = row < SEQ ? out + O_KRP + (size_t)row * ROPE : out + O_KRS + (size_t)(row - SEQ) * ROPE;
                const float rs = 1.0f / sqrtf(wave_sum(v0[u] * v0[u] + v1[u] * v1[u]) * (1.f / KVR) + EPS);
                const float c0 = v0[u] * rs * args.in[I_GKV][lane], c1 = v1[u] * rs * args.in[I_GKV][lane + 64];
                ckv_o[lane] = c0; ckv_o[lane + 64] = c1;
                bf16* kb = KB + (size_t)row * QKD; kb[lane] = (bf16)(cvtpk(c0, 0.f) & 0xffffu); kb[lane + 64] = (bf16)(cvtpk(c1, 0.f) & 0xffffu);
                if (lane < 32) { const float o1 = x1[u] * cs[u] - x2[u] * sn[u], o2 = x2[u] * cs[u] + x1[u] * sn[u];
                    kr_o[lane] = o1; kr_o[lane + 32] = o2; kb[KVR + lane] = (bf16)(cvtpk(o1, 0.f) & 0xffffu); kb[KVR + 32 + lane] = (bf16)(cvtpk(o2, 0.f) & 0xffffu); } } }
        }
        for (int it = gw; it < (SEQ / 32) * 4; it += NGW) { const int q = it & 3, t0 = (it >> 2) * 32, w = 2 << q, c = 128 * q + 2 * lane;
            const float* __restrict__ Uc = U + c; bf16* __restrict__ Oc = OLPL + ATTW + c;
            f32x2 sum = {0.f, 0.f};
            for (int i = 1; i < w; ++i) { const int t = t0 - i; if (t >= 0) sum += *(const f32x2*)(Uc + (size_t)t * POOLW); }
            for (int tb = t0; tb < t0 + 32; tb += 8) { f32x2 un[8], uo[8];
#pragma unroll
                for (int j = 0; j < 8; ++j) { un[j] = *(const f32x2*)(Uc + (size_t)(tb + j) * POOLW); const int told = tb + j - (w - 1); uo[j] = (f32x2){0.f, 0.f}; if (told >= 0) uo[j] = *(const f32x2*)(Uc + (size_t)told * POOLW); }
#pragma unroll
                for (int j = 0; j < 8; ++j) { const int t = tb + j; sum += un[j]; const float rc = 1.0f / (float)(t + 1 < w ? t + 1 : w);
                    *(unsigned*)(Oc + (size_t)t * GW) = cvtpk(sum[0] * rc - un[j][0], sum[1] * rc - un[j][1]); sum -= uo[j]; } }
        }
        for (int it = gw; it < NS * 4; it += NGW) { const int q = it & 3, b = it >> 2, w = 2 << q, c = 128 * q + 2 * lane;
            const f32x2 u = *(const f32x2*)(U + (size_t)(SEQ + b) * POOLW + c); f32x2 sum = u;
            for (int i = 0; i < w - 1; ++i) sum += *(const f32x2*)(args.in[I_SPOOL] + ((size_t)b * PHIST + (PHIST - 1 - i)) * POOLW + c);
            const float rc = 1.0f / (float)w;
            *(unsigned*)(OLPL + (size_t)(SEQ + b) * GW + ATTW + c) = cvtpk(sum[0] * rc - u[0], sum[1] * rc - u[1]); }
        for (int e = gw * 64 + lane; e < (PHIST * POOLW + NS * PHIST * POOLW) / 4; e += NGW * 64) {
            if (e < PHIST * POOLW / 4) { *(f32x4*)(out + O_POOLP + (size_t)e * 4) = *(const f32x4*)(U + (size_t)(SEQ - PHIST) * POOLW + (size_t)e * 4); }
            else { const int e2 = e - PHIST * POOLW / 4, b = e2 / (PHIST * POOLW / 4), r = e2 % (PHIST * POOLW / 4), j = r / (POOLW / 4), c4 = r % (POOLW / 4);
                const f32x4 v = j < PHIST - 1 ? *(const f32x4*)(args.in[I_SPOOL] + ((size_t)b * PHIST + j + 1) * POOLW + c4 * 4) : *(const f32x4*)(U + (size_t)(SEQ + b) * POOLW + c4 * 4);
                *(f32x4*)(out + O_POOLS + (size_t)e2 * 4) = v; } }
#endif
#ifndef P2_NO_GEMM
        pg8::Gemm g{QLAT, BTQ, QRANK, QRANK, QRANK, 0}; pg8::StaticOrder S; S.init(MPAD, 1536, G, bx);
        pg8::Epi2 E{QA, QR, QSS, ROPET};
        pg8::gemm_phase<pg8::Epi2, pg8::StaticOrder, true, true>(lds + RING_OFF, g, S, E);
        { int first = S.nwg - (S.nwg / G) * G, cnt = G - first; if (S.nwg % G == 0) { first = 0; cnt = G; }
          if (bx >= first) { const int sw = (bx - first) * NWAVES + wave, NSW = cnt * NWAVES; LAS float* scr = (LAS float*)(lds + RING_OFF + wave * 16384);
              constexpr int I_OA = (ATTW / 64) * (DM / 32), I_OP = (POOLW / 64) * (DM / 32), I_OUT = (DM / 64) * (DM / 32);
              for (int it = sw; it < I_OA + I_OP + I_OUT; it += NSW) { int r = it;
                  if (r < I_OA) { p0_transpose_item(args.in[I_WOATT], ATTW, DM, BTOA, 0, scr, r, lane); continue; } r -= I_OA;
                  if (r < I_OP) { p0_transpose_item(args.in[I_WOPOOL], POOLW, DM, BTOP, 0, scr, r, lane); continue; } r -= I_OP;
                  p0_transpose_item(args.in[I_WOUT], DM, DM, BTOUT, 0, scr, r, lane); } } }
        VM_WAIT(); __syncthreads();
#endif
    }
    SEAM(2); STAMP(3);

    if (IN(3)) { PHASE_ARGS()
        gu32* qp = (gu32*)(ws + WS_CTL) + CW_QPROMPT; gu32* qd = (gu32*)(ws + WS_CTL) + CW_QDEC;
        volatile LAS unsigned* slot = (volatile LAS unsigned*)(lds + MISC_OFF) + 16;
#define GRAB(q_, v_) do { if (tid == 0) *slot = __hip_atomic_fetch_add((q_), 1u, __ATOMIC_RELAXED, __HIP_MEMORY_SCOPE_AGENT); __syncthreads(); (v_) = (int)*slot; __syncthreads(); } while (0)
        int mode = bx < ND_FIRST ? 0 : 1;
        for (int done = 0; done < 2;) {
            int it;
            const __attribute__((address_space(4))) Args* a2 = (const __attribute__((address_space(4))) Args*)__builtin_amdgcn_kernarg_segment_ptr(); asm volatile("" : "+s"(a2));
            unsigned char* w2 = a2->ws;
            int t2 = tid; asm volatile("" : "+v"(t2)); const int l2 = t2 & 63;
            if (mode == 0) { GRAB(qd, it); if (it >= NS * DSPLIT) { if (it == NS * DSPLIT) STAMPX(12); mode = 1; ++done; continue; }
                att::decode_item(it, a2->in[I_CKV], a2->in[I_CKR], (const int*)a2->in[I_PTAB], (const bf16*)(w2 + WS_QA), (const bf16*)(w2 + WS_QR), (float*)(w2 + WS_DPART), lds + RING_OFF, t2, wave, l2); }
            else { GRAB(qp, it); if (it >= SEQ / 32) { if (it == SEQ / 32) STAMPX(13); mode = 0; ++done; continue; }
                att::prompt_unit(32 * (SEQ / 32 - 1 - it), (const bf16*)(w2 + WS_QA), (const bf16*)(w2 + WS_QR), (const bf16*)(w2 + WS_KB), (bf16*)(w2 + WS_OLPL), lds + RING_OFF, t2, wave, l2); }
        }
#undef GRAB
    }
    SEAM(3); STAMP(4);

    if (IN(4)) { PHASE_ARGS()
        for (int it = gw; it < NS * NH; it += NGW) { const int b = it >> 3, h = it & 7; const size_t row = (size_t)(SEQ + b);
            const float* dp = DPART + ((size_t)(b * DSPLIT) * NH + h) * 130;
            const bf16* qa = QA + row * ATTW + h * NOPE; const bf16* qq = QR + row * (NH * ROPE) + h * ROPE; const bf16* kb = KB + row * QKD;
            float ts = bf2f(qa[lane]) * bf2f(kb[lane]) + bf2f(qa[lane + 64]) * bf2f(kb[lane + 64]) + bf2f(qq[lane]) * bf2f(kb[KVR + lane]);
            ts = wave_sum(ts);
            float M = ts;
#pragma unroll
            for (int p = 0; p < DSPLIT; ++p) M = fmaxf(M, dp[p * NH * 130 + 128]);
            const float wsf = __builtin_amdgcn_exp2f(ts - M);
            float L = wsf, o0 = wsf * bf2f(kb[lane]), o1 = wsf * bf2f(kb[lane + 64]);
#pragma unroll
            for (int p = 0; p < DSPLIT; ++p) { const float* d = dp + p * NH * 130; const float w = __builtin_amdgcn_exp2f(d[128] - M); L += d[129] * w; o0 += d[lane] * w; o1 += d[lane + 64] * w; }
            const float rl = 1.0f / L;
            OLPL[row * GW + h * VD + lane] = (bf16)(cvtpk(o0 * rl, 0.f) & 0xffffu); OLPL[row * GW + h * VD + lane + 64] = (bf16)(cvtpk(o1 * rl, 0.f) & 0xffffu);
        }
        VM_WAIT(); __syncthreads();
    }
    SEAM(4); STAMP(5);

    if (IN(5)) { PHASE_ARGS()
        for (int t = gw; t < 8 * 96; t += NGW) { const int rb = t / 96, n0 = 16 * (t % 96), hd = n0 >> 7, fr = lane & 15, fq = lane >> 4; const size_t row = (size_t)(SEQ + 16 * rb + fr); const int c = n0 + 4 * fq;
            f32x4 acc = skinny_tile(OLPL + (size_t)(SEQ + 16 * rb) * GW + hd * 128, GW, BTG + (size_t)n0 * 256 + 128 * (hd & 1), 256, 128, (f32x4){0.f, 0.f, 0.f, 0.f}, lane);
            acc = acc * unpk4(*(const u32x2*)(SZ + row * GW + c)); if (c >= ATTW) acc = acc * *(const f32x4*)(args.in[I_PSCALE] + c - ATTW);
            *(u32x2*)(G12 + row * GW + c) = (u32x2){cvtpk(acc[0], acc[1]), cvtpk(acc[2], acc[3])}; }
        pg8::Gemm g{OLPL, BTG, GW, 256, 256, 256}; pg8::StaticOrder S; S.init(SEQ, GW, G, bx);
        pg8::Epi5 E{G12, SZ, args.in[I_PSCALE]};
        pg8::gemm_phase<pg8::Epi5, pg8::StaticOrder, true, true>(lds + RING_OFF, g, S, E);
    }
    SEAM(5); STAMP(6);

    if (IN(6)) { PHASE_ARGS()
        for (int t = gw; t < 8 * 64; t += NGW) { const int rb = t >> 6, n0 = 16 * (t & 63), fr = lane & 15, fq = lane >> 4; const size_t row = (size_t)(SEQ + 16 * rb + fr); const int c = n0 + 4 * fq;
            const bf16* a1 = G12 + (size_t)(SEQ + 16 * rb) * GW;
            const f32x4 y1 = skinny_tile(a1, GW, BTOA + (size_t)n0 * ATTW, ATTW, ATTW, (f32x4){0.f, 0.f, 0.f, 0.f}, lane);
            const f32x4 y2 = skinny_tile(a1 + ATTW, GW, BTOP + (size_t)n0 * POOLW, POOLW, POOLW, (f32x4){0.f, 0.f, 0.f, 0.f}, lane);
            const f32x4 m = y1 * unpk4(*(const u32x2*)(SGA + row * DM + c)) + y2 * unpk4(*(const u32x2*)(SGP + row * DM + c));
            *(u32x2*)(MG + row * DM + c) = (u32x2){cvtpk(m[0], m[1]), cvtpk(m[2], m[3])}; }
        { pg8::Gemm g{G12, BTOA, GW, ATTW, ATTW, 0}; pg8::StaticOrder S; S.init(SEQ, DM, G, bx);
          pg8::Epi6<false> E{M1, MG, SGA};
          pg8::gemm_phase<pg8::Epi6<false>, pg8::StaticOrder, true, true>(lds + RING_OFF, g, S, E); }
        VM_WAIT(); __syncthreads();
        { pg8::Gemm g{G12 + ATTW, BTOP, GW, POOLW, POOLW, 0}; pg8::StaticOrder S; S.init(SEQ, DM, G, bx);
          pg8::Epi6<true> E{M1, MG, SGP};
          pg8::gemm_phase<pg8::Epi6<true>, pg8::StaticOrder, true, true>(lds + RING_OFF, g, S, E); }
    }
    SEAM(6); STAMP(7);

    if (IN(7)) { PHASE_ARGS()
        for (int t = gw; t < 8 * 64; t += NGW) { const int rb = t >> 6, n0 = 16 * (t & 63), fr = lane & 15, fq = lane >> 4; const int c = n0 + 4 * fq; const size_t r = (size_t)(16 * rb + fr);
            const f32x4 acc = skinny_tile(MG + (size_t)(SEQ + 16 * rb) * DM, DM, BTOUT + (size_t)n0 * DM, DM, DM, (f32x4){0.f, 0.f, 0.f, 0.f}, lane);
            *(f32x4*)(out + O_YS + r * DM + c) = *(const f32x4*)(args.in[I_XS] + r * DM + c) + acc; }
        pg8::Gemm g{MG, BTOUT, DM, DM, DM, 0}; pg8::StaticOrder S; S.init(SEQ, DM, G, bx);
        pg8::Epi7 E{args.in[I_XP], args.in[I_XS], out};
        pg8::gemm_phase<pg8::Epi7, pg8::StaticOrder, true, true>(lds + RING_OFF, g, S, E);
    }
    SEAM(7); STAMP(8);

    if (IN(8)) { PHASE_ARGS()
        for (int m = gw; m < MTOT; m += NGW) {
            float* y = m < SEQ ? out + O_YP + (size_t)m * DM : out + O_YS + (size_t)(m - SEQ) * DM;
            f32x4* yr = (f32x4*)y + lane; const f32x4* gr = (const f32x4*)args.in[I_GFINAL] + lane;
            f32x4 v[4]; float s = 0.f;
#pragma unroll
            for (int j = 0; j < 4; ++j) { v[j] = yr[64 * j]; s += (v[j][0] * v[j][0] + v[j][1] * v[j][1]) + (v[j][2] * v[j][2] + v[j][3] * v[j][3]); }
            const float rs = 1.0f / sqrtf(wave_sum(s) * (1.f / DM) + EPS);
#pragma unroll
            for (int j = 0; j < 4; ++j) yr[64 * j] = v[j] * rs * gr[64 * j];
        }
    }
    STAMP(9);
#undef IN
#undef SEAM
}

#ifndef MK_CUTS
#define MK_CUTS 0
#endif
extern "C" void kernel_launch(void* const* d_in, const int* in_sizes, int n_in, void* d_out, int out_size, void* d_ws, size_t ws_size, hipStream_t stream) {
    static int grid = 0;
    if (grid == 0) {
        if (n_in != 19 || out_size != (int)O_END || ws_size < WS_END) { fprintf(stderr, "kernel_launch: built for 19 inputs, %zu outputs, >= %zu bytes of workspace; got %d, %d, %zu\n", (size_t)O_END, (size_t)WS_END, n_in, out_size, ws_size); grid = -1; return; }
        int dev = 0, cus = 0, per_cu = 0;
        if (hipGetDevice(&dev) != hipSuccess || hipDeviceGetAttribute(&cus, hipDeviceAttributeMultiprocessorCount, dev) != hipSuccess) { grid = -1; return; }
        if (hipFuncSetAttribute((const void*)mk_fwd, hipFuncAttributeMaxDynamicSharedMemorySize, LDS_BYTES) != hipSuccess) { fprintf(stderr, "kernel_launch: hipFuncSetAttribute failed\n"); grid = -1; return; }
        if (hipOccupancyMaxActiveBlocksPerMultiprocessor(&per_cu, (const void*)mk_fwd, NWAVES * 64, LDS_BYTES) != hipSuccess || per_cu < 1) { fprintf(stderr, "kernel_launch: occupancy query says %d workgroups per CU\n", per_cu); }
        (void)hipGetLastError();
        grid = cus;
    }
    if (grid < 0) return;
    (void)hipMemsetAsync((char*)d_ws + WS_CTL, 0, CTL_ZERO_BYTES, stream);
    Args a{};
    for (int i = 0; i < 19; ++i) a.in[i] = (const float*)d_in[i];
    a.out = (float*)d_out; a.ws = (unsigned char*)d_ws;
#if MK_CUTS
    for (int p = 0; p < N_PHASES; ++p) { a.ph_lo = p; a.ph_hi = p + 1; hipLaunchKernelGGL(mk_fwd, dim3(grid), dim3(NWAVES * 64), LDS_BYTES, stream, a); }
#else
    a.ph_lo = 0; a.ph_hi = N_PHASES; hipLaunchKernelGGL(mk_fwd, dim3(grid), dim3(NWAVES * 64), LDS_BYTES, stream, a);
#endif
#ifdef MK_CHECK
    { static bool once = false; if (!once) { once = true; (void)hipFuncSetAttribute((const void*)chk_attn, hipFuncAttributeMaxDynamicSharedMemorySize, 68000); }
#ifndef CHK_NOERR
      hipLaunchKernelGGL(chk_attn, dim3(160 * 8), dim3(256), 68000, stream, a);
      hipLaunchKernelGGL(chk_chain, dim3(64), dim3(256), 0, stream, a);
#endif
      hipLaunchKernelGGL(chk_report, dim3(64), dim3(256), 0, stream, a); }
#endif
    const hipError_t le = hipPeekAtLastError();
    if (le != hipSuccess) fprintf(stderr, "kernel_launch: launch failed: %s\n", hipGetErrorName(le));
}
```

```cpp
#include <hip/hip_runtime.h>
#include <cstdio>
#include <cstdint>

#define GAS __attribute__((address_space(1)))
#define LAS __attribute__((address_space(3)))
typedef unsigned short bf16;
typedef short bf16x8 __attribute__((ext_vector_type(8)));
typedef short s16x4 __attribute__((ext_vector_type(4)));
typedef float f32x2 __attribute__((ext_vector_type(2)));
typedef float f32x4 __attribute__((ext_vector_type(4)));
typedef float f32x16 __attribute__((ext_vector_type(16)));
typedef unsigned u32x2 __attribute__((ext_vector_type(2)));
typedef unsigned u32x4 __attribute__((ext_vector_type(4)));
typedef GAS unsigned gu32;

constexpr int DM = 1024, SEQ = 16384, NS = 128, PAST = 16384, PAGE = 128, NPG = PAST / PAGE;
constexpr int MTOT = SEQ + NS;
constexpr int MPAD = 65 * 256;
constexpr int NH = 8, NOPE = 128, ROPE = 64, VD = 128, QRANK = 256, KVR = 128, ATTW = NH * VD, POOLW = 512, PHIST = 15;
constexpr int QKD = KVR + ROPE;
constexpr int INC = 4544, N1 = 4608;
constexpr int GW = ATTW + POOLW;
constexpr float EPS = 1e-6f;
constexpr float C2 = 0.07216878364870322f * 1.4426950408889634f;
constexpr size_t O_YP = 0, O_YS = O_YP + (size_t)SEQ * DM, O_CKVP = O_YS + (size_t)NS * DM, O_KRP = O_CKVP + (size_t)SEQ * KVR, O_POOLP = O_KRP + (size_t)SEQ * ROPE,
                 O_CKVS = O_POOLP + (size_t)PHIST * POOLW, O_KRS = O_CKVS + (size_t)NS * KVR, O_POOLS = O_KRS + (size_t)NS * ROPE, O_END = O_POOLS + (size_t)NS * PHIST * POOLW;
static_assert(O_END == 21069312, "d_out map");
constexpr size_t MiB = 1u << 20;
constexpr size_t WS_CTL = 0, CTL_ZERO_BYTES = 1 * MiB;
constexpr size_t WS_BT1 = 2 * MiB;
constexpr size_t WS_BTQ = 11 * MiB;
constexpr size_t WS_BTG = 12 * MiB;
constexpr size_t WS_BTOA = 13 * MiB;
constexpr size_t WS_BTOP = 15 * MiB;
constexpr size_t WS_BTOUT = 16 * MiB;
constexpr size_t WS_ROPE = 18 * MiB;
constexpr size_t WS_QSS = 23 * MiB;
constexpr size_t WS_DPART = 24 * MiB;
constexpr size_t WS_H = 32 * MiB;
constexpr size_t WS_QLAT = 65 * MiB;
constexpr size_t WS_KVRAW = 74 * MiB;
constexpr size_t WS_KB = 87 * MiB;
constexpr size_t WS_SZ = 94 * MiB;
constexpr size_t WS_U = 143 * MiB;
constexpr size_t WS_SGA = 176 * MiB;
constexpr size_t WS_SGP = 209 * MiB;
constexpr size_t WS_OLPL = 242 * MiB;
constexpr size_t WS_QA = 291 * MiB;
constexpr size_t WS_QR = 324 * MiB;
constexpr size_t WS_G12 = 341 * MiB;
constexpr size_t WS_M1 = 390 * MiB;
constexpr size_t WS_MG = 456 * MiB;
constexpr size_t WS_END = 489 * MiB;
static_assert(WS_BT1 + (size_t)N1 * 1024 * 2 <= WS_BTQ && WS_BTQ + 1536 * 256 * 2 <= WS_BTG && WS_BTG + 1536 * 256 * 2 <= WS_BTOA && WS_ROPE + (size_t)(SEQ + 1) * 32 * 8 <= WS_QSS &&
              WS_QSS + (size_t)MPAD * 16 <= WS_DPART && WS_DPART + (size_t)NS * 8 * 8 * 130 * 4 <= WS_H && WS_H + (size_t)MPAD * 2048 <= WS_QLAT && WS_QLAT + (size_t)MPAD * 512 <= WS_KVRAW &&
              WS_KVRAW + (size_t)MPAD * 768 <= WS_KB && WS_KB + (size_t)MPAD * 384 <= WS_SZ && WS_SZ + (size_t)MPAD * 3072 <= WS_U && WS_U + (size_t)MPAD * 2048 <= WS_SGA &&
              WS_SGA + (size_t)MPAD * 2048 <= WS_SGP && WS_SGP + (size_t)MPAD * 2048 <= WS_OLPL && WS_OLPL + (size_t)MPAD * 3072 <= WS_QA && WS_QA + (size_t)MPAD * 2048 <= WS_QR &&
              WS_QR + (size_t)MPAD * 1024 <= WS_G12 && WS_G12 + (size_t)MPAD * 3072 <= WS_M1 && WS_M1 + (size_t)MPAD * 4096 <= WS_MG && WS_MG + (size_t)MPAD * 2048 <= WS_END, "d_ws map");
constexpr int CW_QPROMPT = 1024, CW_QDEC = 1088;
constexpr int DSPLIT = 4;
#ifndef ND_FIRST
#define ND_FIRST 64
#endif
constexpr int CW_BAR = 4096;
constexpr int RING_OFF = 0, RING_BYTES = 131072;
constexpr int LDSCTL_OFF = RING_BYTES, MISC_OFF = LDSCTL_OFF + 320;
constexpr int LDS_BYTES = 147456;
constexpr int NWAVES = 8;

#define LDS_WAIT() asm volatile("s_waitcnt lgkmcnt(0)" ::: "memory")
#define VM_WAIT() asm volatile("s_waitcnt vmcnt(0)" ::: "memory")
#define SBAR() __builtin_amdgcn_sched_barrier(0)
__device__ __forceinline__ unsigned cvtpk(float lo, float hi) { unsigned r; asm("v_cvt_pk_bf16_f32 %0, %1, %2" : "=v"(r) : "v"(lo), "v"(hi)); return r; }
__device__ __forceinline__ float bflo(unsigned w) { return __builtin_bit_cast(float, w << 16); }
__device__ __forceinline__ float bfhi(unsigned w) { return __builtin_bit_cast(float, w & 0xffff0000u); }
__device__ __forceinline__ float bf2f(bf16 b) { return __builtin_bit_cast(float, (unsigned)b << 16); }
__device__ __forceinline__ float sigmoidf_(float x) { return __builtin_amdgcn_rcpf(1.f + __builtin_amdgcn_exp2f(-1.4426950408889634f * x)); }
__device__ __forceinline__ float wave_sum(float v) {
#pragma unroll
    for (int o = 1; o < 64; o <<= 1) v += __shfl_xor(v, o);
    return v;
}

namespace pg8 {
#define PG8_LAS __attribute__((address_space(3)))
typedef unsigned short bf16_t;
constexpr int BM = 256, BK = 64, HALF = 128, HTB = HALF * BK * 2  , STAGE_BYTES = 8 * HTB, NXCD = 8, WGM = 8;
__host__ __device__ __forceinline__ int lds_byte(int r, int c) { const int st = (r >> 4) * 2 + (c >> 5), rr = r & 15, cc = c & 31, ob = rr * 64 + cc * 2; return st * 1024 + (ob ^ (((ob >> 9) & 1) << 5)); }
__host__ __device__ __forceinline__ void stage_rc(int b, int& R, int& C) { const int st = b / 1024, sb = b % 1024, swz = sb ^ (((sb >> 9) & 1) << 5); R = (st >> 1) * 16 + swz / 64; C = (st & 1) * 32 + (swz % 64) / 2; }
__host__ __device__ __forceinline__ int perm32(int rho) { const int n = rho >> 4, i = rho & 15; return 8 * (i >> 2) + 4 * n + (i & 3); }
struct Unit { int pm, pn; };
struct Gemm { const bf16_t* A; const bf16_t* Bt; int lda, ldb, K, a_pn_off; };
struct StaticOrder {
    int nM, nN, nwg, G, c;
    __host__ __device__ void init(int M, int N, int G_, int c_) { nM = M / BM; nN = N / BM; nwg = nM * nN; G = G_; c = c_; }
    __host__ __device__ bool next(int i, Unit& u) const {
        const long L = (long)i * G + c; if (L >= nwg) return false;
        int wgid = (int)L; { const int q = nwg / NXCD, r = nwg % NXCD, xcd = wgid % NXCD, off = wgid / NXCD; wgid = (xcd < r ? xcd * (q + 1) : r * (q + 1) + (xcd - r) * q) + off; }
        const int nig = WGM * nN, gid = wgid / nig, fm = gid * WGM, gsz = (nM - fm) < WGM ? (nM - fm) : WGM;
        u.pm = fm + ((wgid % nig) % gsz); u.pn = (wgid % nig) / gsz; return true;
    }
    __device__ __forceinline__ void a_ready(const Unit&) const {}
    __device__ __forceinline__ void done(const Unit&) const {}
};
#define EPI_PACK8(v0, v1) ((u32x4){cvtpk((v0)[0], (v0)[1]), cvtpk((v0)[2], (v0)[3]), cvtpk((v1)[0], (v1)[1]), cvtpk((v1)[2], (v1)[3])})
#define EPI_UNPK_LO(g) ((f32x4){bflo((g).x), bfhi((g).x), bflo((g).y), bfhi((g).y)})
#define EPI_UNPK_HI(g) ((f32x4){bflo((g).z), bfhi((g).z), bflo((g).w), bfhi((g).w)})
struct Epi1 {
    static constexpr bool PERM = true, AFTER_DRAIN = false;
    bf16_t* QLAT; float* QSS; float* KVRAW; bf16_t* SZ; float* U; bf16_t* SGA; bf16_t* SGP;
    __device__ __forceinline__ void operator()(const f32x4 (&acc)[2][2][4][2], const Unit& u, int wr, int wc, int fr, int fq) const {
        const int pn = u.pn, row0 = u.pm * BM + wr * 64 + fr, c0 = wc * 32 + 8 * fq;
        if (pn == 0) {
#pragma unroll
            for (int ai = 0; ai < 2; ++ai)
#pragma unroll
                for (int m = 0; m < 4; ++m) { const size_t row = (size_t)(row0 + ai * HALF + m * 16); float ss = 0.f;
#pragma unroll
                    for (int bj = 0; bj < 2; ++bj) { const f32x4 v0 = acc[ai][bj][m][0], v1 = acc[ai][bj][m][1];
                        ss += (v0[0] * v0[0] + v0[1] * v0[1]) + (v0[2] * v0[2] + v0[3] * v0[3]) + (v1[0] * v1[0] + v1[1] * v1[1]) + (v1[2] * v1[2] + v1[3] * v1[3]);
                        *(u32x4*)(QLAT + row * 256 + bj * HALF + c0) = EPI_PACK8(v0, v1); }
                    ss += __shfl_xor(ss, 16); ss += __shfl_xor(ss, 32);
                    if (fq == 0) QSS[row * 4 + wc] = ss; }
        } else if (pn == 1) {
#pragma unroll
            for (int ai = 0; ai < 2; ++ai)
#pragma unroll
                for (int m = 0; m < 4; ++m) { const size_t row = (size_t)(row0 + ai * HALF + m * 16);
#pragma unroll
                    for (int bj = 0; bj < 2; ++bj) { const int c = bj * HALF + c0;
                        if (c < QKD) { *(f32x4*)(KVRAW + row * QKD + c) = acc[ai][bj][m][0]; *(f32x4*)(KVRAW + row * QKD + c + 4) = acc[ai][bj][m][1]; } } }
        } else if (pn == 6 || pn == 7) {
#pragma unroll
            for (int ai = 0; ai < 2; ++ai)
#pragma unroll
                for (int m = 0; m < 4; ++m) { const size_t row = (size_t)(row0 + ai * HALF + m * 16);
#pragma unroll
                    for (int bj = 0; bj < 2; ++bj) { float* p = U + row * POOLW + (pn - 6) * 256 + bj * HALF + c0;
                        *(f32x4*)p = acc[ai][bj][m][0]; *(f32x4*)(p + 4) = acc[ai][bj][m][1]; } }
        } else {
            bf16_t* dst; int ld; bool sig;
            if (pn < 6) { dst = SZ + (pn - 2) * 256; ld = GW; sig = false; }
            else if (pn < 10) { dst = SZ + ATTW + (pn - 8) * 256; ld = GW; sig = false; }
            else if (pn < 14) { dst = SGA + (pn - 10) * 256; ld = DM; sig = true; }
            else { dst = SGP + (pn - 14) * 256; ld = DM; sig = true; }
#pragma unroll
            for (int ai = 0; ai < 2; ++ai)
#pragma unroll
                for (int m = 0; m < 4; ++m) { const size_t row = (size_t)(row0 + ai * HALF + m * 16);
#pragma unroll
                    for (int bj = 0; bj < 2; ++bj) { f32x4 v0 = acc[ai][bj][m][0], v1 = acc[ai][bj][m][1];
#pragma unroll
                        for (int e = 0; e < 4; ++e) { const float s0 = sigmoidf_(v0[e]), s1 = sigmoidf_(v1[e]); v0[e] = sig ? s0 : v0[e] * s0; v1[e] = sig ? s1 : v1[e] * s1; }
                        *(u32x4*)(dst + row * ld + bj * HALF + c0) = EPI_PACK8(v0, v1); } }
        }
    }
};
struct Epi2 {
    static constexpr bool PERM = true, AFTER_DRAIN = false;
    bf16_t* QA; bf16_t* QR; const float* QSS; const float* ROPET;
    __device__ __forceinline__ void operator()(const f32x4 (&acc)[2][2][4][2], const Unit& u, int wr, int wc, int fr, int fq) const {
        const int pn = u.pn, row0 = u.pm * BM + wr * 64 + fr, c0 = wc * 32 + 8 * fq;
#pragma unroll
        for (int ai = 0; ai < 2; ++ai)
#pragma unroll
            for (int m = 0; m < 4; ++m) { const size_t row = (size_t)(row0 + ai * HALF + m * 16);
                const f32x4 q4 = *(const f32x4*)(QSS + row * 4);
                const float s = C2 * __builtin_amdgcn_rsqf(((q4[0] + q4[1]) + (q4[2] + q4[3])) * (1.f / QRANK) + EPS);
                if (pn < 4) {
#pragma unroll
                    for (int bj = 0; bj < 2; ++bj) { const f32x4 v0 = acc[ai][bj][m][0] * s, v1 = acc[ai][bj][m][1] * s;
                        *(u32x4*)(QA + row * ATTW + pn * 256 + bj * HALF + c0) = EPI_PACK8(v0, v1); }
                } else {
                    const int pos = row < SEQ ? (int)row : SEQ;
                    const float* rp = ROPET + ((size_t)pos * 32 + 8 * fq) * 2;
                    bf16_t* q = QR + row * (NH * ROPE) + (4 * (pn - 4) + wc) * ROPE + 8 * fq;
#pragma unroll
                    for (int n = 0; n < 2; ++n) {
                        const f32x4 t0 = *(const f32x4*)(rp + 8 * n), t1 = *(const f32x4*)(rp + 8 * n + 4);
                        const f32x4 a = acc[ai][0][m][n], b = acc[ai][1][m][n];
                        u32x2 lo, hi2;
                        lo.x = cvtpk((a[0] * t0[0] - b[0] * t0[1]) * s, (a[1] * t0[2] - b[1] * t0[3]) * s); lo.y = cvtpk((a[2] * t1[0] - b[2] * t1[1]) * s, (a[3] * t1[2] - b[3] * t1[3]) * s);
                        hi2.x = cvtpk((b[0] * t0[0] + a[0] * t0[1]) * s, (b[1] * t0[2] + a[1] * t0[3]) * s); hi2.y = cvtpk((b[2] * t1[0] + a[2] * t1[1]) * s, (b[3] * t1[2] + a[3] * t1[3]) * s);
                        *(u32x2*)(q + 4 * n) = lo; *(u32x2*)(q + 32 + 4 * n) = hi2; }
                }
                if (m & 1) __builtin_amdgcn_sched_barrier(0);
            }
    }
};
struct Epi5 {
    static constexpr bool PERM = true, AFTER_DRAIN = false;
    bf16_t* G12; const bf16_t* SZ; const float* pool_scale;
    __device__ __forceinline__ void operator()(const f32x4 (&acc)[2][2][4][2], const Unit& u, int wr, int wc, int fr, int fq) const {
        const int pn = u.pn, row0 = u.pm * BM + wr * 64 + fr, c0 = wc * 32 + 8 * fq;
#pragma unroll
        for (int bj = 0; bj < 2; ++bj) { const int c = pn * 256 + bj * HALF + c0;
            f32x4 p0 = {1.f, 1.f, 1.f, 1.f}, p1 = p0;
            if (pn >= 4) { p0 = *(const f32x4*)(pool_scale + c - ATTW); p1 = *(const f32x4*)(pool_scale + c - ATTW + 4); }
#pragma unroll
            for (int ai = 0; ai < 2; ++ai)
#pragma unroll
                for (int m = 0; m < 4; ++m) { const size_t row = (size_t)(row0 + ai * HALF + m * 16);
                    const u32x4 g = *(const u32x4*)(SZ + row * GW + c);
                    const f32x4 v0 = acc[ai][bj][m][0] * p0 * EPI_UNPK_LO(g), v1 = acc[ai][bj][m][1] * p1 * EPI_UNPK_HI(g);
                    *(u32x4*)(G12 + row * GW + c) = EPI_PACK8(v0, v1); } }
    }
};
template <bool SECOND> struct Epi6 {
    static constexpr bool PERM = true, AFTER_DRAIN = false;
    float* M1; bf16_t* MG; const bf16_t* SG;
    __device__ __forceinline__ void operator()(const f32x4 (&acc)[2][2][4][2], const Unit& u, int wr, int wc, int fr, int fq) const {
        const int pn = u.pn, row0 = u.pm * BM + wr * 64 + fr, c0 = wc * 32 + 8 * fq;
#pragma unroll
        for (int ai = 0; ai < 2; ++ai)
#pragma unroll
            for (int m = 0; m < 4; ++m) { const size_t row = (size_t)(row0 + ai * HALF + m * 16);
#pragma unroll
                for (int bj = 0; bj < 2; ++bj) { const size_t o = row * DM + pn * 256 + bj * HALF + c0;
                    const u32x4 g = *(const u32x4*)(SG + o);
                    f32x4 v0 = acc[ai][bj][m][0] * EPI_UNPK_LO(g), v1 = acc[ai][bj][m][1] * EPI_UNPK_HI(g);
                    if (!SECOND) { *(f32x4*)(M1 + o) = v0; *(f32x4*)(M1 + o + 4) = v1; }
                    else { v0 += *(const f32x4*)(M1 + o); v1 += *(const f32x4*)(M1 + o + 4); *(u32x4*)(MG + o) = EPI_PACK8(v0, v1); } } }
    }
};
struct Epi7 {
    static constexpr bool PERM = true, AFTER_DRAIN = false;
    const float* xp; const float* xs; float* out;
    __device__ __forceinline__ void operator()(const f32x4 (&acc)[2][2][4][2], const Unit& u, int wr, int wc, int fr, int fq) const {
        const int pn = u.pn, row0 = u.pm * BM + wr * 64 + fr, c0 = wc * 32 + 8 * fq;
#pragma unroll
        for (int ai = 0; ai < 2; ++ai)
#pragma unroll
            for (int m = 0; m < 4; ++m) { const int row = row0 + ai * HALF + m * 16;
                if (row < MTOT) {
                    const float* x = row < SEQ ? xp + (size_t)row * DM : xs + (size_t)(row - SEQ) * DM;
                    float* y = row < SEQ ? out + O_YP + (size_t)row * DM : out + O_YS + (size_t)(row - SEQ) * DM;
#pragma unroll
                    for (int bj = 0; bj < 2; ++bj) { const int c = pn * 256 + bj * HALF + c0;
                        *(f32x4*)(y + c) = *(const f32x4*)(x + c) + acc[ai][bj][m][0]; *(f32x4*)(y + c + 4) = *(const f32x4*)(x + c + 4) + acc[ai][bj][m][1]; } } }
    }
};
template <class Epi, class Sched, bool ALIGN_EPI = false, bool SP2 = false>
__device__ __forceinline__ void gemm_phase(PG8_LAS unsigned char* lds, const Gemm g, const Sched& S, const Epi& E) {
    int tid_ = threadIdx.x; asm volatile("" : "+v"(tid_));
    const int tid = tid_, wid = __builtin_amdgcn_readfirstlane(tid >> 6), lane = tid & 63, wr = wid >> 2, wc = wid & 3, fr = lane & 15, fq = lane >> 4;
    const int K = g.K, nt = K / BK;
    unsigned voffA[2], voffB[2];
#pragma unroll
    for (int i = 0; i < 2; ++i) { int R, C; stage_rc(tid * 16 + i * 8192, R, C); const int Rb = Epi::PERM ? ((R & ~31) + perm32(R & 31)) : R;
        voffA[i] = (unsigned)(R * g.lda + C) * 2u; voffB[i] = (unsigned)(Rb * g.ldb + C) * 2u; }
    const size_t kstep = (size_t)(BK * 2);
    const size_t hA = (size_t)HALF * g.lda * 2, hB = (size_t)HALF * g.ldb * 2;
    const size_t tA = 2 * hA, tB = 2 * hB, pA = (size_t)g.a_pn_off * 2;
    const unsigned ldsw = (unsigned)wid * 1024u;
    const int aoff = lds_byte(wr * 64 + fr, fq * 8), boff = lds_byte(wc * 32 + fr, fq * 8);
#define PG8_SA(b, h) (((b) * 2 + (h)) * HTB)
#define PG8_SB(b, h) ((4 + (b) * 2 + (h)) * HTB)
#define PG8_STAGE(bufoff, gbase, voff) do { _Pragma("unroll") for (int _i = 0; _i < 2; ++_i) \
        __builtin_amdgcn_global_load_lds((const unsigned*)((const char*)(gbase) + (voff)[_i]), (PG8_LAS unsigned*)(lds + (bufoff) + ldsw + _i * 8192), 16, 0, 0); } while (0)
#define PG8_LDA(dst, b, h) do { _Pragma("unroll") for (int m = 0; m < 4; ++m) _Pragma("unroll") for (int k = 0; k < 2; ++k) dst[m][k] = *(const PG8_LAS bf16x8*)(lds + PG8_SA(b, h) + aoff + m * 2048 + k * 1024); } while (0)
#define PG8_LDB(dst, b, h) do { _Pragma("unroll") for (int n = 0; n < 2; ++n) _Pragma("unroll") for (int k = 0; k < 2; ++k) dst[n][k] = *(const PG8_LAS bf16x8*)(lds + PG8_SB(b, h) + boff + n * 2048 + k * 1024); } while (0)
#define PG8_MMA(ai, bj, At, Bt) do { __builtin_amdgcn_s_setprio(1); _Pragma("unroll") for (int m = 0; m < 4; ++m) _Pragma("unroll") for (int n = 0; n < 2; ++n) _Pragma("unroll") for (int k = 0; k < 2; ++k) \
        acc[ai][bj][m][n] = __builtin_amdgcn_mfma_f32_16x16x32_bf16(Bt[n][k], At[m][k], acc[ai][bj][m][n], 0, 0, 0); __builtin_amdgcn_s_setprio(0); } while (0)
#define PG8_WAIT_V(n) asm volatile("s_waitcnt vmcnt(" #n ")" ::: "memory")
#define PG8_WAIT_L(n) asm volatile("s_waitcnt lgkmcnt(" #n ")" ::: "memory")
#define PG8_BAR __builtin_amdgcn_s_barrier()
#define PG8_SCHED __builtin_amdgcn_sched_barrier(0)
    Unit cur, nxt; int ui = 0;
    if (!S.next(0, cur)) return;
    f32x4 acc[2][2][4][2];
#pragma unroll
    for (int a = 0; a < 2; ++a)
#pragma unroll
        for (int b = 0; b < 2; ++b)
#pragma unroll
            for (int m = 0; m < 4; ++m)
#pragma unroll
                for (int n = 0; n < 2; ++n) acc[a][b][m][n] = (f32x4){0.f, 0.f, 0.f, 0.f};
    bf16x8 At[4][2], B0[2][2], B1[2][2];
    const char* cA = (const char*)g.A + (size_t)cur.pm * tA + (size_t)cur.pn * pA; const char* cB = (const char*)g.Bt + (size_t)cur.pn * tB;
    S.a_ready(cur);
    if constexpr (SP2) {
        PG8_STAGE(PG8_SB(0, 0), cB, voffB); PG8_STAGE(PG8_SB(0, 1), cB + hB, voffB); PG8_STAGE(PG8_SA(0, 0), cA, voffA); PG8_STAGE(PG8_SA(0, 1), cA + hA, voffA);
        if (wr == 1) PG8_BAR;
        PG8_WAIT_V(2); PG8_BAR;
        PG8_STAGE(PG8_SB(1, 0), cB + kstep, voffB); PG8_STAGE(PG8_SA(1, 0), cA + kstep, voffA); PG8_STAGE(PG8_SB(1, 1), cB + hB + kstep, voffB);
        PG8_WAIT_V(6); PG8_BAR;
    } else {
        PG8_STAGE(PG8_SB(0, 0), cB, voffB); PG8_STAGE(PG8_SA(0, 0), cA, voffA); PG8_STAGE(PG8_SB(0, 1), cB + hB, voffB); PG8_STAGE(PG8_SA(0, 1), cA + hA, voffA);
        if (wr == 1) PG8_BAR;
        PG8_WAIT_V(4); PG8_BAR;
        PG8_STAGE(PG8_SB(1, 0), cB + kstep, voffB); PG8_STAGE(PG8_SA(1, 0), cA + kstep, voffA); PG8_STAGE(PG8_SB(1, 1), cB + hB + kstep, voffB);
        PG8_WAIT_V(6); PG8_BAR;
    }
    for (;;) {
        const bool has_next = S.next(ui + 1, nxt);
        const char* nA = has_next ? (const char*)g.A + (size_t)nxt.pm * tA + (size_t)nxt.pn * pA : cA; const char* nB = has_next ? (const char*)g.Bt + (size_t)nxt.pn * tB : cB;
        for (int t = 0; t < nt; t += 2) {
            const bool last = (t == nt - 2);
            const char* a1 = cA + (size_t)(t + 1) * kstep;
            const char* a2 = last ? nA : cA + (size_t)(t + 2) * kstep; const char* b2 = last ? nB : cB + (size_t)(t + 2) * kstep;
            const char* a3 = a2 + kstep; const char* b3 = b2 + kstep;
            if (last && has_next) S.a_ready(nxt);
            if constexpr (SP2) {
            PG8_LDB(B0, 0, 0); PG8_LDB(B1, 0, 1); PG8_SCHED; PG8_LDA(At, 0, 0); PG8_STAGE(PG8_SA(1, 1), a1 + hA, voffA);
            PG8_WAIT_V(8); PG8_WAIT_L(0); PG8_BAR; PG8_MMA(0, 0, At, B0); PG8_MMA(0, 1, At, B1); PG8_BAR; PG8_SCHED;
            PG8_LDA(At, 0, 1); PG8_STAGE(PG8_SB(0, 0), b2, voffB); PG8_STAGE(PG8_SB(0, 1), b2 + hB, voffB); PG8_STAGE(PG8_SA(0, 0), a2, voffA);
            PG8_WAIT_V(8); PG8_WAIT_L(0); PG8_BAR; PG8_MMA(1, 0, At, B0); PG8_MMA(1, 1, At, B1); PG8_BAR; PG8_SCHED;
            PG8_LDB(B0, 1, 0); PG8_LDB(B1, 1, 1); PG8_SCHED; PG8_LDA(At, 1, 0); PG8_STAGE(PG8_SA(0, 1), a2 + hA, voffA);
            PG8_WAIT_V(8); PG8_WAIT_L(0); PG8_BAR; PG8_MMA(0, 0, At, B0); PG8_MMA(0, 1, At, B1); PG8_BAR; PG8_SCHED;
            PG8_LDA(At, 1, 1); PG8_STAGE(PG8_SB(1, 0), b3, voffB); PG8_STAGE(PG8_SB(1, 1), b3 + hB, voffB); PG8_STAGE(PG8_SA(1, 0), a3, voffA);
            PG8_WAIT_V(8); PG8_WAIT_L(0); PG8_BAR; PG8_MMA(1, 0, At, B0); PG8_MMA(1, 1, At, B1); PG8_BAR; PG8_SCHED;
            } else {
            PG8_LDB(B0, 0, 0); PG8_SCHED; PG8_LDA(At, 0, 0); PG8_STAGE(PG8_SA(1, 1), a1 + hA, voffA);
            PG8_WAIT_L(8); PG8_BAR; PG8_WAIT_L(0); PG8_MMA(0, 0, At, B0); PG8_BAR; PG8_SCHED;
            PG8_LDB(B1, 0, 1); PG8_STAGE(PG8_SB(0, 0), b2, voffB);
            PG8_BAR; PG8_WAIT_L(0); PG8_MMA(0, 1, At, B1); PG8_BAR;
            PG8_LDA(At, 0, 1); PG8_STAGE(PG8_SA(0, 0), a2, voffA);
            PG8_BAR; PG8_WAIT_L(0); PG8_MMA(1, 0, At, B0); PG8_BAR; PG8_SCHED;
            PG8_STAGE(PG8_SB(0, 1), b2 + hB, voffB);
            PG8_WAIT_V(6); PG8_BAR; PG8_MMA(1, 1, At, B1); PG8_BAR;
            PG8_LDB(B0, 1, 0); PG8_SCHED; PG8_LDA(At, 1, 0); PG8_STAGE(PG8_SA(0, 1), a2 + hA, voffA);
            PG8_WAIT_L(8); PG8_BAR; PG8_WAIT_L(0); PG8_MMA(0, 0, At, B0); PG8_BAR; PG8_SCHED;
            PG8_LDB(B1, 1, 1); PG8_STAGE(PG8_SB(1, 0), b3, voffB);
            PG8_BAR; PG8_WAIT_L(0); PG8_MMA(0, 1, At, B1); PG8_BAR;
            PG8_LDA(At, 1, 1); PG8_STAGE(PG8_SA(1, 0), a3, voffA);
            PG8_BAR; PG8_WAIT_L(0); PG8_MMA(1, 0, At, B0); PG8_BAR; PG8_SCHED;
            PG8_STAGE(PG8_SB(1, 1), b3 + hB, voffB);
            PG8_WAIT_V(6); PG8_BAR; PG8_MMA(1, 1, At, B1); PG8_BAR;
            }
        }
        if constexpr (ALIGN_EPI) { if (wr == 0) PG8_BAR; }
        if constexpr (!Epi::AFTER_DRAIN) { int l_; asm volatile("v_mbcnt_lo_u32_b32 %0, -1, 0\n\tv_mbcnt_hi_u32_b32 %0, -1, %0" : "=v"(l_));
            E(acc, cur, wr, wc, l_ & 15, l_ >> 4); S.done(cur); }
        if (!has_next) break;
#pragma unroll
        for (int a = 0; a < 2; ++a)
#pragma unroll
            for (int b = 0; b < 2; ++b)
#pragma unroll
                for (int m = 0; m < 4; ++m)
#pragma unroll
                    for (int n = 0; n < 2; ++n) acc[a][b][m][n] = (f32x4){0.f, 0.f, 0.f, 0.f};
        cur = nxt; cA = nA; cB = nB; ++ui;
        if constexpr (ALIGN_EPI) { if (wr == 1) PG8_BAR; }
    }
    PG8_WAIT_V(0);
    if constexpr (!ALIGN_EPI) { if (wr == 0) PG8_BAR; }
    PG8_BAR;
    if constexpr (Epi::AFTER_DRAIN) { E.fused(acc, cur, wr, wc, fr, fq, lds, wid, lane); S.done(cur); }
#undef PG8_SA
#undef PG8_SB
#undef PG8_STAGE
#undef PG8_LDA
#undef PG8_LDB
#undef PG8_MMA
#undef PG8_WAIT_V
#undef PG8_WAIT_L
#undef PG8_BAR
#undef PG8_SCHED
}
}
namespace att {
constexpr int SHM_K = 64 * 384, SHM_V = 64 * 256;
constexpr int L_V = 0, L_K = 2 * SHM_V, L_WS = L_K + 2 * SHM_K, L_QR = L_WS + NWAVES * 256, LDS_NEED = L_QR + NWAVES * 4096;
constexpr int DROW = 400, DIMG = 32 * DROW;
static_assert(LDS_NEED <= RING_BYTES && NWAVES * DIMG + 12 * 17 * 16 <= RING_BYTES, "attention LDS");
constexpr float THR2 = 8.f * 1.4426950408889634f;
__device__ __forceinline__ int crow(int r, int hi) { return (r & 3) + 8 * (r >> 2) + 4 * hi; }
__device__ __forceinline__ int v_st(int k, int c) { const int kk = (k & ~0xC) | ((k & 4) << 1) | ((k & 8) >> 1); return ((kk >> 3) * 4 + (c >> 5)) * 512 + ((kk & 7) * 32 + (c & 31)) * 2; }
__device__ __forceinline__ int v_rd_base(int lane) { return ((lane & 3) << 3) | (((lane >> 2) & 3) << 6) | (((lane >> 4) & 1) << 5) | (((lane >> 5) & 1) << 8); }
constexpr int v_rd_off(int d0, int ks, int half) { return d0 * 512 + ks * 4096 + half * 2048; }
__device__ __forceinline__ float pl_swap_max(float v) { auto rr = __builtin_amdgcn_permlane32_swap(__float_as_uint(v), __float_as_uint(v), false, false); return fmaxf(__uint_as_float(rr[0]), __uint_as_float(rr[1])); }
__device__ __forceinline__ float pl_swap_add(float v) { auto rr = __builtin_amdgcn_permlane32_swap(__float_as_uint(v), __float_as_uint(v), false, false); return __uint_as_float(rr[0]) + __uint_as_float(rr[1]); }
#define ATT_PK4(P, B_, OUT) do { unsigned a0 = cvtpk(P[B_+0], P[B_+1]), a1 = cvtpk(P[B_+2], P[B_+3]);                          \
        unsigned b0 = cvtpk(P[B_+4], P[B_+5]), b1 = cvtpk(P[B_+6], P[B_+7]);                                             \
        auto r0 = __builtin_amdgcn_permlane32_swap(a0, b0, false, false); auto r1 = __builtin_amdgcn_permlane32_swap(a1, b1, false, false); \
        u32x4 w = {r0[0], r1[0], r0[1], r1[1]}; OUT = __builtin_bit_cast(bf16x8, w); } while (0)
#define ATT_TRRD(dst, addr, off) asm volatile("ds_read_b64_tr_b16 %0, %1 offset:%2" : "=&v"(dst) : "v"(addr), "i"(off) : "memory")
#define ATT_PK(L, H) ((bf16x8){L[0], L[1], L[2], L[3], H[0], H[1], H[2], H[3]})

__device__ __forceinline__ void mask_tile(f32x16& p0, f32x16& p1, int dq) {
    const float NEG = -__builtin_inff();
#pragma unroll
    for (int r = 0; r < 16; ++r) { const int c = (r & 3) + 8 * (r >> 2);
        if (dq - c < 0) p0[r] = NEG;
        if (dq - c - 32 < 0) p1[r] = NEG; }
}
__device__ __forceinline__ void partialSM(f32x16& p0, f32x16& p1, float& m_reg, float& alpha) {
    float pmax = p0[0];
#pragma unroll
    for (int r = 1; r < 16; ++r) pmax = fmaxf(pmax, p0[r]);
#pragma unroll
    for (int r = 0; r < 16; ++r) pmax = fmaxf(pmax, p1[r]);
    pmax = pl_swap_max(pmax);
    float mn;
    if (__builtin_expect(__all(pmax - m_reg <= THR2), 1)) { mn = m_reg; alpha = 1.f; }
    else { mn = fmaxf(m_reg, pmax); alpha = __builtin_amdgcn_exp2f(m_reg - mn); m_reg = mn; }
#pragma unroll
    for (int r = 0; r < 16; ++r) p0[r] = __builtin_amdgcn_exp2f(p0[r] - mn);
#pragma unroll
    for (int r = 0; r < 16; ++r) p1[r] = p1[r] - mn;
}
__device__ __forceinline__ void finishSM(f32x16& p0, f32x16& p1, float alpha, float& l_reg, bf16x8& pa0, bf16x8& pa1, bf16x8& pa2, bf16x8& pa3) {
#pragma unroll
    for (int r = 0; r < 16; ++r) p1[r] = __builtin_amdgcn_exp2f(p1[r]);
    float ps = 0.f;
#pragma unroll
    for (int r = 0; r < 16; ++r) ps += p0[r];
#pragma unroll
    for (int r = 0; r < 16; ++r) ps += p1[r];
    ps = pl_swap_add(ps);
    l_reg = l_reg * alpha + ps;
    ATT_PK4(p0, 0, pa0); ATT_PK4(p0, 8, pa1); ATT_PK4(p1, 0, pa2); ATT_PK4(p1, 8, pa3);
}
template <int KB>
__device__ __forceinline__ void qkt(f32x16& p0, f32x16& p1, const LAS unsigned char* lds, int r32, int hi, const bf16x8* qr, const LAS unsigned char* qlds) {
    p0 = f32x16{}; p1 = f32x16{};
    const int sw = ((r32 >> 1) & 7) << 4;
    const LAS unsigned char* kb[4];
#pragma unroll
    for (int dd = 0; dd < 4; ++dd) kb[dd] = lds + L_K + KB * SHM_K + r32 * 384 + ((dd * 32 + hi * 16) ^ sw);
#pragma unroll
    for (int d0 = 0; d0 < 12; ++d0) { const LAS unsigned char* a = kb[d0 & 3] + (d0 >> 2) * 128;
        const bf16x8 b0 = *(const LAS bf16x8*)a, b1 = *(const LAS bf16x8*)(a + 32 * 384);
        const bf16x8 qf = d0 < 8 ? qr[d0 & 7] : *(const LAS bf16x8*)(qlds + (d0 - 8) * 1024);
        p0 = __builtin_amdgcn_mfma_f32_32x32x16_bf16(b0, qf, p0, 0, 0, 0);
        p1 = __builtin_amdgcn_mfma_f32_32x32x16_bf16(b1, qf, p1, 0, 0, 0); }
}
template <int VB>
__device__ __forceinline__ void pv_tile(f32x16* o, int vb0, bf16x8 pa0, bf16x8 pa1, bf16x8 pa2, bf16x8 pa3) {
#define ATT_PV_D0(d0) do { s16x4 l0, l1, l2, l3, h0, h1, h2, h3; constexpr int b_ = L_V + VB * SHM_V + v_rd_off(d0, 0, 0); \
        ATT_TRRD(l0, vb0, b_); ATT_TRRD(h0, vb0, b_ + 2048); ATT_TRRD(l1, vb0, b_ + 4096); ATT_TRRD(h1, vb0, b_ + 6144); ATT_TRRD(l2, vb0, b_ + 8192); ATT_TRRD(h2, vb0, b_ + 10240); ATT_TRRD(l3, vb0, b_ + 12288); ATT_TRRD(h3, vb0, b_ + 14336); \
        asm volatile("s_waitcnt lgkmcnt(0)" ::: "memory"); SBAR(); \
        o[d0] = __builtin_amdgcn_mfma_f32_32x32x16_bf16(pa0, ATT_PK(l0, h0), o[d0], 0, 0, 0); \
        o[d0] = __builtin_amdgcn_mfma_f32_32x32x16_bf16(pa1, ATT_PK(l1, h1), o[d0], 0, 0, 0); \
        o[d0] = __builtin_amdgcn_mfma_f32_32x32x16_bf16(pa2, ATT_PK(l2, h2), o[d0], 0, 0, 0); \
        o[d0] = __builtin_amdgcn_mfma_f32_32x32x16_bf16(pa3, ATT_PK(l3, h3), o[d0], 0, 0, 0); } while (0)
    ATT_PV_D0(0); ATT_PV_D0(1); ATT_PV_D0(2); ATT_PV_D0(3);
#undef ATT_PV_D0
}

__device__ __forceinline__ void prompt_unit(int q0, const bf16* __restrict__ QA, const bf16* __restrict__ QR, const bf16* __restrict__ KBm, bf16* __restrict__ OL, LAS unsigned char* lds, int tid, int wid, int lane) {
    const int r32 = lane & 31, hi = lane >> 5;
    const int NT = (q0 >> 6) + 1;
    bf16x8 qr[8];
    LAS unsigned char* qlds = lds + L_QR + wid * 4096 + lane * 16;
    { const bf16* qa = QA + (size_t)(q0 + r32) * ATTW + wid * NOPE + hi * 8; const bf16* qq = QR + (size_t)(q0 + r32) * (NH * ROPE) + wid * ROPE + hi * 8;
#pragma unroll
      for (int d0 = 0; d0 < 8; ++d0) qr[d0] = *(const bf16x8*)(qa + d0 * 16);
#pragma unroll
      for (int d0 = 0; d0 < 4; ++d0) *(LAS bf16x8*)(qlds + d0 * 1024) = *(const bf16x8*)(qq + d0 * 16); }
    LAS float* wsf = (LAS float*)(lds + L_WS) + wid * 64; LAS float* li_l = wsf; LAS float* al_l = wsf + 32;
    float m_reg = -1e30f, l_reg = 0.f; f32x16 o[4] = {};
    const int skey = tid >> 3, sc8 = tid & 7;
    const int kw0 = skey * 384 + ((sc8 * 16) ^ (((skey >> 1) & 7) << 4));
    const int vw0 = v_st(skey, sc8 * 8);
    const int vb0 = (int)(uintptr_t)lds + v_rd_base(lane);
    const int qm = q0 + r32 - 4 * hi;
    const bf16* ksrc = KBm + (size_t)skey * QKD + sc8 * 8;
    bf16x8 st0, st1, st2;
#define ATT_SLOAD(t) do { const bf16* p_ = ksrc + (size_t)(t) * (64 * QKD); st0 = *(const bf16x8*)p_; st1 = *(const bf16x8*)(p_ + 64); st2 = *(const bf16x8*)(p_ + 128); } while (0)
#define ATT_SWRITE(bf) do { LAS unsigned char* k_ = lds + L_K + (bf) * SHM_K + kw0; *(LAS bf16x8*)k_ = st0; *(LAS bf16x8*)(k_ + 128) = st1; *(LAS bf16x8*)(k_ + 256) = st2; \
        LAS unsigned char* v_ = lds + L_V + (bf) * SHM_V + vw0; *(LAS bf16x8*)v_ = st0; *(LAS bf16x8*)(v_ + 1024) = st1; } while (0)
#define ATT_RESC(a) do { if (__any((a) < 1.f)) { if (hi == 0) al_l[r32] = (a); LDS_WAIT(); \
        _Pragma("unroll") for (int d_ = 0; d_ < 4; ++d_) _Pragma("unroll") for (int r = 0; r < 16; ++r) o[d_][r] *= al_l[crow(r, hi)]; } } while (0)
#define ATT_MASKT(P0_, P1_, t) do { if ((t) == NT - 1) mask_tile(P0_, P1_, qm - 64 * (t)); } while (0)
    f32x16 pA0, pA1, pB0, pB1; float alA, alB; bf16x8 pa0, pa1, pa2, pa3;
    ATT_SLOAD(0); VM_WAIT(); ATT_SWRITE(0); SBAR();
    if (NT > 1) ATT_SLOAD(1);
    __syncthreads();
    SBAR(); qkt<0>(pA0, pA1, lds, r32, hi, qr, qlds);
    ATT_MASKT(pA0, pA1, 0); partialSM(pA0, pA1, m_reg, alA);
    if (NT > 1) { VM_WAIT(); ATT_SWRITE(1); }
    __syncthreads();
#define ATT_HALF_STEP(PX0, PX1, alX, PY0, PY1, alY, t, KB, VB, SB) do {                                          \
        SBAR(); qkt<KB>(PX0, PX1, lds, r32, hi, qr, qlds);                                                         \
        finishSM(PY0, PY1, alY, l_reg, pa0, pa1, pa2, pa3); SBAR();                                              \
        if ((t) + 1 < NT) { ATT_SLOAD((t) + 1); SBAR(); }                                                        \
        pv_tile<VB>(o, vb0, pa0, pa1, pa2, pa3); ATT_MASKT(PX0, PX1, (t)); partialSM(PX0, PX1, m_reg, alX);      \
        __syncthreads();                                                                                         \
        if ((t) + 1 < NT) { VM_WAIT(); ATT_SWRITE(SB); }                                                         \
        ATT_RESC(alX); __syncthreads(); } while (0)
    for (int t = 1; t + 1 < NT; t += 2) {
        ATT_HALF_STEP(pB0, pB1, alB, pA0, pA1, alA, t, 1, 0, 0);
        ATT_HALF_STEP(pA0, pA1, alA, pB0, pB1, alB, t + 1, 0, 1, 1);
    }
    const bool even = (NT & 1) == 0;
    if (even) { SBAR(); qkt<1>(pB0, pB1, lds, r32, hi, qr, qlds); SBAR(); }
    finishSM(pA0, pA1, alA, l_reg, pa0, pa1, pa2, pa3); SBAR();
    pv_tile<0>(o, vb0, pa0, pa1, pa2, pa3);
    if (even) { ATT_MASKT(pB0, pB1, NT - 1); partialSM(pB0, pB1, m_reg, alB); ATT_RESC(alB);
        finishSM(pB0, pB1, alB, l_reg, pa0, pa1, pa2, pa3); SBAR(); pv_tile<1>(o, vb0, pa0, pa1, pa2, pa3); }
    if (hi == 0) li_l[r32] = l_reg; LDS_WAIT();
    float rli[16];
#pragma unroll
    for (int r = 0; r < 16; ++r) rli[r] = __builtin_amdgcn_rcpf(li_l[crow(r, hi)]);
    bf16* Ow = OL + (size_t)q0 * GW + wid * VD;
#pragma unroll
    for (int r = 0; r < 16; ++r) { const int orow = crow(r, hi);
#pragma unroll
        for (int d0 = 0; d0 < 4; ++d0) { const float v = o[d0][r] * rli[r]; const float vn = __shfl_xor(v, 1);
            if ((r32 & 1) == 0) *(unsigned*)(Ow + (size_t)orow * GW + d0 * 32 + r32) = cvtpk(v, vn); } }
    __syncthreads();
#undef ATT_SLOAD
#undef ATT_SWRITE
#undef ATT_RESC
#undef ATT_MASKT
#undef ATT_HALF_STEP
}

__device__ __forceinline__ void decode_item(int item, const float* __restrict__ cckv, const float* __restrict__ ckr, const int* __restrict__ ptab, const bf16* __restrict__ QA, const bf16* __restrict__ QR,
                                            float* __restrict__ DPART, LAS unsigned char* lds, int tid, int wid, int lane) {
    constexpr int PPI = NPG / DSPLIT, NSTEP = 4 * PPI / NWAVES;
    const int b = item / DSPLIT, part = item % DSPLIT, r32 = lane & 31, hi = lane >> 5;
    constexpr int QOFF = NWAVES * DIMG, QSTR = 17 * 16;
    if (wid == 0) { const size_t qrow = (size_t)(SEQ + b);
        if (r32 < 8) { const bf16* qa = QA + qrow * ATTW + r32 * NOPE + hi * 8; const bf16* qq = QR + qrow * (NH * ROPE) + r32 * ROPE + hi * 8; LAS unsigned char* d = lds + QOFF + (hi * 8 + r32) * 16;
#pragma unroll
            for (int d0 = 0; d0 < 8; ++d0) *(LAS bf16x8*)(d + d0 * QSTR) = *(const bf16x8*)(qa + d0 * 16);
#pragma unroll
            for (int d0 = 0; d0 < 4; ++d0) *(LAS bf16x8*)(d + (8 + d0) * QSTR) = *(const bf16x8*)(qq + d0 * 16); }
        else if (lane == 8) { const bf16x8 z = {0, 0, 0, 0, 0, 0, 0, 0};
#pragma unroll
            for (int d0 = 0; d0 < 12; ++d0) *(LAS bf16x8*)(lds + QOFF + 256 + d0 * QSTR) = z; } }
    __syncthreads();
    const LAS unsigned char* qsl = lds + QOFF + (r32 < 8 ? (hi * 8 + r32) * 16 : 256);
    LAS unsigned char* img = lds + wid * DIMG;
    const int kaddr = r32 * DROW + 16 * hi;
    const int vaddr = (int)(uintptr_t)img + (8 * (lane >> 5) + ((lane >> 2) & 3)) * DROW + (16 * ((lane >> 4) & 1) + 4 * (lane & 3)) * 2;
    const int woA = (lane >> 5) * DROW + (lane & 31) * 8, woB = (lane >> 4) * DROW + 256 + (lane & 15) * 8;
    float m_reg = -1e30f, l_reg = 0.f; f32x16 o[4] = {};
    f32x4 sa[16], sb[8];
#define DEC_LOAD(s_) do { const int pg_ = PPI * part + wid + 8 * ((s_) >> 2); const int phys_ = __builtin_amdgcn_readfirstlane(ptab[b * NPG + pg_]); \
        const float* pc_ = cckv + (size_t)phys_ * (PAGE * KVR) + ((s_) & 3) * (32 * KVR) + lane * 4; const float* pk_ = ckr + (size_t)phys_ * (PAGE * ROPE) + ((s_) & 3) * (32 * ROPE) + lane * 4; \
        _Pragma("unroll") for (int i = 0; i < 16; ++i) sa[i] = __builtin_nontemporal_load((const f32x4*)(pc_ + i * 256)); \
        _Pragma("unroll") for (int i = 0; i < 8; ++i) sb[i] = __builtin_nontemporal_load((const f32x4*)(pk_ + i * 256)); } while (0)
    DEC_LOAD(0);
    for (int s = 0; s < NSTEP; ++s) {
#pragma unroll
        for (int i = 0; i < 16; ++i) *(LAS u32x2*)(img + woA + i * (2 * DROW)) = (u32x2){cvtpk(sa[i][0], sa[i][1]), cvtpk(sa[i][2], sa[i][3])};
#pragma unroll
        for (int i = 0; i < 8; ++i) *(LAS u32x2*)(img + woB + i * (4 * DROW)) = (u32x2){cvtpk(sb[i][0], sb[i][1]), cvtpk(sb[i][2], sb[i][3])};
        SBAR();
        if (s + 1 < NSTEP) DEC_LOAD(s + 1);
        SBAR();
        f32x16 p0 = {};
#pragma unroll
        for (int d0 = 0; d0 < 12; ++d0) { const bf16x8 a = *(const LAS bf16x8*)(img + kaddr + 32 * d0); const bf16x8 qf = *(const LAS bf16x8*)(qsl + d0 * QSTR); p0 = __builtin_amdgcn_mfma_f32_32x32x16_bf16(a, qf, p0, 0, 0, 0); }
        float pmax = p0[0];
#pragma unroll
        for (int r = 1; r < 16; ++r) pmax = fmaxf(pmax, p0[r]);
        pmax = pl_swap_max(pmax);
        float mn, alpha;
        if (__builtin_expect(__all(pmax - m_reg <= THR2), 1)) { mn = m_reg; alpha = 1.f; }
        else { mn = fmaxf(m_reg, pmax); alpha = __builtin_amdgcn_exp2f(m_reg - mn); m_reg = mn; }
        float ps = 0.f;
#pragma unroll
        for (int r = 0; r < 16; ++r) { p0[r] = __builtin_amdgcn_exp2f(p0[r] - mn); ps += p0[r]; }
        ps = pl_swap_add(ps);
        l_reg = l_reg * alpha + ps;
        bf16x8 pa0, pa1; ATT_PK4(p0, 0, pa0); ATT_PK4(p0, 8, pa1);
        if (__any(alpha < 1.f)) {
#pragma unroll
            for (int r = 0; r < 4; ++r) { const float a = __shfl(alpha, r + 4 * hi);
#pragma unroll
                for (int d = 0; d < 4; ++d) o[d][r] *= a; } }
#define DEC_PV_D0(d0) do { s16x4 l0, h0, l1, h1; ATT_TRRD(l0, vaddr, (d0) * 64); ATT_TRRD(h0, vaddr, (d0) * 64 + 4 * DROW); ATT_TRRD(l1, vaddr, (d0) * 64 + 16 * DROW); ATT_TRRD(h1, vaddr, (d0) * 64 + 20 * DROW); \
        asm volatile("s_waitcnt lgkmcnt(0)" ::: "memory"); SBAR(); \
        o[d0] = __builtin_amdgcn_mfma_f32_32x32x16_bf16(pa0, ATT_PK(l0, h0), o[d0], 0, 0, 0); \
        o[d0] = __builtin_amdgcn_mfma_f32_32x32x16_bf16(pa1, ATT_PK(l1, h1), o[d0], 0, 0, 0); } while (0)
        DEC_PV_D0(0); DEC_PV_D0(1); DEC_PV_D0(2); DEC_PV_D0(3);
#undef DEC_PV_D0
        asm volatile("" ::: "memory");
    }
#undef DEC_LOAD
    LDS_WAIT();
    { LAS float* Ow = (LAS float*)img; LAS float* ml = (LAS float*)(img + 4096);
#pragma unroll
      for (int r = 0; r < 4; ++r)
#pragma unroll
          for (int d = 0; d < 4; ++d) Ow[(r + 4 * hi) * VD + d * 32 + r32] = o[d][r];
      if (lane < 8) { ml[2 * lane] = m_reg; ml[2 * lane + 1] = l_reg; } }
    __syncthreads();
    { const int head = tid >> 6, c = tid & 63; float M = -1e30f;
#pragma unroll
      for (int w = 0; w < NWAVES; ++w) M = fmaxf(M, ((LAS float*)(lds + w * DIMG + 4096))[2 * head]);
      float L = 0.f, O0 = 0.f, O1 = 0.f;
#pragma unroll
      for (int w = 0; w < NWAVES; ++w) { LAS float* ml = (LAS float*)(lds + w * DIMG + 4096); LAS float* Ow = (LAS float*)(lds + w * DIMG) + head * VD;
          const float f = __builtin_amdgcn_exp2f(ml[2 * head] - M); L += ml[2 * head + 1] * f; O0 += Ow[c] * f; O1 += Ow[c + 64] * f; }
      float* dp = DPART + ((size_t)item * NH + head) * 130; dp[c] = O0; dp[c + 64] = O1; if (c == 0) { dp[128] = M; dp[129] = L; } }
    __syncthreads();
}
}
#define XB_TMO      128
#define XB_XCNT(j)  (256  + 64 * (j))
#define XB_XSUB(j)  (1280 + 64 * (j))
#define XB_XGEN(j)  (2304 + 64 * (j))
#define XB_TOP      3328
#define XB_TOPGEN   3392
#define XCD_BAR_WORDS 3456
#define XB_SPIN_CAP (1u << 18)

__device__ __forceinline__ unsigned xb_ld(unsigned* p)              { return __hip_atomic_load(p, __ATOMIC_RELAXED, __HIP_MEMORY_SCOPE_AGENT); }
__device__ __forceinline__ unsigned xb_add(unsigned* p, unsigned v) { return __hip_atomic_fetch_add(p, v, __ATOMIC_RELAXED, __HIP_MEMORY_SCOPE_AGENT); }
__device__ __forceinline__ unsigned xb_xcc_id() { return (unsigned)__builtin_amdgcn_s_getreg((3 << 11) | 20) & 0xFu; }
#define XB_SPIN(cond, bar) do { unsigned _sp = 0; while (cond) { __builtin_amdgcn_s_sleep(1); \
    if ((++_sp & 255u) == 0u) { if (xb_ld(&(bar)[XB_TMO])) break; if (_sp > XB_SPIN_CAP) { atomicAdd(&(bar)[XB_TMO], 1u); break; } } } } while (0)

struct XcdBarrier {
    unsigned* bar; unsigned x;
    volatile LAS unsigned* st;
};

__device__ __forceinline__ XcdBarrier xcd_barrier_post(unsigned* bar, volatile LAS unsigned* st) {
    XcdBarrier b; b.bar = bar; b.x = xb_xcc_id(); b.st = st;
    if (threadIdx.x == 0) (void)xb_add(&bar[XB_XCNT(b.x)], 1u);
    return b;
}
__device__ __forceinline__ void xcd_barrier_complete(unsigned* bar, unsigned x, unsigned& nloc, unsigned& nx) {
    const unsigned G = gridDim.x * gridDim.y * gridDim.z;
    unsigned sum, cnt, mine, sp = 0u;
    for (;;) {
        sum = 0u; cnt = 0u; mine = 0u;
#pragma unroll
        for (unsigned j = 0; j < 16; ++j) { const unsigned c = xb_ld(&bar[XB_XCNT(j)]); sum += c; cnt += (c > 0u) ? 1u : 0u; mine = (j == x) ? c : mine; }
        if (sum == G) break;
        __builtin_amdgcn_s_sleep(1);
        if ((++sp & 255u) == 0u) { if (xb_ld(&bar[XB_TMO])) break; if (sp > XB_SPIN_CAP) { atomicAdd(&bar[XB_TMO], 1u); break; } }
    }
    nloc = mine > 0u ? mine : 1u; nx = cnt > 0u ? cnt : 1u;
}

__device__ __forceinline__ void xcd_barrier(const XcdBarrier& b) {
    asm volatile("s_waitcnt vmcnt(0)" ::: "memory");
    __syncthreads();
    if (threadIdx.x == 0) {
        unsigned* bar = b.bar;
        __builtin_amdgcn_s_waitcnt(0);
        unsigned nloc = b.st[0], nx = b.st[1];
        if (nloc == 0u) { xcd_barrier_complete(bar, b.x, nloc, nx); b.st[0] = nloc; b.st[1] = nx; }
        const unsigned old = xb_add(&bar[XB_XSUB(b.x)], 1u);
        const unsigned gen = old / nloc;
        if (old + 1u == (gen + 1u) * nloc) {
            __builtin_amdgcn_fence(__ATOMIC_RELEASE, "agent");
            asm volatile("s_waitcnt vmcnt(0)" ::: "memory");
            const unsigned og = xb_add(&bar[XB_TOP], 1u);
            const unsigned tg = og / nx;
            if (og + 1u == (tg + 1u) * nx) xb_add(&bar[XB_TOPGEN], 1u);
            else XB_SPIN(xb_ld(&bar[XB_TOPGEN]) == tg, bar);
            __builtin_amdgcn_fence(__ATOMIC_ACQUIRE, "agent");
            xb_add(&bar[XB_XGEN(b.x)], 1u);
            asm volatile("s_waitcnt vmcnt(0)" ::: "memory");
        } else {
            XB_SPIN(xb_ld(&bar[XB_XGEN(b.x)]) == gen, bar);
            __builtin_amdgcn_fence(__ATOMIC_ACQUIRE, "agent");
            asm volatile("s_waitcnt vmcnt(0)" ::: "memory");
        }
    }
    __syncthreads();
}

struct Args { const float* in[19]; float* out; unsigned char* ws; int ph_lo, ph_hi; };
enum { I_XP = 0, I_XS, I_CKV, I_CKR, I_SPOOL, I_PTAB, I_GPRE, I_WIN, I_GQ, I_WUQ, I_GKV, I_WUK, I_WUV, I_WOATT, I_WPOOL, I_PSCALE, I_WOPOOL, I_WOUT, I_GFINAL };
constexpr int N_PHASES = 9;

__device__ __forceinline__ void p0_transpose_item(const float* __restrict__ W, int K, int N, bf16* __restrict__ WT, int row_off, LAS float* scr, int item, int lane) {
    const int nblk = N / 32, kb = item / nblk, nb = item % nblk, k0 = 64 * kb, n0 = 32 * nb;
#pragma unroll 8
    for (int i = 0; i < 32; ++i) { const int kk = 2 * i + (lane >> 5); scr[kk * 33 + (lane & 31)] = W[(size_t)(k0 + kk) * N + n0 + (lane & 31)]; }
    LDS_WAIT(); asm volatile("" ::: "memory");
    const int c = lane & 7;
#pragma unroll
    for (int j = 0; j < 4; ++j) { const int n = (lane >> 3) + 8 * j; const LAS float* s = scr + (8 * c) * 33 + n;
        u32x4 o; o.x = cvtpk(s[0 * 33], s[1 * 33]); o.y = cvtpk(s[2 * 33], s[3 * 33]); o.z = cvtpk(s[4 * 33], s[5 * 33]); o.w = cvtpk(s[6 * 33], s[7 * 33]);
        *(u32x4*)(WT + (size_t)(row_off + n0 + n) * K + k0 + 8 * c) = o; }
    LDS_WAIT(); asm volatile("" ::: "memory");
}


#define PHASE_ARGS() \
    int tid_ = threadIdx.x; asm volatile("" : "+v"(tid_)); const int tid = tid_, lane = tid & 63, wave = __builtin_amdgcn_readfirstlane(tid >> 6); (void)lane; \
    const __attribute__((address_space(4))) Args* ap_ = (const __attribute__((address_space(4))) Args*)__builtin_amdgcn_kernarg_segment_ptr(); asm volatile("" : "+s"(ap_)); const __attribute__((address_space(4))) Args& args = *ap_; \
    unsigned char* ws = args.ws; float* out = args.out; (void)out; \
    bf16* BT1 = (bf16*)(ws + WS_BT1); bf16* BTQ = (bf16*)(ws + WS_BTQ); bf16* BTG = (bf16*)(ws + WS_BTG); bf16* BTOA = (bf16*)(ws + WS_BTOA); bf16* BTOP = (bf16*)(ws + WS_BTOP); bf16* BTOUT = (bf16*)(ws + WS_BTOUT); \
    float* ROPET = (float*)(ws + WS_ROPE); float* QSS = (float*)(ws + WS_QSS); float* DPART = (float*)(ws + WS_DPART); \
    bf16* H = (bf16*)(ws + WS_H); bf16* QLAT = (bf16*)(ws + WS_QLAT); float* KVRAW = (float*)(ws + WS_KVRAW); bf16* KB = (bf16*)(ws + WS_KB); bf16* SZ = (bf16*)(ws + WS_SZ); \
    float* U = (float*)(ws + WS_U); bf16* SGA = (bf16*)(ws + WS_SGA); bf16* SGP = (bf16*)(ws + WS_SGP); bf16* OLPL = (bf16*)(ws + WS_OLPL); bf16* QA = (bf16*)(ws + WS_QA); bf16* QR = (bf16*)(ws + WS_QR); \
    bf16* G12 = (bf16*)(ws + WS_G12); float* M1 = (float*)(ws + WS_M1); bf16* MG = (bf16*)(ws + WS_MG); \
    (void)BT1; (void)BTQ; (void)BTG; (void)BTOA; (void)BTOP; (void)BTOUT; (void)ROPET; (void)QSS; (void)DPART; (void)H; (void)QLAT; (void)KVRAW; (void)KB; (void)SZ; (void)U; (void)SGA; (void)SGP; (void)OLPL; (void)QA; (void)QR; (void)G12; (void)M1; (void)MG; \
    const int G = gridDim.x, bx = blockIdx.x; const int vcu = (G % 8 == 0) ? (bx % 8) * (G / 8) + bx / 8 : bx; const int gw = vcu * NWAVES + wave, NGW = G * NWAVES; (void)gw; (void)NGW;


__device__ __forceinline__ f32x4 skinny_tile(const bf16* __restrict__ A, int lda, const bf16* __restrict__ Bt, int ldb, int K, f32x4 acc, int lane) {
    const bf16* ap = A + (size_t)(lane & 15) * lda + (lane >> 4) * 8; const bf16* bp = Bt + (size_t)(lane & 15) * ldb + (lane >> 4) * 8;
#pragma unroll 8
    for (int k = 0; k < K; k += 32) acc = __builtin_amdgcn_mfma_f32_16x16x32_bf16(*(const bf16x8*)(bp + k), *(const bf16x8*)(ap + k), acc, 0, 0, 0);
    return acc;
}
__device__ __forceinline__ f32x4 unpk4(u32x2 g) { return (f32x4){bflo(g.x), bfhi(g.x), bflo(g.y), bfhi(g.y)}; }

__global__ void __launch_bounds__(NWAVES * 64, 2) mk_fwd(Args args_in) {
    extern __shared__ __attribute__((aligned(16))) unsigned char lds_raw[];
    LAS unsigned char* lds = (LAS unsigned char*)lds_raw;
    volatile LAS unsigned* MISC = (volatile LAS unsigned*)(lds + MISC_OFF);
    for (int u = threadIdx.x; u < (LDS_BYTES - LDSCTL_OFF) / 4; u += NWAVES * 64) ((LAS unsigned*)(lds + LDSCTL_OFF))[u] = 0u;
    __syncthreads();
    const int lo = args_in.ph_lo, hi = args_in.ph_hi;
    XcdBarrier bar = xcd_barrier_post((unsigned*)(args_in.ws + WS_CTL) + CW_BAR + lo * XCD_BAR_WORDS, MISC + 8);
#ifndef PH_MASK
#define PH_MASK 0x1ff
#endif
#define IN(k) (((PH_MASK >> (k)) & 1) && lo <= (k) && (k) < hi)
#define SEAM(k) do { if (IN(k) && IN((k) + 1)) xcd_barrier(bar); } while (0)
#ifdef MK_CHECK
#define STAMP(k) do { if (blockIdx.x == 0 && threadIdx.x == 0) ((unsigned long long*)((unsigned*)(args_in.ws + WS_CTL) + 131072 + 64))[(k)] = __builtin_amdgcn_s_memrealtime(); } while (0)
#else
#define STAMP(k) do { } while (0)
#endif
#ifdef MK_CHECK
#define STAMPX(k) do { if (threadIdx.x == 0) ((unsigned long long*)((unsigned*)(args_in.ws + WS_CTL) + 131072 + 64))[(k)] = __builtin_amdgcn_s_memrealtime(); } while (0)
#else
#define STAMPX(k) do { } while (0)
#endif
    STAMP(0);

    if (IN(0)) { PHASE_ARGS()
        LAS float* scr = (LAS float*)(lds + RING_OFF + wave * 16384);
        for (int it = gw; it < (DM / 64) * (INC / 32); it += NGW) { const int nb = it % (INC / 32); p0_transpose_item(args.in[I_WIN], DM, INC, BT1, (32 * nb >= 448) ? 64 : 0, scr, it, lane); }
        for (int i = bx * 512 + tid; i < 64 * DM / 8; i += G * 512) *(u32x4*)(BT1 + (size_t)448 * DM + (size_t)i * 8) = (u32x4){0u, 0u, 0u, 0u};
        for (int m0 = gw; m0 < MTOT; m0 += 2 * NGW) {
            const f32x4* gr = (const f32x4*)args.in[I_GPRE] + lane;
            f32x4 v[2][4]; float s[2] = {0.f, 0.f};
#pragma unroll
            for (int u = 0; u < 2; ++u) { const int m = m0 + u * NGW; if (m < MTOT) {
                const float* xrow = m < SEQ ? args.in[I_XP] + (size_t)m * DM : args.in[I_XS] + (size_t)(m - SEQ) * DM; const f32x4* xr = (const f32x4*)xrow + lane;
#pragma unroll
                for (int j = 0; j < 4; ++j) v[u][j] = __builtin_nontemporal_load(xr + 64 * j); } }
#pragma unroll
            for (int u = 0; u < 2; ++u) { const int m = m0 + u * NGW; if (m < MTOT) {
#pragma unroll
                for (int j = 0; j < 4; ++j) s[u] += (v[u][j][0] * v[u][j][0] + v[u][j][1] * v[u][j][1]) + (v[u][j][2] * v[u][j][2] + v[u][j][3] * v[u][j][3]);
                const float rs = 1.0f / sqrtf(wave_sum(s[u]) * (1.f / DM) + EPS);
                unsigned long long* o8 = (unsigned long long*)(H + (size_t)m * DM) + lane;
#pragma unroll
                for (int j = 0; j < 4; ++j) { const f32x4 g = gr[64 * j]; o8[64 * j] = (unsigned long long)cvtpk(v[u][j][0] * rs * g[0], v[u][j][1] * rs * g[1]) | ((unsigned long long)cvtpk(v[u][j][2] * rs * g[2], v[u][j][3] * rs * g[3]) << 32); } } }
        }
        VM_WAIT(); __syncthreads();
    }
    SEAM(0); STAMP(1);

    if (IN(1)) { PHASE_ARGS()
        pg8::Gemm g{H, BT1, DM, DM, DM, 0}; pg8::StaticOrder S; S.init(MPAD, N1, G, bx);
        pg8::Epi1 E{QLAT, QSS, KVRAW, SZ, U, SGA, SGP};
        pg8::gemm_phase<pg8::Epi1, pg8::StaticOrder, true, true>(lds + RING_OFF, g, S, E);
        { int first = S.nwg - (S.nwg / G) * G, cnt = G - first; if (S.nwg % G == 0) { first = 0; cnt = G; }
          if (bx >= first) { const int sw = (bx - first) * NWAVES + wave, NSW = cnt * NWAVES;
        for (int it = sw; it < 256 + 512; it += NSW) {
            const float* wuq = args.in[I_WUQ]; const float* gq = args.in[I_GQ];
            if (it < 256) { const int h = it >> 5, r0 = (it & 31) * 4; const float* uk = args.in[I_WUK] + ((size_t)r0 * NH + h) * NOPE;
                float a[4][4] = {};
#pragma unroll 4
                for (int n = 0; n < NOPE; n += 4) { f32x4 k4[4];
#pragma unroll
                    for (int i = 0; i < 4; ++i) k4[i] = *(const f32x4*)(uk + (size_t)i * NH * NOPE + n);
#pragma unroll
                    for (int j = 0; j < 4; ++j) { const f32x4 q4 = *(const f32x4*)(wuq + (size_t)(lane + 64 * j) * (NH * (NOPE + ROPE)) + h * (NOPE + ROPE) + n);
#pragma unroll
                        for (int i = 0; i < 4; ++i) a[i][j] += (q4[0] * k4[i][0] + q4[1] * k4[i][1]) + (q4[2] * k4[i][2] + q4[3] * k4[i][3]); } }
#pragma unroll
                for (int i = 0; i < 4; ++i)
#pragma unroll
                    for (int j = 0; j < 4; ++j) { const int k = lane + 64 * j; BTQ[(size_t)(h * NOPE + r0 + i) * QRANK + k] = (bf16)(cvtpk(a[i][j] * gq[k], 0.f) & 0xffffu); }
            } else { const int j2 = it - 256, pn = j2 >> 8, jj = j2 & 255, bj = jj >> 7, x = jj & 127, head = 4 * pn + (x >> 5), dim = (x & 31) + 32 * bj;
#pragma unroll
                for (int j = 0; j < 4; ++j) { const int k = lane + 64 * j; BTQ[(size_t)(1024 + j2) * QRANK + k] = (bf16)(cvtpk(gq[k] * wuq[(size_t)k * (NH * (NOPE + ROPE)) + head * (NOPE + ROPE) + NOPE + dim], 0.f) & 0xffffu); } }
        }
        for (int it = sw; it < 1536; it += NSW) {
#pragma unroll
            for (int j = 0; j < 4; ++j) { const int kk = lane + 64 * j; float v = 0.f;
                if (it < 1024) { const int h = it >> 7, vv = it & 127; if ((kk >> 7) == (h & 1)) v = args.in[I_WUV][((size_t)(kk & 127) * NH + h) * VD + vv]; }
                else { const int n = it - 1024, g = n >> 7, d = n & 127; if ((kk >> 7) == (g & 1)) v = args.in[I_WPOOL][((size_t)g * 128 + (kk & 127)) * 128 + d]; }
                BTG[(size_t)it * 256 + kk] = (bf16)(cvtpk(v, 0.f) & 0xffffu); }
        }
        { const float inv = powf(10000.0f, -(float)(lane & 31) / 32.0f);
          for (int e = sw * 64 + lane; e < (SEQ + 1) * 32; e += NSW * 64) { const int pos = e >> 5; float sn, cs; sincosf((float)pos * inv, &sn, &cs);
              *(f32x2*)(ROPET + 2 * (size_t)e) = (f32x2){cs, sn}; } }
          } }
        VM_WAIT(); __syncthreads();
    }
    SEAM(1); STAMP(2);

    if (IN(2)) { PHASE_ARGS()
#ifndef P2_NO_ELEM
        for (int r0 = gw; r0 < MTOT; r0 += 2 * NGW) {
            float v0[2], v1[2], x1[2], x2[2], cs[2], sn[2];
#pragma unroll
            for (int u = 0; u < 2; ++u) { const int row = r0 + u * NGW < MTOT ? r0 + u * NGW : r0; const float* src = KVRAW + (size_t)row * QKD; const int pos = row < SEQ ? row : SEQ;
                v0[u] = src[lane]; v1[u] = src[lane + 64]; x1[u] = src[KVR + (lane & 31)]; x2[u] = src[KVR + 32 + (lane & 31)];
                cs[u] = ROPET[2 * ((size_t)pos * 32 + (lane & 31))]; sn[u] = ROPET[2 * ((size_t)pos * 32 + (lane & 31)) + 1]; }
#pragma unroll
            for (int u = 0; u < 2; ++u) { const int row = r0 + u * NGW; if (row < MTOT) {
                float* ckv_o = row < SEQ ? out + O_CKVP + (size_t)row * KVR : out + O_CKVS + (size_t)(row - SEQ) * KVR;
                float* kr_o = row < SEQ ? out + O_KRP + (size_t)row * ROPE : out + O_KRS + (size_t)(row - SEQ) * ROPE;
                const float rs = 1.0f / sqrtf(wave_sum(v0[u] * v0[u] + v1[u] * v1[u]) * (1.f / KVR) + EPS);
                const float c0 = v0[u] * rs * args.in[I_GKV][lane], c1 = v1[u] * rs * args.in[I_GKV][lane + 64];
                ckv_o[lane] = c0; ckv_o[lane + 64] = c1;
                bf16* kb = KB + (size_t)row * QKD; kb[lane] = (bf16)(cvtpk(c0, 0.f) & 0xffffu); kb[lane + 64] = (bf16)(cvtpk(c1, 0.f) & 0xffffu);
                if (lane < 32) { const float o1 = x1[u] * cs[u] - x2[u] * sn[u], o2 = x2[u] * cs[u] + x1[u] * sn[u];
                    kr_o[lane] = o1; kr_o[lane + 32] = o2; kb[KVR + lane] = (bf16)(cvtpk(o1, 0.f) & 0xffffu); kb[KVR + 32 + lane] = (bf16)(cvtpk(o2, 0.f) & 0xffffu); } } }
        }
        for (int it = gw; it < (SEQ / 32) * 4; it += NGW) { const int q = it & 3, t0 = (it >> 2) * 32, w = 2 << q, c = 128 * q + 2 * lane;
            const float* __restrict__ Uc = U + c; bf16* __restrict__ Oc = OLPL + ATTW + c;
            f32x2 sum = {0.f, 0.f};
            for (int i = 1; i < w; ++i) { const int t = t0 - i; if (t >= 0) sum += *(const f32x2*)(Uc + (size_t)t * POOLW); }
            for (int tb = t0; tb < t0 + 32; tb += 8) { f32x2 un[8], uo[8];
#pragma unroll
                for (int j = 0; j < 8; ++j) { un[j] = *(const f32x2*)(Uc + (size_t)(tb + j) * POOLW); const int told = tb + j - (w - 1); uo[j] = (f32x2){0.f, 0.f}; if (told >= 0) uo[j] = *(const f32x2*)(Uc + (size_t)told * POOLW); }
#pragma unroll
                for (int j = 0; j < 8; ++j) { const int t = tb + j; sum += un[j]; const float rc = 1.0f / (float)(t + 1 < w ? t + 1 : w);
                    *(unsigned*)(Oc + (size_t)t * GW) = cvtpk(sum[0] * rc - un[j][0], sum[1] * rc - un[j][1]); sum -= uo[j]; } }
        }
        for (int it = gw; it < NS * 4; it += NGW) { const int q = it & 3, b = it >> 2, w = 2 << q, c = 128 * q + 2 * lane;
            const f32x2 u = *(const f32x2*)(U + (size_t)(SEQ + b) * POOLW + c); f32x2 sum = u;
            for (int i = 0; i < w - 1; ++i) sum += *(const f32x2*)(args.in[I_SPOOL] + ((size_t)b * PHIST + (PHIST - 1 - i)) * POOLW + c);
            const float rc = 1.0f / (float)w;
            *(unsigned*)(OLPL + (size_t)(SEQ + b) * GW + ATTW + c) = cvtpk(sum[0] * rc - u[0], sum[1] * rc - u[1]); }
        for (int e = gw * 64 + lane; e < (PHIST * POOLW + NS * PHIST * POOLW) / 4; e += NGW * 64) {
            if (e < PHIST * POOLW / 4) { *(f32x4*)(out + O_POOLP + (size_t)e * 4) = *(const f32x4*)(U + (size_t)(SEQ - PHIST) * POOLW + (size_t)e * 4); }
            else { const int e2 = e - PHIST * POOLW / 4, b = e2 / (PHIST * POOLW / 4), r = e2 % (PHIST * POOLW / 4), j = r / (POOLW / 4), c4 = r % (POOLW / 4);
                const f32x4 v = j < PHIST - 1 ? *(const f32x4*)(args.in[I_SPOOL] + ((size_t)b * PHIST + j + 1) * POOLW + c4 * 4) : *(const f32x4*)(U + (size_t)(SEQ + b) * POOLW + c4 * 4);
                *(f32x4*)(out + O_POOLS + (size_t)e2 * 4) = v; } }
#endif
#ifndef P2_NO_GEMM
        pg8::Gemm g{QLAT, BTQ, QRANK, QRANK, QRANK, 0}; pg8::StaticOrder S; S.init(MPAD, 1536, G, bx);
        pg8::Epi2 E{QA, QR, QSS, ROPET};
        pg8::gemm_phase<pg8::Epi2, pg8::StaticOrder, true, true>(lds + RING_OFF, g, S, E);
        { int first = S.nwg - (S.nwg / G) * G, cnt = G - first; if (S.nwg % G == 0) { first = 0; cnt = G; }
          if (bx >= first) { const int sw = (bx - first) * NWAVES + wave, NSW = cnt * NWAVES; LAS float* scr = (LAS float*)(lds + RING_OFF + wave * 16384);
              constexpr int I_OA = (ATTW / 64) * (DM / 32), I_OP = (POOLW / 64) * (DM / 32), I_OUT = (DM / 64) * (DM / 32);
              for (int it = sw; it < I_OA + I_OP + I_OUT; it += NSW) { int r = it;
                  if (r < I_OA) { p0_transpose_item(args.in[I_WOATT], ATTW, DM, BTOA, 0, scr, r, lane); continue; } r -= I_OA;
                  if (r < I_OP) { p0_transpose_item(args.in[I_WOPOOL], POOLW, DM, BTOP, 0, scr, r, lane); continue; } r -= I_OP;
                  p0_transpose_item(args.in[I_WOUT], DM, DM, BTOUT, 0, scr, r, lane); } } }
        VM_WAIT(); __syncthreads();
#endif
    }
    SEAM(2); STAMP(3);

    if (IN(3)) { PHASE_ARGS()
        gu32* qp = (gu32*)(ws + WS_CTL) + CW_QPROMPT; gu32* qd = (gu32*)(ws + WS_CTL) + CW_QDEC;
        volatile LAS unsigned* slot = (volatile LAS unsigned*)(lds + MISC_OFF) + 16;
#define GRAB(q_, v_) do { if (tid == 0) *slot = __hip_atomic_fetch_add((q_), 1u, __ATOMIC_RELAXED, __HIP_MEMORY_SCOPE_AGENT); __syncthreads(); (v_) = (int)*slot; __syncthreads(); } while (0)
        int mode = bx < ND_FIRST ? 0 : 1;
        for (int done = 0; done < 2;) {
            int it;
            const __attribute__((address_space(4))) Args* a2 = (const __attribute__((address_space(4))) Args*)__builtin_amdgcn_kernarg_segment_ptr(); asm volatile("" : "+s"(a2));
            unsigned char* w2 = a2->ws;
            int t2 = tid; asm volatile("" : "+v"(t2)); const int l2 = t2 & 63;
            if (mode == 0) { GRAB(qd, it); if (it >= NS * DSPLIT) { if (it == NS * DSPLIT) STAMPX(12); mode = 1; ++done; continue; }
                att::decode_item(it, a2->in[I_CKV], a2->in[I_CKR], (const int*)a2->in[I_PTAB], (const bf16*)(w2 + WS_QA), (const bf16*)(w2 + WS_QR), (float*)(w2 + WS_DPART), lds + RING_OFF, t2, wave, l2); }
            else { GRAB(qp, it); if (it >= SEQ / 32) { if (it == SEQ / 32) STAMPX(13); mode = 0; ++done; continue; }
                att::prompt_unit(32 * (SEQ / 32 - 1 - it), (const bf16*)(w2 + WS_QA), (const bf16*)(w2 + WS_QR), (const bf16*)(w2 + WS_KB), (bf16*)(w2 + WS_OLPL), lds + RING_OFF, t2, wave, l2); }
        }
#undef GRAB
    }
    SEAM(3); STAMP(4);

    if (IN(4)) { PHASE_ARGS()
        for (int it = gw; it < NS * NH; it += NGW) { const int b = it >> 3, h = it & 7; const size_t row = (size_t)(SEQ + b);
            const float* dp = DPART + ((size_t)(b * DSPLIT) * NH + h) * 130;
            const bf16* qa = QA + row * ATTW + h * NOPE; const bf16* qq = QR + row * (NH * ROPE) + h * ROPE; const bf16* kb = KB + row * QKD;
            float ts = bf2f(qa[lane]) * bf2f(kb[lane]) + bf2f(qa[lane + 64]) * bf2f(kb[lane + 64]) + bf2f(qq[lane]) * bf2f(kb[KVR + lane]);
            ts = wave_sum(ts);
            float M = ts;
#pragma unroll
            for (int p = 0; p < DSPLIT; ++p) M = fmaxf(M, dp[p * NH * 130 + 128]);
            const float wsf = __builtin_amdgcn_exp2f(ts - M);
            float L = wsf, o0 = wsf * bf2f(kb[lane]), o1 = wsf * bf2f(kb[lane + 64]);
#pragma unroll
            for (int p = 0; p < DSPLIT; ++p) { const float* d = dp + p * NH * 130; const float w = __builtin_amdgcn_exp2f(d[128] - M); L += d[129] * w; o0 += d[lane] * w; o1 += d[lane + 64] * w; }
            const float rl = 1.0f / L;
            OLPL[row * GW + h * VD + lane] = (bf16)(cvtpk(o0 * rl, 0.f) & 0xffffu); OLPL[row * GW + h * VD + lane + 64] = (bf16)(cvtpk(o1 * rl, 0.f) & 0xffffu);
        }
        VM_WAIT(); __syncthreads();
    }
    SEAM(4); STAMP(5);

    if (IN(5)) { PHASE_ARGS()
        for (int t = gw; t < 8 * 96; t += NGW) { const int rb = t / 96, n0 = 16 * (t % 96), hd = n0 >> 7, fr = lane & 15, fq = lane >> 4; const size_t row = (size_t)(SEQ + 16 * rb + fr); const int c = n0 + 4 * fq;
            f32x4 acc = skinny_tile(OLPL + (size_t)(SEQ + 16 * rb) * GW + hd * 128, GW, BTG + (size_t)n0 * 256 + 128 * (hd & 1), 256, 128, (f32x4){0.f, 0.f, 0.f, 0.f}, lane);
            acc = acc * unpk4(*(const u32x2*)(SZ + row * GW + c)); if (c >= ATTW) acc = acc * *(const f32x4*)(args.in[I_PSCALE] + c - ATTW);
            *(u32x2*)(G12 + row * GW + c) = (u32x2){cvtpk(acc[0], acc[1]), cvtpk(acc[2], acc[3])}; }
        pg8::Gemm g{OLPL, BTG, GW, 256, 256, 256}; pg8::StaticOrder S; S.init(SEQ, GW, G, bx);
        pg8::Epi5 E{G12, SZ, args.in[I_PSCALE]};
        pg8::gemm_phase<pg8::Epi5, pg8::StaticOrder, true, true>(lds + RING_OFF, g, S, E);
    }
    SEAM(5); STAMP(6);

    if (IN(6)) { PHASE_ARGS()
        for (int t = gw; t < 8 * 64; t += NGW) { const int rb = t >> 6, n0 = 16 * (t & 63), fr = lane & 15, fq = lane >> 4; const size_t row = (size_t)(SEQ + 16 * rb + fr); const int c = n0 + 4 * fq;
            const bf16* a1 = G12 + (size_t)(SEQ + 16 * rb) * GW;
            const f32x4 y1 = skinny_tile(a1, GW, BTOA + (size_t)n0 * ATTW, ATTW, ATTW, (f32x4){0.f, 0.f, 0.f, 0.f}, lane);
            const f32x4 y2 = skinny_tile(a1 + ATTW, GW, BTOP + (size_t)n0 * POOLW, POOLW, POOLW, (f32x4){0.f, 0.f, 0.f, 0.f}, lane);
            const f32x4 m = y1 * unpk4(*(const u32x2*)(SGA + row * DM + c)) + y2 * unpk4(*(const u32x2*)(SGP + row * DM + c));
            *(u32x2*)(MG + row * DM + c) = (u32x2){cvtpk(m[0], m[1]), cvtpk(m[2], m[3])}; }
        { pg8::Gemm g{G12, BTOA, GW, ATTW, ATTW, 0}; pg8::StaticOrder S; S.init(SEQ, DM, G, bx);
          pg8::Epi6<false> E{M1, MG, SGA};
          pg8::gemm_phase<pg8::Epi6<false>, pg8::StaticOrder, true, true>(lds + RING_OFF, g, S, E); }
        VM_WAIT(); __syncthreads();
        { pg8::Gemm g{G12 + ATTW, BTOP, GW, POOLW, POOLW, 0}; pg8::StaticOrder S; S.init(SEQ, DM, G, bx);
          pg8::Epi6<true> E{M1, MG, SGP};
          pg8::gemm_phase<pg8::Epi6<true>, pg8::StaticOrder, true, true>(lds + RING_OFF, g, S, E); }
    }
    SEAM(6); STAMP(7);

    if (IN(7)) { PHASE_ARGS()
        for (int t = gw; t < 8 * 64; t += NGW) { const int rb = t >> 6, n0 = 16 * (t & 63), fr = lane & 15, fq = lane >> 4; const int c = n0 + 4 * fq; const size_t r = (size_t)(16 * rb + fr);
            const f32x4 acc = skinny_tile(MG + (size_t)(SEQ + 16 * rb) * DM, DM, BTOUT + (size_t)n0 * DM, DM, DM, (f32x4){0.f, 0.f, 0.f, 0.f}, lane);
            *(f32x4*)(out + O_YS + r * DM + c) = *(const f32x4*)(args.in[I_XS] + r * DM + c) + acc; }
        pg8::Gemm g{MG, BTOUT, DM, DM, DM, 0}; pg8::StaticOrder S; S.init(SEQ, DM, G, bx);
        pg8::Epi7 E{args.in[I_XP], args.in[I_XS], out};
        pg8::gemm_phase<pg8::Epi7, pg8::StaticOrder, true, true>(lds + RING_OFF, g, S, E);
    }
    SEAM(7); STAMP(8);

    if (IN(8)) { PHASE_ARGS()
        for (int m = gw; m < MTOT; m += NGW) {
            float* y = m < SEQ ? out + O_YP + (size_t)m * DM : out + O_YS + (size_t)(m - SEQ) * DM;
            f32x4* yr = (f32x4*)y + lane; const f32x4* gr = (const f32x4*)args.in[I_GFINAL] + lane;
            f32x4 v[4]; float s = 0.f;
#pragma unroll
            for (int j = 0; j < 4; ++j) { v[j] = yr[64 * j]; s += (v[j][0] * v[j][0] + v[j][1] * v[j][1]) + (v[j][2] * v[j][2] + v[j][3] * v[j][3]); }
            const float rs = 1.0f / sqrtf(wave_sum(s) * (1.f / DM) + EPS);
#pragma unroll
            for (int j = 0; j < 4; ++j) yr[64 * j] = v[j] * rs * gr[64 * j];
        }
    }
    STAMP(9);
#undef IN
#undef SEAM
}

#ifndef MK_CUTS
#define MK_CUTS 0
#endif
extern "C" void kernel_launch(void* const* d_in, const int* in_sizes, int n_in, void* d_out, int out_size, void* d_ws, size_t ws_size, hipStream_t stream) {
    static int grid = 0;
    if (grid == 0) {
        if (n_in != 19 || out_size != (int)O_END || ws_size < WS_END) { fprintf(stderr, "kernel_launch: built for 19 inputs, %zu outputs, >= %zu bytes of workspace; got %d, %d, %zu\n", (size_t)O_END, (size_t)WS_END, n_in, out_size, ws_size); grid = -1; return; }
        int dev = 0, cus = 0, per_cu = 0;
        if (hipGetDevice(&dev) != hipSuccess || hipDeviceGetAttribute(&cus, hipDeviceAttributeMultiprocessorCount, dev) != hipSuccess) { grid = -1; return; }
        if (hipFuncSetAttribute((const void*)mk_fwd, hipFuncAttributeMaxDynamicSharedMemorySize, LDS_BYTES) != hipSuccess) { fprintf(stderr, "kernel_launch: hipFuncSetAttribute failed\n"); grid = -1; return; }
        if (hipOccupancyMaxActiveBlocksPerMultiprocessor(&per_cu, (const void*)mk_fwd, NWAVES * 64, LDS_BYTES) != hipSuccess || per_cu < 1) { fprintf(stderr, "kernel_launch: occupancy query says %d workgroups per CU\n", per_cu); }
        (void)hipGetLastError();
        grid = cus;
    }
    if (grid < 0) return;
    (void)hipMemsetAsync((char*)d_ws + WS_CTL, 0, CTL_ZERO_BYTES, stream);
    Args a{};
    for (int i = 0; i < 19; ++i) a.in[i] = (const float*)d_in[i];
    a.out = (float*)d_out; a.ws = (unsigned char*)d_ws;
#if MK_CUTS
    for (int p = 0; p < N_PHASES; ++p) { a.ph_lo = p; a.ph_hi = p + 1; hipLaunchKernelGGL(mk_fwd, dim3(grid), dim3(NWAVES * 64), LDS_BYTES, stream, a); }
#else
    a.ph_lo = 0; a.ph_hi = N_PHASES; hipLaunchKernelGGL(mk_fwd, dim3(grid), dim3(NWAVES * 64), LDS_BYTES, stream, a);
#endif
#ifdef MK_CHECK
    { static bool once = false; if (!once) { once = true; (void)hipFuncSetAttribute((const void*)chk_attn, hipFuncAttributeMaxDynamicSharedMemorySize, 68000); }
#ifndef CHK_NOERR
      hipLaunchKernelGGL(chk_attn, dim3(160 * 8), dim3(256), 68000, stream, a);
      hipLaunchKernelGGL(chk_chain, dim3(64), dim3(256), 0, stream, a);
#endif
      hipLaunchKernelGGL(chk_report, dim3(64), dim3(256), 0, stream, a); }
#endif
    const hipError_t le = hipPeekAtLastError();
    if (le != hipSuccess) fprintf(stderr, "kernel_launch: launch failed: %s\n", hipGetErrorName(le));
}
```

```cpp
#include <hip/hip_runtime.h>
#include <cstdio>
#include <cstdint>

#define GAS __attribute__((address_space(1)))
#define LAS __attribute__((address_space(3)))
typedef unsigned short bf16;
typedef short bf16x8 __attribute__((ext_vector_type(8)));
typedef short s16x4 __attribute__((ext_vector_type(4)));
typedef float f32x2 __attribute__((ext_vector_type(2)));
typedef float f32x4 __attribute__((ext_vector_type(4)));
typedef float f32x16 __attribute__((ext_vector_type(16)));
typedef unsigned u32x2 __attribute__((ext_vector_type(2)));
typedef unsigned u32x4 __attribute__((ext_vector_type(4)));
typedef GAS unsigned gu32;

constexpr int DM = 1024, SEQ = 16384, NS = 128, PAST = 16384, PAGE = 128, NPG = PAST / PAGE;
constexpr int MTOT = SEQ + NS;
constexpr int MPAD = 65 * 256;
constexpr int NH = 8, NOPE = 128, ROPE = 64, VD = 128, QRANK = 256, KVR = 128, ATTW = NH * VD, POOLW = 512, PHIST = 15;
constexpr int QKD = KVR + ROPE;
constexpr int INC = 4544, N1 = 4608;
constexpr int GW = ATTW + POOLW;
constexpr float EPS = 1e-6f;
constexpr float C2 = 0.07216878364870322f * 1.4426950408889634f;
constexpr size_t O_YP = 0, O_YS = O_YP + (size_t)SEQ * DM, O_CKVP = O_YS + (size_t)NS * DM, O_KRP = O_CKVP + (size_t)SEQ * KVR, O_POOLP = O_KRP + (size_t)SEQ * ROPE,
                 O_CKVS = O_POOLP + (size_t)PHIST * POOLW, O_KRS = O_CKVS + (size_t)NS * KVR, O_POOLS = O_KRS + (size_t)NS * ROPE, O_END = O_POOLS + (size_t)NS * PHIST * POOLW;
static_assert(O_END == 21069312, "d_out map");
constexpr size_t MiB = 1u << 20;
constexpr size_t WS_CTL = 0, CTL_ZERO_BYTES = 1 * MiB;
constexpr size_t WS_BT1 = 2 * MiB;
constexpr size_t WS_BTQ = 11 * MiB;
constexpr size_t WS_BTG = 12 * MiB;
constexpr size_t WS_BTOA = 13 * MiB;
constexpr size_t WS_BTOP = 15 * MiB;
constexpr size_t WS_BTOUT = 16 * MiB;
constexpr size_t WS_ROPE = 18 * MiB;
constexpr size_t WS_QSS = 23 * MiB;
constexpr size_t WS_DPART = 24 * MiB;
constexpr size_t WS_H = 32 * MiB;
constexpr size_t WS_QLAT = 65 * MiB;
constexpr size_t WS_KVRAW = 74 * MiB;
constexpr size_t WS_KB = 87 * MiB;
constexpr size_t WS_SZ = 94 * MiB;
constexpr size_t WS_U = 143 * MiB;
constexpr size_t WS_SGA = 176 * MiB;
constexpr size_t WS_SGP = 209 * MiB;
constexpr size_t WS_OLPL = 242 * MiB;
constexpr size_t WS_QA = 291 * MiB;
constexpr size_t WS_QR = 324 * MiB;
constexpr size_t WS_G12 = 341 * MiB;
constexpr size_t WS_M1 = 390 * MiB;
constexpr size_t WS_MG = 456 * MiB;
constexpr size_t WS_END = 489 * MiB;
static_assert(WS_BT1 + (size_t)N1 * 1024 * 2 <= WS_BTQ && WS_BTQ + 1536 * 256 * 2 <= WS_BTG && WS_BTG + 1536 * 256 * 2 <= WS_BTOA && WS_ROPE + (size_t)(SEQ + 1) * 32 * 8 <= WS_QSS &&
              WS_QSS + (size_t)MPAD * 16 <= WS_DPART && WS_DPART + (size_t)NS * 8 * 8 * 130 * 4 <= WS_H && WS_H + (size_t)MPAD * 2048 <= WS_QLAT && WS_QLAT + (size_t)MPAD * 512 <= WS_KVRAW &&
              WS_KVRAW + (size_t)MPAD * 768 <= WS_KB && WS_KB + (size_t)MPAD * 384 <= WS_SZ && WS_SZ + (size_t)MPAD * 3072 <= WS_U && WS_U + (size_t)MPAD * 2048 <= WS_SGA &&
              WS_SGA + (size_t)MPAD * 2048 <= WS_SGP && WS_SGP + (size_t)MPAD * 2048 <= WS_OLPL && WS_OLPL + (size_t)MPAD * 3072 <= WS_QA && WS_QA + (size_t)MPAD * 2048 <= WS_QR &&
              WS_QR + (size_t)MPAD * 1024 <= WS_G12 && WS_G12 + (size_t)MPAD * 3072 <= WS_M1 && WS_M1 + (size_t)MPAD * 4096 <= WS_MG && WS_MG + (size_t)MPAD * 2048 <= WS_END, "d_ws map");
constexpr int CW_QPROMPT = 1024, CW_QDEC = 1088;
constexpr int DSPLIT = 4;
#ifndef ND_FIRST
#define ND_FIRST 64
#endif
constexpr int CW_BAR = 4096;
constexpr int RING_OFF = 0, RING_BYTES = 131072;
constexpr int LDSCTL_OFF = RING_BYTES, MISC_OFF = LDSCTL_OFF + 320;
constexpr int LDS_BYTES = 147456;
constexpr int NWAVES = 8;

#define LDS_WAIT() asm volatile("s_waitcnt lgkmcnt(0)" ::: "memory")
#define VM_WAIT() asm volatile("s_waitcnt vmcnt(0)" ::: "memory")
#define SBAR() __builtin_amdgcn_sched_barrier(0)
__device__ __forceinline__ unsigned cvtpk(float lo, float hi) { unsigned r; asm("v_cvt_pk_bf16_f32 %0, %1, %2" : "=v"(r) : "v"(lo), "v"(hi)); return r; }
__device__ __forceinline__ float bflo(unsigned w) { return __builtin_bit_cast(float, w << 16); }
__device__ __forceinline__ float bfhi(unsigned w) { return __builtin_bit_cast(float, w & 0xffff0000u); }
__device__ __forceinline__ float bf2f(bf16 b) { return __builtin_bit_cast(float, (unsigned)b << 16); }
__device__ __forceinline__ float sigmoidf_(float x) { return __builtin_amdgcn_rcpf(1.f + __builtin_amdgcn_exp2f(-1.4426950408889634f * x)); }
__device__ __forceinline__ float wave_sum(float v) {
#pragma unroll
    for (int o = 1; o < 64; o <<= 1) v += __shfl_xor(v, o);
    return v;
}

namespace pg8 {
#define PG8_LAS __attribute__((address_space(3)))
typedef unsigned short bf16_t;
constexpr int BM = 256, BK = 64, HALF = 128, HTB = HALF * BK * 2  , STAGE_BYTES = 8 * HTB, NXCD = 8, WGM = 8;
__host__ __device__ __forceinline__ int lds_byte(int r, int c) { const int st = (r >> 4) * 2 + (c >> 5), rr = r & 15, cc = c & 31, ob = rr * 64 + cc * 2; return st * 1024 + (ob ^ (((ob >> 9) & 1) << 5)); }
__host__ __device__ __forceinline__ void stage_rc(int b, int& R, int& C) { const int st = b / 1024, sb = b % 1024, swz = sb ^ (((sb >> 9) & 1) << 5); R = (st >> 1) * 16 + swz / 64; C = (st & 1) * 32 + (swz % 64) / 2; }
__host__ __device__ __forceinline__ int perm32(int rho) { const int n = rho >> 4, i = rho & 15; return 8 * (i >> 2) + 4 * n + (i & 3); }
struct Unit { int pm, pn; };
struct Gemm { const bf16_t* A; const bf16_t* Bt; int lda, ldb, K, a_pn_off; };
struct StaticOrder {
    int nM, nN, nwg, G, c;
    __host__ __device__ void init(int M, int N, int G_, int c_) { nM = M / BM; nN = N / BM; nwg = nM * nN; G = G_; c = c_; }
    __host__ __device__ bool next(int i, Unit& u) const {
        const long L = (long)i * G + c; if (L >= nwg) return false;
        int wgid = (int)L; { const int q = nwg / NXCD, r = nwg % NXCD, xcd = wgid % NXCD, off = wgid / NXCD; wgid = (xcd < r ? xcd * (q + 1) : r * (q + 1) + (xcd - r) * q) + off; }
        const int nig = WGM * nN, gid = wgid / nig, fm = gid * WGM, gsz = (nM - fm) < WGM ? (nM - fm) : WGM;
        u.pm = fm + ((wgid % nig) % gsz); u.pn = (wgid % nig) / gsz; return true;
    }
    __device__ __forceinline__ void a_ready(const Unit&) const {}
    __device__ __forceinline__ void done(const Unit&) const {}
};
#define EPI_PACK8(v0, v1) ((u32x4){cvtpk((v0)[0], (v0)[1]), cvtpk((v0)[2], (v0)[3]), cvtpk((v1)[0], (v1)[1]), cvtpk((v1)[2], (v1)[3])})
#define EPI_UNPK_LO(g) ((f32x4){bflo((g).x), bfhi((g).x), bflo((g).y), bfhi((g).y)})
#define EPI_UNPK_HI(g) ((f32x4){bflo((g).z), bfhi((g).z), bflo((g).w), bfhi((g).w)})
struct Epi1 {
    static constexpr bool PERM = true, AFTER_DRAIN = false;
    bf16_t* QLAT; float* QSS; float* KVRAW; bf16_t* SZ; float* U; bf16_t* SGA; bf16_t* SGP;
    __device__ __forceinline__ void operator()(const f32x4 (&acc)[2][2][4][2], const Unit& u, int wr, int wc, int fr, int fq) const {
        const int pn = u.pn, row0 = u.pm * BM + wr * 64 + fr, c0 = wc * 32 + 8 * fq;
        if (pn == 0) {
#pragma unroll
            for (int ai = 0; ai < 2; ++ai)
#pragma unroll
                for (int m = 0; m < 4; ++m) { const size_t row = (size_t)(row0 + ai * HALF + m * 16); float ss = 0.f;
#pragma unroll
                    for (int bj = 0; bj < 2; ++bj) { const f32x4 v0 = acc[ai][bj][m][0], v1 = acc[ai][bj][m][1];
                        ss += (v0[0] * v0[0] + v0[1] * v0[1]) + (v0[2] * v0[2] + v0[3] * v0[3]) + (v1[0] * v1[0] + v1[1] * v1[1]) + (v1[2] * v1[2] + v1[3] * v1[3]);
                        *(u32x4*)(QLAT + row * 256 + bj * HALF + c0) = EPI_PACK8(v0, v1); }
                    ss += __shfl_xor(ss, 16); ss += __shfl_xor(ss, 32);
                    if (fq == 0) QSS[row * 4 + wc] = ss; }
        } else if (pn == 1) {
#pragma unroll
            for (int ai = 0; ai < 2; ++ai)
#pragma unroll
                for (int m = 0; m < 4; ++m) { const size_t row = (size_t)(row0 + ai * HALF + m * 16);
#pragma unroll
                    for (int bj = 0; bj < 2; ++bj) { const int c = bj * HALF + c0;
                        if (c < QKD) { *(f32x4*)(KVRAW + row * QKD + c) = acc[ai][bj][m][0]; *(f32x4*)(KVRAW + row * QKD + c + 4) = acc[ai][bj][m][1]; } } }
        } else if (pn == 6 || pn == 7) {
#pragma unroll
            for (int ai = 0; ai < 2; ++ai)
#pragma unroll
                for (int m = 0; m < 4; ++m) { const size_t row = (size_t)(row0 + ai * HALF + m * 16);
#pragma unroll
                    for (int bj = 0; bj < 2; ++bj) { float* p = U + row * POOLW + (pn - 6) * 256 + bj * HALF + c0;
                        *(f32x4*)p = acc[ai][bj][m][0]; *(f32x4*)(p + 4) = acc[ai][bj][m][1]; } }
        } else {
            bf16_t* dst; int ld; bool sig;
            if (pn < 6) { dst = SZ + (pn - 2) * 256; ld = GW; sig = false; }
            else if (pn < 10) { dst = SZ + ATTW + (pn - 8) * 256; ld = GW; sig = false; }
            else if (pn < 14) { dst = SGA + (pn - 10) * 256; ld = DM; sig = true; }
            else { dst = SGP + (pn - 14) * 256; ld = DM; sig = true; }
#pragma unroll
            for (int ai = 0; ai < 2; ++ai)
#pragma unroll
                for (int m = 0; m < 4; ++m) { const size_t row = (size_t)(row0 + ai * HALF + m * 16);
#pragma unroll
                    for (int bj = 0; bj < 2; ++bj) { f32x4 v0 = acc[ai][bj][m][0], v1 = acc[ai][bj][m][1];
#pragma unroll
                        for (int e = 0; e < 4; ++e) { const float s0 = sigmoidf_(v0[e]), s1 = sigmoidf_(v1[e]); v0[e] = sig ? s0 : v0[e] * s0; v1[e] = sig ? s1 : v1[e] * s1; }
                        *(u32x4*)(dst + row * ld + bj * HALF + c0) = EPI_PACK8(v0, v1); } }
        }
    }
};
struct Epi2 {
    static constexpr bool PERM = true, AFTER_DRAIN = false;
    bf16_t* QA; bf16_t* QR; const float* QSS; const float* ROPET;
    __device__ __forceinline__ void operator()(const f32x4 (&acc)[2][2][4][2], const Unit& u, int wr, int wc, int fr, int fq) const {
        const int pn = u.pn, row0 = u.pm * BM + wr * 64 + fr, c0 = wc * 32 + 8 * fq;
#pragma unroll
        for (int ai = 0; ai < 2; ++ai)
#pragma unroll
            for (int m = 0; m < 4; ++m) { const size_t row = (size_t)(row0 + ai * HALF + m * 16);
                const f32x4 q4 = *(const f32x4*)(QSS + row * 4);
                const float s = C2 * __builtin_amdgcn_rsqf(((q4[0] + q4[1]) + (q4[2] + q4[3])) * (1.f / QRANK) + EPS);
                if (pn < 4) {
#pragma unroll
                    for (int bj = 0; bj < 2; ++bj) { const f32x4 v0 = acc[ai][bj][m][0] * s, v1 = acc[ai][bj][m][1] * s;
                        *(u32x4*)(QA + row * ATTW + pn * 256 + bj * HALF + c0) = EPI_PACK8(v0, v1); }
                } else {
                    const int pos = row < SEQ ? (int)row : SEQ;
                    const float* rp = ROPET + ((size_t)pos * 32 + 8 * fq) * 2;
                    bf16_t* q = QR + row * (NH * ROPE) + (4 * (pn - 4) + wc) * ROPE + 8 * fq;
#pragma unroll
                    for (int n = 0; n < 2; ++n) {
                        const f32x4 t0 = *(const f32x4*)(rp + 8 * n), t1 = *(const f32x4*)(rp + 8 * n + 4);
                        const f32x4 a = acc[ai][0][m][n], b = acc[ai][1][m][n];
                        u32x2 lo, hi2;
                        lo.x = cvtpk((a[0] * t0[0] - b[0] * t0[1]) * s, (a[1] * t0[2] - b[1] * t0[3]) * s); lo.y = cvtpk((a[2] * t1[0] - b[2] * t1[1]) * s, (a[3] * t1[2] - b[3] * t1[3]) * s);
                        hi2.x = cvtpk((b[0] * t0[0] + a[0] * t0[1]) * s, (b[1] * t0[2] + a[1] * t0[3]) * s); hi2.y = cvtpk((b[2] * t1[0] + a[2] * t1[1]) * s, (b[3] * t1[2] + a[3] * t1[3]) * s);
                        *(u32x2*)(q + 4 * n) = lo; *(u32x2*)(q + 32 + 4 * n) = hi2; }
                }
                if (m & 1) __builtin_amdgcn_sched_barrier(0);
            }
    }
};
struct Epi5 {
    static constexpr bool PERM = true, AFTER_DRAIN = false;
    bf16_t* G12; const bf16_t* SZ; const float* pool_scale;
    __device__ __forceinline__ void operator()(const f32x4 (&acc)[2][2][4][2], const Unit& u, int wr, int wc, int fr, int fq) const {
        const int pn = u.pn, row0 = u.pm * BM + wr * 64 + fr, c0 = wc * 32 + 8 * fq;
#pragma unroll
        for (int bj = 0; bj < 2; ++bj) { const int c = pn * 256 + bj * HALF + c0;
            f32x4 p0 = {1.f, 1.f, 1.f, 1.f}, p1 = p0;
            if (pn >= 4) { p0 = *(const f32x4*)(pool_scale + c - ATTW); p1 = *(const f32x4*)(pool_scale + c - ATTW + 4); }
#pragma unroll
            for (int ai = 0; ai < 2; ++ai)
#pragma unroll
                for (int m = 0; m < 4; ++m) { const size_t row = (size_t)(row0 + ai * HALF + m * 16);
                    const u32x4 g = *(const u32x4*)(SZ + row * GW + c);
                    const f32x4 v0 = acc[ai][bj][m][0] * p0 * EPI_UNPK_LO(g), v1 = acc[ai][bj][m][1] * p1 * EPI_UNPK_HI(g);
                    *(u32x4*)(G12 + row * GW + c) = EPI_PACK8(v0, v1); } }
    }
};
template <bool SECOND> struct Epi6 {
    static constexpr bool PERM = true, AFTER_DRAIN = false;
    float* M1; bf16_t* MG; const bf16_t* SG;
    __device__ __forceinline__ void operator()(const f32x4 (&acc)[2][2][4][2], const Unit& u, int wr, int wc, int fr, int fq) const {
        const int pn = u.pn, row0 = u.pm * BM + wr * 64 + fr, c0 = wc * 32 + 8 * fq;
#pragma unroll
        for (int ai = 0; ai < 2; ++ai)
#pragma unroll
            for (int m = 0; m < 4; ++m) { const size_t row = (size_t)(row0 + ai * HALF + m * 16);
#pragma unroll
                for (int bj = 0; bj < 2; ++bj) { const size_t o = row * DM + pn * 256 + bj * HALF + c0;
                    const u32x4 g = *(const u32x4*)(SG + o);
                    f32x4 v0 = acc[ai][bj][m][0] * EPI_UNPK_LO(g), v1 = acc[ai][bj][m][1] * EPI_UNPK_HI(g);
                    if (!SECOND) { *(f32x4*)(M1 + o) = v0; *(f32x4*)(M1 + o + 4) = v1; }
                    else { v0 += *(const f32x4*)(M1 + o); v1 += *(const f32x4*)(M1 + o + 4); *(u32x4*)(MG + o) = EPI_PACK8(v0, v1); } } }
    }
};
struct Epi7 {
    static constexpr bool PERM = true, AFTER_DRAIN = false;
    const float* xp; const float* xs; float* out;
    __device__ __forceinline__ void operator()(const f32x4 (&acc)[2][2][4][2], const Unit& u, int wr, int wc, int fr, int fq) const {
        const int pn = u.pn, row0 = u.pm * BM + wr * 64 + fr, c0 = wc * 32 + 8 * fq;
#pragma unroll
        for (int ai = 0; ai < 2; ++ai)
#pragma unroll
            for (int m = 0; m < 4; ++m) { const int row = row0 + ai * HALF + m * 16;
                if (row < MTOT) {
                    const float* x = row < SEQ ? xp + (size_t)row * DM : xs + (size_t)(row - SEQ) * DM;
                    float* y = row < SEQ ? out + O_YP + (size_t)row * DM : out + O_YS + (size_t)(row - SEQ) * DM;
#pragma unroll
                    for (int bj = 0; bj < 2; ++bj) { const int c = pn * 256 + bj * HALF + c0;
                        *(f32x4*)(y + c) = *(const f32x4*)(x + c) + acc[ai][bj][m][0]; *(f32x4*)(y + c + 4) = *(const f32x4*)(x + c + 4) + acc[ai][bj][m][1]; } } }
    }
};
template <class Epi, class Sched, bool ALIGN_EPI = false, bool SP2 = false>
__device__ __forceinline__ void gemm_phase(PG8_LAS unsigned char* lds, const Gemm g, const Sched& S, const Epi& E) {
    int tid_ = threadIdx.x; asm volatile("" : "+v"(tid_));
    const int tid = tid_, wid = __builtin_amdgcn_readfirstlane(tid >> 6), lane = tid & 63, wr = wid >> 2, wc = wid & 3, fr = lane & 15, fq = lane >> 4;
    const int K = g.K, nt = K / BK;
    unsigned voffA[2], voffB[2];
#pragma unroll
    for (int i = 0; i < 2; ++i) { int R, C; stage_rc(tid * 16 + i * 8192, R, C); const int Rb = Epi::PERM ? ((R & ~31) + perm32(R & 31)) : R;
        voffA[i] = (unsigned)(R * g.lda + C) * 2u; voffB[i] = (unsigned)(Rb * g.ldb + C) * 2u; }
    const size_t kstep = (size_t)(BK * 2);
    const size_t hA = (size_t)HALF * g.lda * 2, hB = (size_t)HALF * g.ldb * 2;
    const size_t tA = 2 * hA, tB = 2 * hB, pA = (size_t)g.a_pn_off * 2;
    const unsigned ldsw = (unsigned)wid * 1024u;
    const int aoff = lds_byte(wr * 64 + fr, fq * 8), boff = lds_byte(wc * 32 + fr, fq * 8);
#define PG8_SA(b, h) (((b) * 2 + (h)) * HTB)
#define PG8_SB(b, h) ((4 + (b) * 2 + (h)) * HTB)
#define PG8_STAGE(bufoff, gbase, voff) do { _Pragma("unroll") for (int _i = 0; _i < 2; ++_i) \
        __builtin_amdgcn_global_load_lds((const unsigned*)((const char*)(gbase) + (voff)[_i]), (PG8_LAS unsigned*)(lds + (bufoff) + ldsw + _i * 8192), 16, 0, 0); } while (0)
#define PG8_LDA(dst, b, h) do { _Pragma("unroll") for (int m = 0; m < 4; ++m) _Pragma("unroll") for (int k = 0; k < 2; ++k) dst[m][k] = *(const PG8_LAS bf16x8*)(lds + PG8_SA(b, h) + aoff + m * 2048 + k * 1024); } while (0)
#define PG8_LDB(dst, b, h) do { _Pragma("unroll") for (int n = 0; n < 2; ++n) _Pragma("unroll") for (int k = 0; k < 2; ++k) dst[n][k] = *(const PG8_LAS bf16x8*)(lds + PG8_SB(b, h) + boff + n * 2048 + k * 1024); } while (0)
#define PG8_MMA(ai, bj, At, Bt) do { __builtin_amdgcn_s_setprio(1); _Pragma("unroll") for (int m = 0; m < 4; ++m) _Pragma("unroll") for (int n = 0; n < 2; ++n) _Pragma("unroll") for (int k = 0; k < 2; ++k) \
        acc[ai][bj][m][n] = __builtin_amdgcn_mfma_f32_16x16x32_bf16(Bt[n][k], At[m][k], acc[ai][bj][m][n], 0, 0, 0); __builtin_amdgcn_s_setprio(0); } while (0)
#define PG8_WAIT_V(n) asm volatile("s_waitcnt vmcnt(" #n ")" ::: "memory")
#define PG8_WAIT_L(n) asm volatile("s_waitcnt lgkmcnt(" #n ")" ::: "memory")
#define PG8_BAR __builtin_amdgcn_s_barrier()
#define PG8_SCHED __builtin_amdgcn_sched_barrier(0)
    Unit cur, nxt; int ui = 0;
    if (!S.next(0, cur)) return;
    f32x4 acc[2][2][4][2];
#pragma unroll
    for (int a = 0; a < 2; ++a)
#pragma unroll
        for (int b = 0; b < 2; ++b)
#pragma unroll
            for (int m = 0; m < 4; ++m)
#pragma unroll
                for (int n = 0; n < 2; ++n) acc[a][b][m][n] = (f32x4){0.f, 0.f, 0.f, 0.f};
    bf16x8 At[4][2], B0[2][2], B1[2][2];
    const char* cA = (const char*)g.A + (size_t)cur.pm * tA + (size_t)cur.pn * pA; const char* cB = (const char*)g.Bt + (size_t)cur.pn * tB;
    S.a_ready(cur);
    if constexpr (SP2) {
        PG8_STAGE(PG8_SB(0, 0), cB, voffB); PG8_STAGE(PG8_SB(0, 1), cB + hB, voffB); PG8_STAGE(PG8_SA(0, 0), cA, voffA); PG8_STAGE(PG8_SA(0, 1), cA + hA, voffA);
        if (wr == 1) PG8_BAR;
        PG8_WAIT_V(2); PG8_BAR;
        PG8_STAGE(PG8_SB(1, 0), cB + kstep, voffB); PG8_STAGE(PG8_SA(1, 0), cA + kstep, voffA); PG8_STAGE(PG8_SB(1, 1), cB + hB + kstep, voffB);
        PG8_WAIT_V(6); PG8_BAR;
    } else {
        PG8_STAGE(PG8_SB(0, 0), cB, voffB); PG8_STAGE(PG8_SA(0, 0), cA, voffA); PG8_STAGE(PG8_SB(0, 1), cB + hB, voffB); PG8_STAGE(PG8_SA(0, 1), cA + hA, voffA);
        if (wr == 1) PG8_BAR;
        PG8_WAIT_V(4); PG8_BAR;
        PG8_STAGE(PG8_SB(1, 0), cB + kstep, voffB); PG8_STAGE(PG8_SA(1, 0), cA + kstep, voffA); PG8_STAGE(PG8_SB(1, 1), cB + hB + kstep, voffB);
        PG8_WAIT_V(6); PG8_BAR;
    }
    for (;;) {
        const bool has_next = S.next(ui + 1, nxt);
        const char* nA = has_next ? (const char*)g.A + (size_t)nxt.pm * tA + (size_t)nxt.pn * pA : cA; const char* nB = has_next ? (const char*)g.Bt + (size_t)nxt.pn * tB : cB;
        for (int t = 0; t < nt; t += 2) {
            const bool last = (t == nt - 2);
            const char* a1 = cA + (size_t)(t + 1) * kstep;
            const char* a2 = last ? nA : cA + (size_t)(t + 2) * kstep; const char* b2 = last ? nB : cB + (size_t)(t + 2) * kstep;
            const char* a3 = a2 + kstep; const char* b3 = b2 + kstep;
            if (last && has_next) S.a_ready(nxt);
            if constexpr (SP2) {
            PG8_LDB(B0, 0, 0); PG8_LDB(B1, 0, 1); PG8_SCHED; PG8_LDA(At, 0, 0); PG8_STAGE(PG8_SA(1, 1), a1 + hA, voffA);
            PG8_WAIT_V(8); PG8_WAIT_L(0); PG8_BAR; PG8_MMA(0, 0, At, B0); PG8_MMA(0, 1, At, B1); PG8_BAR; PG8_SCHED;
            PG8_LDA(At, 0, 1); PG8_STAGE(PG8_SB(0, 0), b2, voffB); PG8_STAGE(PG8_SB(0, 1), b2 + hB, voffB); PG8_STAGE(PG8_SA(0, 0), a2, voffA);
            PG8_WAIT_V(8); PG8_WAIT_L(0); PG8_BAR; PG8_MMA(1, 0, At, B0); PG8_MMA(1, 1, At, B1); PG8_BAR; PG8_SCHED;
            PG8_LDB(B0, 1, 0); PG8_LDB(B1, 1, 1); PG8_SCHED; PG8_LDA(At, 1, 0); PG8_STAGE(PG8_SA(0, 1), a2 + hA, voffA);
            PG8_WAIT_V(8); PG8_WAIT_L(0); PG8_BAR; PG8_MMA(0, 0, At, B0); PG8_MMA(0, 1, At, B1); PG8_BAR; PG8_SCHED;
            PG8_LDA(At, 1, 1); PG8_STAGE(PG8_SB(1, 0), b3, voffB); PG8_STAGE(PG8_SB(1, 1), b3 + hB, voffB); PG8_STAGE(PG8_SA(1, 0), a3, voffA);
            PG8_WAIT_V(8); PG8_WAIT_L(0); PG8_BAR; PG8_MMA(1, 0, At, B0); PG8_MMA(1, 1, At, B1); PG8_BAR; PG8_SCHED;
            } else {
            PG8_LDB(B0, 0, 0); PG8_SCHED; PG8_LDA(At, 0, 0); PG8_STAGE(PG8_SA(1, 1), a1 + hA, voffA);
            PG8_WAIT_L(8); PG8_BAR; PG8_WAIT_L(0); PG8_MMA(0, 0, At, B0); PG8_BAR; PG8_SCHED;
            PG8_LDB(B1, 0, 1); PG8_STAGE(PG8_SB(0, 0), b2, voffB);
            PG8_BAR; PG8_WAIT_L(0); PG8_MMA(0, 1, At, B1); PG8_BAR;
            PG8_LDA(At, 0, 1); PG8_STAGE(PG8_SA(0, 0), a2, voffA);
            PG8_BAR; PG8_WAIT_L(0); PG8_MMA(1, 0, At, B0); PG8_BAR; PG8_SCHED;
            PG8_STAGE(PG8_SB(0, 1), b2 + hB, voffB);
            PG8_WAIT_V(6); PG8_BAR; PG8_MMA(1, 1, At, B1); PG8_BAR;
            PG8_LDB(B0, 1, 0); PG8_SCHED; PG8_LDA(At, 1, 0); PG8_STAGE(PG8_SA(0, 1), a2 + hA, voffA);
            PG8_WAIT_L(8); PG8_BAR; PG8_WAIT_L(0); PG8_MMA(0, 0, At, B0); PG8_BAR; PG8_SCHED;
            PG8_LDB(B1, 1, 1); PG8_STAGE(PG8_SB(1, 0), b3, voffB);
            PG8_BAR; PG8_WAIT_L(0); PG8_MMA(0, 1, At, B1); PG8_BAR;
            PG8_LDA(At, 1, 1); PG8_STAGE(PG8_SA(1, 0), a3, voffA);
            PG8_BAR; PG8_WAIT_L(0); PG8_MMA(1, 0, At, B0); PG8_BAR; PG8_SCHED;
            PG8_STAGE(PG8_SB(1, 1), b3 + hB, voffB);
            PG8_WAIT_V(6); PG8_BAR; PG8_MMA(1, 1, At, B1); PG8_BAR;
            }
        }
        if constexpr (ALIGN_EPI) { if (wr == 0) PG8_BAR; }
        if constexpr (!Epi::AFTER_DRAIN) { int l_; asm volatile("v_mbcnt_lo_u32_b32 %0, -1, 0\n\tv_mbcnt_hi_u32_b32 %0, -1, %0" : "=v"(l_));
            E(acc, cur, wr, wc, l_ & 15, l_ >> 4); S.done(cur); }
        if (!has_next) break;
#pragma unroll
        for (int a = 0; a < 2; ++a)
#pragma unroll
            for (int b = 0; b < 2; ++b)
#pragma unroll
                for (int m = 0; m < 4; ++m)
#pragma unroll
                    for (int n = 0; n < 2; ++n) acc[a][b][m][n] = (f32x4){0.f, 0.f, 0.f, 0.f};
        cur = nxt; cA = nA; cB = nB; ++ui;
        if constexpr (ALIGN_EPI) { if (wr == 1) PG8_BAR; }
    }
    PG8_WAIT_V(0);
    if constexpr (!ALIGN_EPI) { if (wr == 0) PG8_BAR; }
    PG8_BAR;
    if constexpr (Epi::AFTER_DRAIN) { E.fused(acc, cur, wr, wc, fr, fq, lds, wid, lane); S.done(cur); }
#undef PG8_SA
#undef PG8_SB
#undef PG8_STAGE
#undef PG8_LDA
#undef PG8_LDB
#undef PG8_MMA
#undef PG8_WAIT_V
#undef PG8_WAIT_L
#undef PG8_BAR
#undef PG8_SCHED
}
}
namespace att {
constexpr int SHM_K = 64 * 384, SHM_V = 64 * 256;
constexpr int L_V = 0, L_K = 2 * SHM_V, L_WS = L_K + 2 * SHM_K, L_QR = L_WS + NWAVES * 256, LDS_NEED = L_QR + NWAVES * 4096;
constexpr int DROW = 400, DIMG = 32 * DROW;
static_assert(LDS_NEED <= RING_BYTES && NWAVES * DIMG + 12 * 17 * 16 <= RING_BYTES, "attention LDS");
constexpr float THR2 = 8.f * 1.4426950408889634f;
__device__ __forceinline__ int crow(int r, int hi) { return (r & 3) + 8 * (r >> 2) + 4 * hi; }
__device__ __forceinline__ int v_st(int k, int c) { const int kk = (k & ~0xC) | ((k & 4) << 1) | ((k & 8) >> 1); return ((kk >> 3) * 4 + (c >> 5)) * 512 + ((kk & 7) * 32 + (c & 31)) * 2; }
__device__ __forceinline__ int v_rd_base(int lane) { return ((lane & 3) << 3) | (((lane >> 2) & 3) << 6) | (((lane >> 4) & 1) << 5) | (((lane >> 5) & 1) << 8); }
constexpr int v_rd_off(int d0, int ks, int half) { return d0 * 512 + ks * 4096 + half * 2048; }
__device__ __forceinline__ float pl_swap_max(float v) { auto rr = __builtin_amdgcn_permlane32_swap(__float_as_uint(v), __float_as_uint(v), false, false); return fmaxf(__uint_as_float(rr[0]), __uint_as_float(rr[1])); }
__device__ __forceinline__ float pl_swap_add(float v) { auto rr = __builtin_amdgcn_permlane32_swap(__float_as_uint(v), __float_as_uint(v), false, false); return __uint_as_float(rr[0]) + __uint_as_float(rr[1]); }
#define ATT_PK4(P, B_, OUT) do { unsigned a0 = cvtpk(P[B_+0], P[B_+1]), a1 = cvtpk(P[B_+2], P[B_+3]);                          \
        unsigned b0 = cvtpk(P[B_+4], P[B_+5]), b1 = cvtpk(P[B_+6], P[B_+7]);                                             \
        auto r0 = __builtin_amdgcn_permlane32_swap(a0, b0, false, false); auto r1 = __builtin_amdgcn_permlane32_swap(a1, b1, false, false); \
        u32x4 w = {r0[0], r1[0], r0[1], r1[1]}; OUT = __builtin_bit_cast(bf16x8, w); } while (0)
#define ATT_TRRD(dst, addr, off) asm volatile("ds_read_b64_tr_b16 %0, %1 offset:%2" : "=&v"(dst) : "v"(addr), "i"(off) : "memory")
#define ATT_PK(L, H) ((bf16x8){L[0], L[1], L[2], L[3], H[0], H[1], H[2], H[3]})

__device__ __forceinline__ void mask_tile(f32x16& p0, f32x16& p1, int dq) {
    const float NEG = -__builtin_inff();
#pragma unroll
    for (int r = 0; r < 16; ++r) { const int c = (r & 3) + 8 * (r >> 2);
        if (dq - c < 0) p0[r] = NEG;
        if (dq - c - 32 < 0) p1[r] = NEG; }
}
__device__ __forceinline__ void partialSM(f32x16& p0, f32x16& p1, float& m_reg, float& alpha) {
    float pmax = p0[0];
#pragma unroll
    for (int r = 1; r < 16; ++r) pmax = fmaxf(pmax, p0[r]);
#pragma unroll
    for (int r = 0; r < 16; ++r) pmax = fmaxf(pmax, p1[r]);
    pmax = pl_swap_max(pmax);
    float mn;
    if (__builtin_expect(__all(pmax - m_reg <= THR2), 1)) { mn = m_reg; alpha = 1.f; }
    else { mn = fmaxf(m_reg, pmax); alpha = __builtin_amdgcn_exp2f(m_reg - mn); m_reg = mn; }
#pragma unroll
    for (int r = 0; r < 16; ++r) p0[r] = __builtin_amdgcn_exp2f(p0[r] - mn);
#pragma unroll
    for (int r = 0; r < 16; ++r) p1[r] = p1[r] - mn;
}
__device__ __forceinline__ void finishSM(f32x16& p0, f32x16& p1, float alpha, float& l_reg, bf16x8& pa0, bf16x8& pa1, bf16x8& pa2, bf16x8& pa3) {
#pragma unroll
    for (int r = 0; r < 16; ++r) p1[r] = __builtin_amdgcn_exp2f(p1[r]);
    float ps = 0.f;
#pragma unroll
    for (int r = 0; r < 16; ++r) ps += p0[r];
#pragma unroll
    for (int r = 0; r < 16; ++r) ps += p1[r];
    ps = pl_swap_add(ps);
    l_reg = l_reg * alpha + ps;
    ATT_PK4(p0, 0, pa0); ATT_PK4(p0, 8, pa1); ATT_PK4(p1, 0, pa2); ATT_PK4(p1, 8, pa3);
}
template <int KB>
__device__ __forceinline__ void qkt(f32x16& p0, f32x16& p1, const LAS unsigned char* lds, int r32, int hi, const bf16x8* qr, const LAS unsigned char* qlds) {
    p0 = f32x16{}; p1 = f32x16{};
    const int sw = ((r32 >> 1) & 7) << 4;
    const LAS unsigned char* kb[4];
#pragma unroll
    for (int dd = 0; dd < 4; ++dd) kb[dd] = lds + L_K + KB * SHM_K + r32 * 384 + ((dd * 32 + hi * 16) ^ sw);
#pragma unroll
    for (int d0 = 0; d0 < 12; ++d0) { const LAS unsigned char* a = kb[d0 & 3] + (d0 >> 2) * 128;
        const bf16x8 b0 = *(const LAS bf16x8*)a, b1 = *(const LAS bf16x8*)(a + 32 * 384);
        const bf16x8 qf = d0 < 8 ? qr[d0 & 7] : *(const LAS bf16x8*)(qlds + (d0 - 8) * 1024);
        p0 = __builtin_amdgcn_mfma_f32_32x32x16_bf16(b0, qf, p0, 0, 0, 0);
        p1 = __builtin_amdgcn_mfma_f32_32x32x16_bf16(b1, qf, p1, 0, 0, 0); }
}
template <int VB>
__device__ __forceinline__ void pv_tile(f32x16* o, int vb0, bf16x8 pa0, bf16x8 pa1, bf16x8 pa2, bf16x8 pa3) {
#define ATT_PV_D0(d0) do { s16x4 l0, l1, l2, l3, h0, h1, h2, h3; constexpr int b_ = L_V + VB * SHM_V + v_rd_off(d0, 0, 0); \
        ATT_TRRD(l0, vb0, b_); ATT_TRRD(h0, vb0, b_ + 2048); ATT_TRRD(l1, vb0, b_ + 4096); ATT_TRRD(h1, vb0, b_ + 6144); ATT_TRRD(l2, vb0, b_ + 8192); ATT_TRRD(h2, vb0, b_ + 10240); ATT_TRRD(l3, vb0, b_ + 12288); ATT_TRRD(h3, vb0, b_ + 14336); \
        asm volatile("s_waitcnt lgkmcnt(0)" ::: "memory"); SBAR(); \
        o[d0] = __builtin_amdgcn_mfma_f32_32x32x16_bf16(pa0, ATT_PK(l0, h0), o[d0], 0, 0, 0); \
        o[d0] = __builtin_amdgcn_mfma_f32_32x32x16_bf16(pa1, ATT_PK(l1, h1), o[d0], 0, 0, 0); \
        o[d0] = __builtin_amdgcn_mfma_f32_32x32x16_bf16(pa2, ATT_PK(l2, h2), o[d0], 0, 0, 0); \
        o[d0] = __builtin_amdgcn_mfma_f32_32x32x16_bf16(pa3, ATT_PK(l3, h3), o[d0], 0, 0, 0); } while (0)
    ATT_PV_D0(0); ATT_PV_D0(1); ATT_PV_D0(2); ATT_PV_D0(3);
#undef ATT_PV_D0
}

__device__ __forceinline__ void prompt_unit(int q0, const bf16* __restrict__ QA, const bf16* __restrict__ QR, const bf16* __restrict__ KBm, bf16* __restrict__ OL, LAS unsigned char* lds, int tid, int wid, int lane) {
    const int r32 = lane & 31, hi = lane >> 5;
    const int NT = (q0 >> 6) + 1;
    bf16x8 qr[8];
    LAS unsigned char* qlds = lds + L_QR + wid * 4096 + lane * 16;
    { const bf16* qa = QA + (size_t)(q0 + r32) * ATTW + wid * NOPE + hi * 8; const bf16* qq = QR + (size_t)(q0 + r32) * (NH * ROPE) + wid * ROPE + hi * 8;
#pragma unroll
      for (int d0 = 0; d0 < 8; ++d0) qr[d0] = *(const bf16x8*)(qa + d0 * 16);
#pragma unroll
      for (int d0 = 0; d0 < 4; ++d0) *(LAS bf16x8*)(qlds + d0 * 1024) = *(const bf16x8*)(qq + d0 * 16); }
    LAS float* wsf = (LAS float*)(lds + L_WS) + wid * 64; LAS float* li_l = wsf; LAS float* al_l = wsf + 32;
    float m_reg = -1e30f, l_reg = 0.f; f32x16 o[4] = {};
    const int skey = tid >> 3, sc8 = tid & 7;
    const int kw0 = skey * 384 + ((sc8 * 16) ^ (((skey >> 1) & 7) << 4));
    const int vw0 = v_st(skey, sc8 * 8);
    const int vb0 = (int)(uintptr_t)lds + v_rd_base(lane);
    const int qm = q0 + r32 - 4 * hi;
    const bf16* ksrc = KBm + (size_t)skey * QKD + sc8 * 8;
    bf16x8 st0, st1, st2;
#define ATT_SLOAD(t) do { const bf16* p_ = ksrc + (size_t)(t) * (64 * QKD); st0 = *(const bf16x8*)p_; st1 = *(const bf16x8*)(p_ + 64); st2 = *(const bf16x8*)(p_ + 128); } while (0)
#define ATT_SWRITE(bf) do { LAS unsigned char* k_ = lds + L_K + (bf) * SHM_K + kw0; *(LAS bf16x8*)k_ = st0; *(LAS bf16x8*)(k_ + 128) = st1; *(LAS bf16x8*)(k_ + 256) = st2; \
        LAS unsigned char* v_ = lds + L_V + (bf) * SHM_V + vw0; *(LAS bf16x8*)v_ = st0; *(LAS bf16x8*)(v_ + 1024) = st1; } while (0)
#define ATT_RESC(a) do { if (__any((a) < 1.f)) { if (hi == 0) al_l[r32] = (a); LDS_WAIT(); \
        _Pragma("unroll") for (int d_ = 0; d_ < 4; ++d_) _Pragma("unroll") for (int r = 0; r < 16; ++r) o[d_][r] *= al_l[crow(r, hi)]; } } while (0)
#define ATT_MASKT(P0_, P1_, t) do { if ((t) == NT - 1) mask_tile(P0_, P1_, qm - 64 * (t)); } while (0)
    f32x16 pA0, pA1, pB0, pB1; float alA, alB; bf16x8 pa0, pa1, pa2, pa3;
    ATT_SLOAD(0); VM_WAIT(); ATT_SWRITE(0); SBAR();
    if (NT > 1) ATT_SLOAD(1);
    __syncthreads();
    SBAR(); qkt<0>(pA0, pA1, lds, r32, hi, qr, qlds);
    ATT_MASKT(pA0, pA1, 0); partialSM(pA0, pA1, m_reg, alA);
    if (NT > 1) { VM_WAIT(); ATT_SWRITE(1); }
    __syncthreads();
#define ATT_HALF_STEP(PX0, PX1, alX, PY0, PY1, alY, t, KB, VB, SB) do {                                          \
        SBAR(); qkt<KB>(PX0, PX1, lds, r32, hi, qr, qlds);                                                         \
        finishSM(PY0, PY1, alY, l_reg, pa0, pa1, pa2, pa3); SBAR();                                              \
        if ((t) + 1 < NT) { ATT_SLOAD((t) + 1); SBAR(); }                                                        \
        pv_tile<VB>(o, vb0, pa0, pa1, pa2, pa3); ATT_MASKT(PX0, PX1, (t)); partialSM(PX0, PX1, m_reg, alX);      \
        __syncthreads();                                                                                         \
        if ((t) + 1 < NT) { VM_WAIT(); ATT_SWRITE(SB); }                                                         \
        ATT_RESC(alX); __syncthreads(); } while (0)
    for (int t = 1; t + 1 < NT; t += 2) {
        ATT_HALF_STEP(pB0, pB1, alB, pA0, pA1, alA, t, 1, 0, 0);
        ATT_HALF_STEP(pA0, pA1, alA, pB0, pB1, alB, t + 1, 0, 1, 1);
    }
    const bool even = (NT & 1) == 0;
    if (even) { SBAR(); qkt<1>(pB0, pB1, lds, r32, hi, qr, qlds); SBAR(); }
    finishSM(pA0, pA1, alA, l_reg, pa0, pa1, pa2, pa3); SBAR();
    pv_tile<0>(o, vb0, pa0, pa1, pa2, pa3);
    if (even) { ATT_MASKT(pB0, pB1, NT - 1); partialSM(pB0, pB1, m_reg, alB); ATT_RESC(alB);
        finishSM(pB0, pB1, alB, l_reg, pa0, pa1, pa2, pa3); SBAR(); pv_tile<1>(o, vb0, pa0, pa1, pa2, pa3); }
    if (hi == 0) li_l[r32] = l_reg; LDS_WAIT();
    float rli[16];
#pragma unroll
    for (int r = 0; r < 16; ++r) rli[r] = __builtin_amdgcn_rcpf(li_l[crow(r, hi)]);
    bf16* Ow = OL + (size_t)q0 * GW + wid * VD;
#pragma unroll
    for (int r = 0; r < 16; ++r) { const int orow = crow(r, hi);
#pragma unroll
        for (int d0 = 0; d0 < 4; ++d0) { const float v = o[d0][r] * rli[r]; const float vn = __shfl_xor(v, 1);
            if ((r32 & 1) == 0) *(unsigned*)(Ow + (size_t)orow * GW + d0 * 32 + r32) = cvtpk(v, vn); } }
    __syncthreads();
#undef ATT_SLOAD
#undef ATT_SWRITE
#undef ATT_RESC
#undef ATT_MASKT
#undef ATT_HALF_STEP
}

__device__ __forceinline__ void decode_item(int item, const float* __restrict__ cckv, const float* __restrict__ ckr, const int* __restrict__ ptab, const bf16* __restrict__ QA, const bf16* __restrict__ QR,
                                            float* __restrict__ DPART, LAS unsigned char* lds, int tid, int wid, int lane) {
    constexpr int PPI = NPG / DSPLIT, NSTEP = 4 * PPI / NWAVES;
    const int b = item / DSPLIT, part = item % DSPLIT, r32 = lane & 31, hi = lane >> 5;
    constexpr int QOFF = NWAVES * DIMG, QSTR = 17 * 16;
    if (wid == 0) { const size_t qrow = (size_t)(SEQ + b);
        if (r32 < 8) { const bf16* qa = QA + qrow * ATTW + r32 * NOPE + hi * 8; const bf16* qq = QR + qrow * (NH * ROPE) + r32 * ROPE + hi * 8; LAS unsigned char* d = lds + QOFF + (hi * 8 + r32) * 16;
#pragma unroll
            for (int d0 = 0; d0 < 8; ++d0) *(LAS bf16x8*)(d + d0 * QSTR) = *(const bf16x8*)(qa + d0 * 16);
#pragma unroll
            for (int d0 = 0; d0 < 4; ++d0) *(LAS bf16x8*)(d + (8 + d0) * QSTR) = *(const bf16x8*)(qq + d0 * 16); }
        else if (lane == 8) { const bf16x8 z = {0, 0, 0, 0, 0, 0, 0, 0};
#pragma unroll
            for (int d0 = 0; d0 < 12; ++d0) *(LAS bf16x8*)(lds + QOFF + 256 + d0 * QSTR) = z; } }
    __syncthreads();
    const LAS unsigned char* qsl = lds + QOFF + (r32 < 8 ? (hi * 8 + r32) * 16 : 256);
    LAS unsigned char* img = lds + wid * DIMG;
    const int kaddr = r32 * DROW + 16 * hi;
    const int vaddr = (int)(uintptr_t)img + (8 * (lane >> 5) + ((lane >> 2) & 3)) * DROW + (16 * ((lane >> 4) & 1) + 4 * (lane & 3)) * 2;
    const int woA = (lane >> 5) * DROW + (lane & 31) * 8, woB = (lane >> 4) * DROW + 256 + (lane & 15) * 8;
    float m_reg = -1e30f, l_reg = 0.f; f32x16 o[4] = {};
    f32x4 sa[16], sb[8];
#define DEC_LOAD(s_) do { const int pg_ = PPI * part + wid + 8 * ((s_) >> 2); const int phys_ = __builtin_amdgcn_readfirstlane(ptab[b * NPG + pg_]); \
        const float* pc_ = cckv + (size_t)phys_ * (PAGE * KVR) + ((s_) & 3) * (32 * KVR) + lane * 4; const float* pk_ = ckr + (size_t)phys_ * (PAGE * ROPE) + ((s_) & 3) * (32 * ROPE) + lane * 4; \
        _Pragma("unroll") for (int i = 0; i < 16; ++i) sa[i] = __builtin_nontemporal_load((const f32x4*)(pc_ + i * 256)); \
        _Pragma("unroll") for (int i = 0; i < 8; ++i) sb[i] = __builtin_nontemporal_load((const f32x4*)(pk_ + i * 256)); } while (0)
    DEC_LOAD(0);
    for (int s = 0; s < NSTEP; ++s) {
#pragma unroll
        for (int i = 0; i < 16; ++i) *(LAS u32x2*)(img + woA + i * (2 * DROW)) = (u32x2){cvtpk(sa[i][0], sa[i][1]), cvtpk(sa[i][2], sa[i][3])};
#pragma unroll
        for (int i = 0; i < 8; ++i) *(LAS u32x2*)(img + woB + i * (4 * DROW)) = (u32x2){cvtpk(sb[i][0], sb[i][1]), cvtpk(sb[i][2], sb[i][3])};
        SBAR();
        if (s + 1 < NSTEP) DEC_LOAD(s + 1);
        SBAR();
        f32x16 p0 = {};
#pragma unroll
        for (int d0 = 0; d0 < 12; ++d0) { const bf16x8 a = *(const LAS bf16x8*)(img + kaddr + 32 * d0); const bf16x8 qf = *(const LAS bf16x8*)(qsl + d0 * QSTR); p0 = __builtin_amdgcn_mfma_f32_32x32x16_bf16(a, qf, p0, 0, 0, 0); }
        float pmax = p0[0];
#pragma unroll
        for (int r = 1; r < 16; ++r) pmax = fmaxf(pmax, p0[r]);
        pmax = pl_swap_max(pmax);
        float mn, alpha;
        if (__builtin_expect(__all(pmax - m_reg <= THR2), 1)) { mn = m_reg; alpha = 1.f; }
        else { mn = fmaxf(m_reg, pmax); alpha = __builtin_amdgcn_exp2f(m_reg - mn); m_reg = mn; }
        float ps = 0.f;
#pragma unroll
        for (int r = 0; r < 16; ++r) { p0[r] = __builtin_amdgcn_exp2f(p0[r] - mn); ps += p0[r]; }
        ps = pl_swap_add(ps);
        l_reg = l_reg * alpha + ps;
        bf16x8 pa0, pa1; ATT_PK4(p0, 0, pa0); ATT_PK4(p0, 8, pa1);
        if (__any(alpha < 1.f)) {
#pragma unroll
            for (int r = 0; r < 4; ++r) { const float a = __shfl(alpha, r + 4 * hi);
#pragma unroll
                for (int d = 0; d < 4; ++d) o[d][r] *= a; } }
#define DEC_PV_D0(d0) do { s16x4 l0, h0, l1, h1; ATT_TRRD(l0, vaddr, (d0) * 64); ATT_TRRD(h0, vaddr, (d0) * 64 + 4 * DROW); ATT_TRRD(l1, vaddr, (d0) * 64 + 16 * DROW); ATT_TRRD(h1, vaddr, (d0) * 64 + 20 * DROW); \
        asm volatile("s_waitcnt lgkmcnt(0)" ::: "memory"); SBAR(); \
        o[d0] = __builtin_amdgcn_mfma_f32_32x32x16_bf16(pa0, ATT_PK(l0, h0), o[d0], 0, 0, 0); \
        o[d0] = __builtin_amdgcn_mfma_f32_32x32x16_bf16(pa1, ATT_PK(l1, h1), o[d0], 0, 0, 0); } while (0)
        DEC_PV_D0(0); DEC_PV_D0(1); DEC_PV_D0(2); DEC_PV_D0(3);
#undef DEC_PV_D0
        asm volatile("" ::: "memory");
    }
#undef DEC_LOAD
    LDS_WAIT();
    { LAS float* Ow = (LAS float*)img; LAS float* ml = (LAS float*)(img + 4096);
#pragma unroll
      for (int r = 0; r < 4; ++r)
#pragma unroll
          for (int d = 0; d < 4; ++d) Ow[(r + 4 * hi) * VD + d * 32 + r32] = o[d][r];
      if (lane < 8) { ml[2 * lane] = m_reg; ml[2 * lane + 1] = l_reg; } }
    __syncthreads();
    { const int head = tid >> 6, c = tid & 63; float M = -1e30f;
#pragma unroll
      for (int w = 0; w < NWAVES; ++w) M = fmaxf(M, ((LAS float*)(lds + w * DIMG + 4096))[2 * head]);
      float L = 0.f, O0 = 0.f, O1 = 0.f;
#pragma unroll
      for (int w = 0; w < NWAVES; ++w) { LAS float* ml = (LAS float*)(lds + w * DIMG + 4096); LAS float* Ow = (LAS float*)(lds + w * DIMG) + head * VD;
          const float f = __builtin_amdgcn_exp2f(ml[2 * head] - M); L += ml[2 * head + 1] * f; O0 += Ow[c] * f; O1 += Ow[c + 64] * f; }
      float* dp = DPART + ((size_t)item * NH + head) * 130; dp[c] = O0; dp[c + 64] = O1; if (c == 0) { dp[128] = M; dp[129] = L; } }
    __syncthreads();
}
}
#define XB_TMO      128
#define XB_XCNT(j)  (256  + 64 * (j))
#define XB_XSUB(j)  (1280 + 64 * (j))
#define XB_XGEN(j)  (2304 + 64 * (j))
#define XB_TOP      3328
#define XB_TOPGEN   3392
#define XCD_BAR_WORDS 3456
#define XB_SPIN_CAP (1u << 18)

__device__ __forceinline__ unsigned xb_ld(unsigned* p)              { return __hip_atomic_load(p, __ATOMIC_RELAXED, __HIP_MEMORY_SCOPE_AGENT); }
__device__ __forceinline__ unsigned xb_add(unsigned* p, unsigned v) { return __hip_atomic_fetch_add(p, v, __ATOMIC_RELAXED, __HIP_MEMORY_SCOPE_AGENT); }
__device__ __forceinline__ unsigned xb_xcc_id() { return (unsigned)__builtin_amdgcn_s_getreg((3 << 11) | 20) & 0xFu; }
#define XB_SPIN(cond, bar) do { unsigned _sp = 0; while (cond) { __builtin_amdgcn_s_sleep(1); \
    if ((++_sp & 255u) == 0u) { if (xb_ld(&(bar)[XB_TMO])) break; if (_sp > XB_SPIN_CAP) { atomicAdd(&(bar)[XB_TMO], 1u); break; } } } } while (0)

struct XcdBarrier {
    unsigned* bar; unsigned x;
    volatile LAS unsigned* st;
};

__device__ __forceinline__ XcdBarrier xcd_barrier_post(unsigned* bar, volatile LAS unsigned* st) {
    XcdBarrier b; b.bar = bar; b.x = xb_xcc_id(); b.st = st;
    if (threadIdx.x == 0) (void)xb_add(&bar[XB_XCNT(b.x)], 1u);
    return b;
}
__device__ __forceinline__ void xcd_barrier_complete(unsigned* bar, unsigned x, unsigned& nloc, unsigned& nx) {
    const unsigned G = gridDim.x * gridDim.y * gridDim.z;
    unsigned sum, cnt, mine, sp = 0u;
    for (;;) {
        sum = 0u; cnt = 0u; mine = 0u;
#pragma unroll
        for (unsigned j = 0; j < 16; ++j) { const unsigned c = xb_ld(&bar[XB_XCNT(j)]); sum += c; cnt += (c > 0u) ? 1u : 0u; mine = (j == x) ? c : mine; }
        if (sum == G) break;
        __builtin_amdgcn_s_sleep(1);
        if ((++sp & 255u) == 0u) { if (xb_ld(&bar[XB_TMO])) break; if (sp > XB_SPIN_CAP) { atomicAdd(&bar[XB_TMO], 1u); break; } }
    }
    nloc = mine > 0u ? mine : 1u; nx = cnt > 0u ? cnt : 1u;
}

__device__ __forceinline__ void xcd_barrier(const XcdBarrier& b) {
    asm volatile("s_waitcnt vmcnt(0)" ::: "memory");
    __syncthreads();
    if (threadIdx.x == 0) {
        unsigned* bar = b.bar;
        __builtin_amdgcn_s_waitcnt(0);
        unsigned nloc = b.st[0], nx = b.st[1];
        if (nloc == 0u) { xcd_barrier_complete(bar, b.x, nloc, nx); b.st[0] = nloc; b.st[1] = nx; }
        const unsigned old = xb_add(&bar[XB_XSUB(b.x)], 1u);
        const unsigned gen = old / nloc;
        if (old + 1u == (gen + 1u) * nloc) {
            __builtin_amdgcn_fence(__ATOMIC_RELEASE, "agent");
            asm volatile("s_waitcnt vmcnt(0)" ::: "memory");
            const unsigned og = xb_add(&bar[XB_TOP], 1u);
            const unsigned tg = og / nx;
            if (og + 1u == (tg + 1u) * nx) xb_add(&bar[XB_TOPGEN], 1u);
            else XB_SPIN(xb_ld(&bar[XB_TOPGEN]) == tg, bar);
            __builtin_amdgcn_fence(__ATOMIC_ACQUIRE, "agent");
            xb_add(&bar[XB_XGEN(b.x)], 1u);
            asm volatile("s_waitcnt vmcnt(0)" ::: "memory");
        } else {
            XB_SPIN(xb_ld(&bar[XB_XGEN(b.x)]) == gen, bar);
            __builtin_amdgcn_fence(__ATOMIC_ACQUIRE, "agent");
            asm volatile("s_waitcnt vmcnt(0)" ::: "memory");
        }
    }
    __syncthreads();
}

struct Args { const float* in[19]; float* out; unsigned char* ws; int ph_lo, ph_hi; };
enum { I_XP = 0, I_XS, I_CKV, I_CKR, I_SPOOL, I_PTAB, I_GPRE, I_WIN, I_GQ, I_WUQ, I_GKV, I_WUK, I_WUV, I_WOATT, I_WPOOL, I_PSCALE, I_WOPOOL, I_WOUT, I_GFINAL };
constexpr int N_PHASES = 9;

__device__ __forceinline__ void p0_transpose_item(const float* __restrict__ W, int K, int N, bf16* __restrict__ WT, int row_off, LAS float* scr, int item, int lane) {
    const int nblk = N / 32, kb = item / nblk, nb = item % nblk, k0 = 64 * kb, n0 = 32 * nb;
#pragma unroll 8
    for (int i = 0; i < 32; ++i) { const int kk = 2 * i + (lane >> 5); scr[kk * 33 + (lane & 31)] = W[(size_t)(k0 + kk) * N + n0 + (lane & 31)]; }
    LDS_WAIT(); asm volatile("" ::: "memory");
    const int c = lane & 7;
#pragma unroll
    for (int j = 0; j < 4; ++j) { const int n = (lane >> 3) + 8 * j; const LAS float* s = scr + (8 * c) * 33 + n;
        u32x4 o; o.x = cvtpk(s[0 * 33], s[1 * 33]); o.y = cvtpk(s[2 * 33], s[3 * 33]); o.z = cvtpk(s[4 * 33], s[5 * 33]); o.w = cvtpk(s[6 * 33], s[7 * 33]);
        *(u32x4*)(WT + (size_t)(row_off + n0 + n) * K + k0 + 8 * c) = o; }
    LDS_WAIT(); asm volatile("" ::: "memory");
}


#define PHASE_ARGS() \
    int tid_ = threadIdx.x; asm volatile("" : "+v"(tid_)); const int tid = tid_, lane = tid & 63, wave = __builtin_amdgcn_readfirstlane(tid >> 6); (void)lane; \
    const __attribute__((address_space(4))) Args* ap_ = (const __attribute__((address_space(4))) Args*)__builtin_amdgcn_kernarg_segment_ptr(); asm volatile("" : "+s"(ap_)); const __attribute__((address_space(4))) Args& args = *ap_; \
    unsigned char* ws = args.ws; float* out = args.out; (void)out; \
    bf16* BT1 = (bf16*)(ws + WS_BT1); bf16* BTQ = (bf16*)(ws + WS_BTQ); bf16* BTG = (bf16*)(ws + WS_BTG); bf16* BTOA = (bf16*)(ws + WS_BTOA); bf16* BTOP = (bf16*)(ws + WS_BTOP); bf16* BTOUT = (bf16*)(ws + WS_BTOUT); \
    float* ROPET = (float*)(ws + WS_ROPE); float* QSS = (float*)(ws + WS_QSS); float* DPART = (float*)(ws + WS_DPART); \
    bf16* H = (bf16*)(ws + WS_H); bf16* QLAT = (bf16*)(ws + WS_QLAT); float* KVRAW = (float*)(ws + WS_KVRAW); bf16* KB = (bf16*)(ws + WS_KB); bf16* SZ = (bf16*)(ws + WS_SZ); \
    float* U = (float*)(ws + WS_U); bf16* SGA = (bf16*)(ws + WS_SGA); bf16* SGP = (bf16*)(ws + WS_SGP); bf16* OLPL = (bf16*)(ws + WS_OLPL); bf16* QA = (bf16*)(ws + WS_QA); bf16* QR = (bf16*)(ws + WS_QR); \
    bf16* G12 = (bf16*)(ws + WS_G12); float* M1 = (float*)(ws + WS_M1); bf16* MG = (bf16*)(ws + WS_MG); \
    (void)BT1; (void)BTQ; (void)BTG; (void)BTOA; (void)BTOP; (void)BTOUT; (void)ROPET; (void)QSS; (void)DPART; (void)H; (void)QLAT; (void)KVRAW; (void)KB; (void)SZ; (void)U; (void)SGA; (void)SGP; (void)OLPL; (void)QA; (void)QR; (void)G12; (void)M1; (void)MG; \
    const int G = gridDim.x, bx = blockIdx.x; const int vcu = (G % 8 == 0) ? (bx % 8) * (G / 8) + bx / 8 : bx; const int gw = vcu * NWAVES + wave, NGW = G * NWAVES; (void)gw; (void)NGW;


__device__ __forceinline__ f32x4 skinny_tile(const bf16* __restrict__ A, int lda, const bf16* __restrict__ Bt, int ldb, int K, f32x4 acc, int lane) {
    const bf16* ap = A + (size_t)(lane & 15) * lda + (lane >> 4) * 8; const bf16* bp = Bt + (size_t)(lane & 15) * ldb + (lane >> 4) * 8;
#pragma unroll 8
    for (int k = 0; k < K; k += 32) acc = __builtin_amdgcn_mfma_f32_16x16x32_bf16(*(const bf16x8*)(bp + k), *(const bf16x8*)(ap + k), acc, 0, 0, 0);
    return acc;
}
__device__ __forceinline__ f32x4 unpk4(u32x2 g) { return (f32x4){bflo(g.x), bfhi(g.x), bflo(g.y), bfhi(g.y)}; }

__global__ void __launch_bounds__(NWAVES * 64, 2) mk_fwd(Args args_in) {
    extern __shared__ __attribute__((aligned(16))) unsigned char lds_raw[];
    LAS unsigned char* lds = (LAS unsigned char*)lds_raw;
    volatile LAS unsigned* MISC = (volatile LAS unsigned*)(lds + MISC_OFF);
    for (int u = threadIdx.x; u < (LDS_BYTES - LDSCTL_OFF) / 4; u += NWAVES * 64) ((LAS unsigned*)(lds + LDSCTL_OFF))[u] = 0u;
    __syncthreads();
    const int lo = args_in.ph_lo, hi = args_in.ph_hi;
    XcdBarrier bar = xcd_barrier_post((unsigned*)(args_in.ws + WS_CTL) + CW_BAR + lo * XCD_BAR_WORDS, MISC + 8);
#ifndef PH_MASK
#define PH_MASK 0x1ff
#endif
#define IN(k) (((PH_MASK >> (k)) & 1) && lo <= (k) && (k) < hi)
#define SEAM(k) do { if (IN(k) && IN((k) + 1)) xcd_barrier(bar); } while (0)
#ifdef MK_CHECK
#define STAMP(k) do { if (blockIdx.x == 0 && threadIdx.x == 0) ((unsigned long long*)((unsigned*)(args_in.ws + WS_CTL) + 131072 + 64))[(k)] = __builtin_amdgcn_s_memrealtime(); } while (0)
#else
#define STAMP(k) do { } while (0)
#endif
#ifdef MK_CHECK
#define STAMPX(k) do { if (threadIdx.x == 0) ((unsigned long long*)((unsigned*)(args_in.ws + WS_CTL) + 131072 + 64))[(k)] = __builtin_amdgcn_s_memrealtime(); } while (0)
#else
#define STAMPX(k) do { } while (0)
#endif
    STAMP(0);

    if (IN(0)) { PHASE_ARGS()
        LAS float* scr = (LAS float*)(lds + RING_OFF + wave * 16384);
        for (int it = gw; it < (DM / 64) * (INC / 32); it += NGW) { const int nb = it % (INC / 32); p0_transpose_item(args.in[I_WIN], DM, INC, BT1, (32 * nb >= 448) ? 64 : 0, scr, it, lane); }
        for (int i = bx * 512 + tid; i < 64 * DM / 8; i += G * 512) *(u32x4*)(BT1 + (size_t)448 * DM + (size_t)i * 8) = (u32x4){0u, 0u, 0u, 0u};
        for (int m0 = gw; m0 < MTOT; m0 += 2 * NGW) {
            const f32x4* gr = (const f32x4*)args.in[I_GPRE] + lane;
            f32x4 v[2][4]; float s[2] = {0.f, 0.f};
#pragma unroll
            for (int u = 0; u < 2; ++u) { const int m = m0 + u * NGW; if (m < MTOT) {
                const float* xrow = m < SEQ ? args.in[I_XP] + (size_t)m * DM : args.in[I_XS] + (size_t)(m - SEQ) * DM; const f32x4* xr = (const f32x4*)xrow + lane;
#pragma unroll
                for (int j = 0; j < 4; ++j) v[u][j] = __builtin_nontemporal_load(xr + 64 * j); } }
#pragma unroll
            for (int u = 0; u < 2; ++u) { const int m = m0 + u * NGW; if (m < MTOT) {
#pragma unroll
                for (int j = 0; j < 4; ++j) s[u] += (v[u][j][0] * v[u][j][0] + v[u][j][1] * v[u][j][1]) + (v[u][j][2] * v[u][j][2] + v[u][j][3] * v[u][j][3]);
                const float rs = 1.0f / sqrtf(wave_sum(s[u]) * (1.f / DM) + EPS);
                unsigned long long* o8 = (unsigned long long*)(H + (size_t)m * DM) + lane;
#pragma unroll
                for (int j = 0; j < 4; ++j) { const f32x4 g = gr[64 * j]; o8[64 * j] = (unsigned long long)cvtpk(v[u][j][0] * rs * g[0], v[u][j][1] * rs * g[1]) | ((unsigned long long)cvtpk(v[u][j][2] * rs * g[2], v[u][j][3] * rs * g[3]) << 32); } } }
        }
        VM_WAIT(); __syncthreads();
    }
    SEAM(0); STAMP(1);

    if (IN(1)) { PHASE_ARGS()
        pg8::Gemm g{H, BT1, DM, DM, DM, 0}; pg8::StaticOrder S; S.init(MPAD, N1, G, bx);
        pg8::Epi1 E{QLAT, QSS, KVRAW, SZ, U, SGA, SGP};
        pg8::gemm_phase<pg8::Epi1, pg8::StaticOrder, true, true>(lds + RING_OFF, g, S, E);
        { int first = S.nwg - (S.nwg / G) * G, cnt = G - first; if (S.nwg % G == 0) { first = 0; cnt = G; }
          if (bx >= first) { const int sw = (bx - first) * NWAVES + wave, NSW = cnt * NWAVES;
        for (int it = sw; it < 256 + 512; it += NSW) {
            const float* wuq = args.in[I_WUQ]; const float* gq = args.in[I_GQ];
            if (it < 256) { const int h = it >> 5, r0 = (it & 31) * 4; const float* uk = args.in[I_WUK] + ((size_t)r0 * NH + h) * NOPE;
                float a[4][4] = {};
#pragma unroll 4
                for (int n = 0; n < NOPE; n += 4) { f32x4 k4[4];
#pragma unroll
                    for (int i = 0; i < 4; ++i) k4[i] = *(const f32x4*)(uk + (size_t)i * NH * NOPE + n);
#pragma unroll
                    for (int j = 0; j < 4; ++j) { const f32x4 q4 = *(const f32x4*)(wuq + (size_t)(lane + 64 * j) * (NH * (NOPE + ROPE)) + h * (NOPE + ROPE) + n);
#pragma unroll
                        for (int i = 0; i < 4; ++i) a[i][j] += (q4[0] * k4[i][0] + q4[1] * k4[i][1]) + (q4[2] * k4[i][2] + q4[3] * k4[i][3]); } }
#pragma unroll
                for (int i = 0; i < 4; ++i)
#pragma unroll
                    for (int j = 0; j < 4; ++j) { const int k = lane + 64 * j; BTQ[(size_t)(h * NOPE + r0 + i) * QRANK + k] = (bf16)(cvtpk(a[i][j] * gq[k], 0.f) & 0xffffu); }
            } else { const int j2 = it - 256, pn = j2 >> 8, jj = j2 & 255, bj = jj >> 7, x = jj & 127, head = 4 * pn + (x >> 5), dim = (x & 31) + 32 * bj;
#pragma unroll
                for (int j = 0; j < 4; ++j) { const int k = lane + 64 * j; BTQ[(size_t)(1024 + j2) * QRANK + k] = (bf16)(cvtpk(gq[k] * wuq[(size_t)k * (NH * (NOPE + ROPE)) + head * (NOPE + ROPE) + NOPE + dim], 0.f) & 0xffffu); } }
        }
        for (int it = sw; it < 1536; it += NSW) {
#pragma unroll
            for (int j = 0; j < 4; ++j) { const int kk = lane + 64 * j; float v = 0.f;
                if (it < 1024) { const int h = it >> 7, vv = it & 127; if ((kk >> 7) == (h & 1)) v = args.in[I_WUV][((size_t)(kk & 127) * NH + h) * VD + vv]; }
                else { const int n = it - 1024, g = n >> 7, d = n & 127; if ((kk >> 7) == (g & 1)) v = args.in[I_WPOOL][((size_t)g * 128 + (kk & 127)) * 128 + d]; }
                BTG[(size_t)it * 256 + kk] = (bf16)(cvtpk(v, 0.f) & 0xffffu); }
        }
        { const float inv = powf(10000.0f, -(float)(lane & 31) / 32.0f);
          for (int e = sw * 64 + lane; e < (SEQ + 1) * 32; e += NSW * 64) { const int pos = e >> 5; float sn, cs; sincosf((float)pos * inv, &sn, &cs);
              *(f32x2*)(ROPET + 2 * (size_t)e) = (f32x2){cs, sn}; } }
          } }
        VM_WAIT(); __syncthreads();
    }
    SEAM(1); STAMP(2);

    if (IN(2)) { PHASE_ARGS()
#ifndef P2_NO_ELEM
        for (int r0 = gw; r0 < MTOT; r0 += 2 * NGW) {
            float v0[2], v1[2], x1[2], x2[2], cs[2], sn[2];
#pragma unroll
            for (int u = 0; u < 2; ++u) { const int row = r0 + u * NGW < MTOT ? r0 + u * NGW : r0; const float* src = KVRAW + (size_t)row * QKD; const int pos = row < SEQ ? row : SEQ;
                v0[u] = src[lane]; v1[u] = src[lane + 64]; x1[u] = src[KVR + (lane & 31)]; x2[u] = src[KVR + 32 + (lane & 31)];
                cs[u] = ROPET[2 * ((size_t)pos * 32 + (lane & 31))]; sn[u] = ROPET[2 * ((size_t)pos * 32 + (lane & 31)) + 1]; }
#pragma unroll
            for (int u = 0; u < 2; ++u) { const int row = r0 + u * NGW; if (row < MTOT) {
                float* ckv_o = row < SEQ ? out + O_CKVP + (size_t)row * KVR : out + O_CKVS + (size_t)(row - SEQ) * KVR;
                float* kr_o = row < SEQ ? out + O_KRP + (size_t)row * ROPE : out + O_KRS + (size_t)(row - SEQ) * ROPE;
                const float rs = 1.0f / sqrtf(wave_sum(v0[u] * v0[u] + v1[u] * v1[u]) * (1.f / KVR) + EPS);
                const float c0 = v0[u] * rs * args.in[I_GKV][lane], c1 = v1[u] * rs * args.in[I_GKV][lane + 64];
                ckv_o[lane] = c0; ckv_o[lane + 64] = c1;
                bf16* kb = KB + (size_t)row * QKD; kb[lane] = (bf16)(cvtpk(c0, 0.f) & 0xffffu); kb[lane + 64] = (bf16)(cvtpk(c1, 0.f) & 0xffffu);
                if (lane < 32) { const float o1 = x1[u] * cs[u] - x2[u] * sn[u], o2 = x2[u] * cs[u] + x1[u] * sn[u];
                    kr_o[lane] = o1; kr_o[lane + 32] = o2; kb[KVR + lane] = (bf16)(cvtpk(o1, 0.f) & 0xffffu); kb[KVR + 32 + lane] = (bf16)(cvtpk(o2, 0.f) & 0xffffu); } } }
        }
        for (int it = gw; it < (SEQ / 32) * 4; it += NGW) { const int q = it & 3, t0 = (it >> 2) * 32, w = 2 << q, c = 128 * q + 2 * lane;
            const float* __restrict__ Uc = U + c; bf16* __restrict__ Oc = OLPL + ATTW + c;
            f32x2 sum = {0.f, 0.f};
            for (int i = 1; i < w; ++i) { const int t = t0 - i; if (t >= 0) sum += *(const f32x2*)(Uc + (size_t)t * POOLW); }
            for (int tb = t0; tb < t0 + 32; tb += 8) { f32x2 un[8], uo[8];
#pragma unroll
                for (int j = 0; j < 8; ++j) { un[j] = *(const f32x2*)(Uc + (size_t)(tb + j) * POOLW); const int told = tb + j - (w - 1); uo[j] = (f32x2){0.f, 0.f}; if (told >= 0) uo[j] = *(const f32x2*)(Uc + (size_t)told * POOLW); }
#pragma unroll
                for (int j = 0; j < 8; ++j) { const int t = tb + j; sum += un[j]; const float rc = 1.0f / (float)(t + 1 < w ? t + 1 : w);
                    *(unsigned*)(Oc + (size_t)t * GW) = cvtpk(sum[0] * rc - un[j][0], sum[1] * rc - un[j][1]); sum -= uo[j]; } }
        }
        for (int it = gw; it < NS * 4; it += NGW) { const int q = it & 3, b = it >> 2, w = 2 << q, c = 128 * q + 2 * lane;
            const f32x2 u = *(const f32x2*)(U + (size_t)(SEQ + b) * POOLW + c); f32x2 sum = u;
            for (int i = 0; i < w - 1; ++i) sum += *(const f32x2*)(args.in[I_SPOOL] + ((size_t)b * PHIST + (PHIST - 1 - i)) * POOLW + c);
            const float rc = 1.0f / (float)w;
            *(unsigned*)(OLPL + (size_t)(SEQ + b) * GW + ATTW + c) = cvtpk(sum[0] * rc - u[0], sum[1] * rc - u[1]); }
        for (int e = gw * 64 + lane; e < (PHIST * POOLW + NS * PHIST * POOLW) / 4; e += NGW * 64) {
            if (e < PHIST * POOLW / 4) { *(f32x4*)(out + O_POOLP + (size_t)e * 4) = *(const f32x4*)(U + (size_t)(SEQ - PHIST) * POOLW + (size_t)e * 4); }
            else { const int e2 = e - PHIST * POOLW / 4, b = e2 / (PHIST * POOLW / 4), r = e2 % (PHIST * POOLW / 4), j = r / (POOLW / 4), c4 = r % (POOLW / 4);
                const f32x4 v = j < PHIST - 1 ? *(const f32x4*)(args.in[I_SPOOL] + ((size_t)b * PHIST + j + 1) * POOLW + c4 * 4) : *(const f32x4*)(U + (size_t)(SEQ + b) * POOLW + c4 * 4);
                *(f32x4*)(out + O_POOLS + (size_t)e2 * 4) = v; } }
#endif
#ifndef P2_NO_GEMM
        pg8::Gemm g{QLAT, BTQ, QRANK, QRANK, QRANK, 0}; pg8::StaticOrder S; S.init(MPAD, 1536, G, bx);
        pg8::Epi2 E{QA, QR, QSS, ROPET};
        pg8::gemm_phase<pg8::Epi2, pg8::StaticOrder, true, true>(lds + RING_OFF, g, S, E);
        { int first = S.nwg - (S.nwg / G) * G, cnt = G - first; if (S.nwg % G == 0) { first = 0; cnt = G; }
          if (bx >= first) { const int sw = (bx - first) * NWAVES + wave, NSW = cnt * NWAVES; LAS float* scr = (LAS float*)(lds + RING_OFF + wave * 16384);
              constexpr int I_OA = (ATTW / 64) * (DM / 32), I_OP = (POOLW / 64) * (DM / 32), I_OUT = (DM / 64) * (DM / 32);
              for (int it = sw; it < I_OA + I_OP + I_OUT; it += NSW) { int r = it;
                  if (r < I_OA) { p0_transpose_item(args.in[I_WOATT], ATTW, DM, BTOA, 0, scr, r, lane); continue; } r -= I_OA;
                  if (r < I_OP) { p0_transpose_item(args.in[I_WOPOOL], POOLW, DM, BTOP, 0, scr, r, lane); continue; } r -= I_OP;
                  p0_transpose_item(args.in[I_WOUT], DM, DM, BTOUT, 0, scr, r, lane); } } }
        VM_WAIT(); __syncthreads();
#endif
    }
    SEAM(2); STAMP(3);

    if (IN(3)) { PHASE_ARGS()
        gu32* qp = (gu32*)(ws + WS_CTL) + CW_QPROMPT; gu32* qd = (gu32*)(ws + WS_CTL) + CW_QDEC;
        volatile LAS unsigned* slot = (volatile LAS unsigned*)(lds + MISC_OFF) + 16;
#define GRAB(q_, v_) do { if (tid == 0) *slot = __hip_atomic_fetch_add((q_), 1u, __ATOMIC_RELAXED, __HIP_MEMORY_SCOPE_AGENT); __syncthreads(); (v_) = (int)*slot; __syncthreads(); } while (0)
        int mode = bx < ND_FIRST ? 0 : 1;
        for (int done = 0; done < 2;) {
            int it;
            const __attribute__((address_space(4))) Args* a2 = (const __attribute__((address_space(4))) Args*)__builtin_amdgcn_kernarg_segment_ptr(); asm volatile("" : "+s"(a2));
            unsigned char* w2 = a2->ws;
            int t2 = tid; asm volatile("" : "+v"(t2)); const int l2 = t2 & 63;
            if (mode == 0) { GRAB(qd, it); if (it >= NS * DSPLIT) { if (it == NS * DSPLIT) STAMPX(12); mode = 1; ++done; continue; }
                att::decode_item(it, a2->in[I_CKV], a2->in[I_CKR], (const int*)a2->in[I_PTAB], (const bf16*)(w2 + WS_QA), (const bf16*)(w2 + WS_QR), (float*)(w2 + WS_DPART), lds + RING_OFF, t2, wave, l2); }
            else { GRAB(qp, it); if (it >= SEQ / 32) { if (it == SEQ / 32) STAMPX(13); mode = 0; ++done; continue; }
                att::prompt_unit(32 * (SEQ / 32 - 1 - it), (const bf16*)(w2 + WS_QA), (const bf16*)(w2 + WS_QR), (const bf16*)(w2 + WS_KB), (bf16*)(w2 + WS_OLPL), lds + RING_OFF, t2, wave, l2); }
        }
#undef GRAB
    }
    SEAM(3); STAMP(4);

    if (IN(4)) { PHASE_ARGS()
        for (int it = gw; it < NS * NH; it += NGW) { const int b = it >> 3, h = it & 7; const size_t row = (size_t)(SEQ + b);
            const float* dp = DPART + ((size_t)(b * DSPLIT) * NH + h) * 130;
            const bf16* qa = QA + row * ATTW + h * NOPE; const bf16* qq = QR + row * (NH * ROPE) + h * ROPE; const bf16* kb = KB + row * QKD;
            float ts = bf2f(qa[lane]) * bf2f(kb[lane]) + bf2f(qa[lane + 64]) * bf2f(kb[lane + 64]) + bf2f(qq[lane]) * bf2f(kb[KVR + lane]);
            ts = wave_sum(ts);
            float M = ts;
#pragma unroll
            for (int p = 0; p < DSPLIT; ++p) M = fmaxf(M, dp[p * NH * 130 + 128]);
            const float wsf = __builtin_amdgcn_exp2f(ts - M);
            float L = wsf, o0 = wsf * bf2f(kb[lane]), o1 = wsf * bf2f(kb[lane + 64]);
#pragma unroll
            for (int p = 0; p < DSPLIT; ++p) { const float* d = dp + p * NH * 130; const float w = __builtin_amdgcn_exp2f(d[128] - M); L += d[129] * w; o0 += d[lane] * w; o1 += d[lane + 64] * w; }
            const float rl = 1.0f / L;
            OLPL[row * GW + h * VD + lane] = (bf16)(cvtpk(o0 * rl, 0.f) & 0xffffu); OLPL[row * GW + h * VD + lane + 64] = (bf16)(cvtpk(o1 * rl, 0.f) & 0xffffu);
        }
        VM_WAIT(); __syncthreads();
    }
    SEAM(4); STAMP(5);

    if (IN(5)) { PHASE_ARGS()
        for (int t = gw; t < 8 * 96; t += NGW) { const int rb = t / 96, n0 = 16 * (t % 96), hd = n0 >> 7, fr = lane & 15, fq = lane >> 4; const size_t row = (size_t)(SEQ + 16 * rb + fr); const int c = n0 + 4 * fq;
            f32x4 acc = skinny_tile(OLPL + (size_t)(SEQ + 16 * rb) * GW + hd * 128, GW, BTG + (size_t)n0 * 256 + 128 * (hd & 1), 256, 128, (f32x4){0.f, 0.f, 0.f, 0.f}, lane);
            acc = acc * unpk4(*(const u32x2*)(SZ + row * GW + c)); if (c >= ATTW) acc = acc * *(const f32x4*)(args.in[I_PSCALE] + c - ATTW);
            *(u32x2*)(G12 + row * GW + c) = (u32x2){cvtpk(acc[0], acc[1]), cvtpk(acc[2], acc[3])}; }
        pg8::Gemm g{OLPL, BTG, GW, 256, 256, 256}; pg8::StaticOrder S; S.init(SEQ, GW, G, bx);
        pg8::Epi5 E{G12, SZ, args.in[I_PSCALE]};
        pg8::gemm_phase<pg8::Epi5, pg8::StaticOrder, true, true>(lds + RING_OFF, g, S, E);
    }
    SEAM(5); STAMP(6);

    if (IN(6)) { PHASE_ARGS()
        for (int t0 = 2 * bx; t0 < 8 * 64; t0 += 2 * G) { const int t = t0 + (wave >> 2), kq = wave & 3, rb = t >> 6, n0 = 16 * (t & 63), fr = lane & 15, fq = lane >> 4;
            LAS f32x4* red = (LAS f32x4*)(lds + RING_OFF);
            if (t < 8 * 64) { const bf16* a1 = G12 + (size_t)(SEQ + 16 * rb) * GW;
                red[wave * 64 + lane] = skinny_tile(a1 + kq * (ATTW / 4), GW, BTOA + (size_t)n0 * ATTW + kq * (ATTW / 4), ATTW, ATTW / 4, (f32x4){0.f, 0.f, 0.f, 0.f}, lane);
                red[512 + wave * 64 + lane] = skinny_tile(a1 + ATTW + kq * (POOLW / 4), GW, BTOP + (size_t)n0 * POOLW + kq * (POOLW / 4), POOLW, POOLW / 4, (f32x4){0.f, 0.f, 0.f, 0.f}, lane); }
            __syncthreads();
            if (t < 8 * 64 && kq == 0) { const size_t row = (size_t)(SEQ + 16 * rb + fr); const int c = n0 + 4 * fq; LAS f32x4* r1 = red + wave * 64 + lane; LAS f32x4* r2 = r1 + 512;
                const f32x4 y1 = (r1[0] + r1[64]) + (r1[128] + r1[192]), y2 = (r2[0] + r2[64]) + (r2[128] + r2[192]);
                const f32x4 m = y1 * unpk4(*(const u32x2*)(SGA + row * DM + c)) + y2 * unpk4(*(const u32x2*)(SGP + row * DM + c));
                *(u32x2*)(MG + row * DM + c) = (u32x2){cvtpk(m[0], m[1]), cvtpk(m[2], m[3])}; }
            __syncthreads(); }
        { pg8::Gemm g{G12, BTOA, GW, ATTW, ATTW, 0}; pg8::StaticOrder S; S.init(SEQ, DM, G, bx);
          pg8::Epi6<false> E{M1, MG, SGA};
          pg8::gemm_phase<pg8::Epi6<false>, pg8::StaticOrder, true, true>(lds + RING_OFF, g, S, E); }
        VM_WAIT(); __syncthreads();
        { pg8::Gemm g{G12 + ATTW, BTOP, GW, POOLW, POOLW, 0}; pg8::StaticOrder S; S.init(SEQ, DM, G, bx);
          pg8::Epi6<true> E{M1, MG, SGP};
          pg8::gemm_phase<pg8::Epi6<true>, pg8::StaticOrder, true, true>(lds + RING_OFF, g, S, E); }
    }
    SEAM(6); STAMP(7);

    if (IN(7)) { PHASE_ARGS()
        for (int t0 = 2 * bx; t0 < 8 * 64; t0 += 2 * G) { const int t = t0 + (wave >> 2), kq = wave & 3, rb = t >> 6, n0 = 16 * (t & 63), fr = lane & 15, fq = lane >> 4;
            LAS f32x4* red = (LAS f32x4*)(lds + RING_OFF);
            if (t < 8 * 64) red[wave * 64 + lane] = skinny_tile(MG + (size_t)(SEQ + 16 * rb) * DM + kq * (DM / 4), DM, BTOUT + (size_t)n0 * DM + kq * (DM / 4), DM, DM / 4, (f32x4){0.f, 0.f, 0.f, 0.f}, lane);
            __syncthreads();
            if (t < 8 * 64 && kq == 0) { const int c = n0 + 4 * fq; const size_t r = (size_t)(16 * rb + fr); LAS f32x4* r1 = red + wave * 64 + lane;
                *(f32x4*)(out + O_YS + r * DM + c) = *(const f32x4*)(args.in[I_XS] + r * DM + c) + ((r1[0] + r1[64]) + (r1[128] + r1[192])); }
            __syncthreads(); }
        pg8::Gemm g{MG, BTOUT, DM, DM, DM, 0}; pg8::StaticOrder S; S.init(SEQ, DM, G, bx);
        pg8::Epi7 E{args.in[I_XP], args.in[I_XS], out};
        pg8::gemm_phase<pg8::Epi7, pg8::StaticOrder, true, true>(lds + RING_OFF, g, S, E);
    }
    SEAM(7); STAMP(8);

    if (IN(8)) { PHASE_ARGS()
        for (int m = gw; m < MTOT; m += NGW) {
            float* y = m < SEQ ? out + O_YP + (size_t)m * DM : out + O_YS + (size_t)(m - SEQ) * DM;
            f32x4* yr = (f32x4*)y + lane; const f32x4* gr = (const f32x4*)args.in[I_GFINAL] + lane;
            f32x4 v[4]; float s = 0.f;
#pragma unroll
            for (int j = 0; j < 4; ++j) { v[j] = yr[64 * j]; s += (v[j][0] * v[j][0] + v[j][1] * v[j][1]) + (v[j][2] * v[j][2] + v[j][3] * v[j][3]); }
            const float rs = 1.0f / sqrtf(wave_sum(s) * (1.f / DM) + EPS);
#pragma unroll
            for (int j = 0; j < 4; ++j) yr[64 * j] = v[j] * rs * gr[64 * j];
        }
    }
    STAMP(9);
#undef IN
#undef SEAM
}

#ifndef MK_CUTS
#define MK_CUTS 0
#endif
extern "C" void kernel_launch(void* const* d_in, const int* in_sizes, int n_in, void* d_out, int out_size, void* d_ws, size_t ws_size, hipStream_t stream) {
    static int grid = 0;
    if (grid == 0) {
        if (n_in != 19 || out_size != (int)O_END || ws_size < WS_END) { fprintf(stderr, "kernel_launch: built for 19 inputs, %zu outputs, >= %zu bytes of workspace; got %d, %d, %zu\n", (size_t)O_END, (size_t)WS_END, n_in, out_size, ws_size); grid = -1; return; }
        int dev = 0, cus = 0, per_cu = 0;
        if (hipGetDevice(&dev) != hipSuccess || hipDeviceGetAttribute(&cus, hipDeviceAttributeMultiprocessorCount, dev) != hipSuccess) { grid = -1; return; }
        if (hipFuncSetAttribute((const void*)mk_fwd, hipFuncAttributeMaxDynamicSharedMemorySize, LDS_BYTES) != hipSuccess) { fprintf(stderr, "kernel_launch: hipFuncSetAttribute failed\n"); grid = -1; return; }
        if (hipOccupancyMaxActiveBlocksPerMultiprocessor(&per_cu, (const void*)mk_fwd, NWAVES * 64, LDS_BYTES) != hipSuccess || per_cu < 1) { fprintf(stderr, "kernel_launch: occupancy query says %d workgroups per CU\n", per_cu); }
        (void)hipGetLastError();
        grid = cus;
    }
    if (grid < 0) return;
    (void)hipMemsetAsync((char*)d_ws + WS_CTL, 0, CTL_ZERO_BYTES, stream);
    Args a{};
    for (int i = 0; i < 19; ++i) a.in[i] = (const float*)d_in[i];
    a.out = (float*)d_out; a.ws = (unsigned char*)d_ws;
#if MK_CUTS
    for (int p = 0; p < N_PHASES; ++p) { a.ph_lo = p; a.ph_hi = p + 1; hipLaunchKernelGGL(mk_fwd, dim3(grid), dim3(NWAVES * 64), LDS_BYTES, stream, a); }
#else
    a.ph_lo = 0; a.ph_hi = N_PHASES; hipLaunchKernelGGL(mk_fwd, dim3(grid), dim3(NWAVES * 64), LDS_BYTES, stream, a);
#endif
#ifdef MK_CHECK
    { static bool once = false; if (!once) { once = true; (void)hipFuncSetAttribute((const void*)chk_attn, hipFuncAttributeMaxDynamicSharedMemorySize, 68000); }
#ifndef CHK_NOERR
      hipLaunchKernelGGL(chk_attn, dim3(160 * 8), dim3(256), 68000, stream, a);
      hipLaunchKernelGGL(chk_chain, dim3(64), dim3(256), 0, stream, a);
#endif
      hipLaunchKernelGGL(chk_report, dim3(64), dim3(256), 0, stream, a); }
#endif
    const hipError_t le = hipPeekAtLastError();
    if (le != hipSuccess) fprintf(stderr, "kernel_launch: launch failed: %s\n", hipGetErrorName(le));
}
```
